# Optimizing an MI355X kernel written in HIP

```python
import math
import jax, jax.numpy as jnp
from jax import lax
import numpy as np

D_MODEL = 1024
BATCH = 4
SEQ = 8192
DEPTH = 2

HEAD_DIM = 64
N_META = 16
BLOCK_Q = 128
N_PAD = BLOCK_Q - N_META
NEG = -1e30
SB_HEADS = (D_MODEL // 2) // HEAD_DIM
SB_W = SB_HEADS * HEAD_DIM
DIFF_HEADS = (D_MODEL // 2) // (2 * HEAD_DIM)
DIFF_W = DIFF_HEADS * 2 * HEAD_DIM
EVEN_IN = 3 * SB_W + 3 * DIFF_W
FOX_HEADS = (D_MODEL // 2) // HEAD_DIM
FOX_W = FOX_HEADS * HEAD_DIM
S5_CHANNELS = D_MODEL // 2
S5_GROUP = 16
S5_GROUPS = S5_CHANNELS // S5_GROUP
S5_STATE = 64
ODD_IN = 3 * FOX_W + FOX_HEADS + S5_CHANNELS
D_FF = -(-8 * D_MODEL // (3 * 256)) * 256
N_EVEN = (DEPTH + 1) // 2
N_ODD = DEPTH // 2

kernel_name = "hybrid_stickbreak_diff_fox_s5_block"


def rms_norm(x, g, eps=1e-6):
    xf = x.astype(jnp.float32)
    y = xf * lax.rsqrt(jnp.mean(xf * xf, axis=-1, keepdims=True) + eps)
    return (y * g.astype(jnp.float32)).astype(x.dtype)


def sweep_blocks(block_fn, n_pos):
    starts = jnp.arange(n_pos // BLOCK_Q, dtype=jnp.int32) * BLOCK_Q
    out = lax.map(block_fn, starts)
    nb, b, bq, h, dv = out.shape
    return jnp.transpose(out, (1, 0, 2, 3, 4)).reshape(b, nb * bq, h, dv)


def stick_breaking_attention(q, k, v):
    L = q.shape[1]
    scale = HEAD_DIM ** -0.5
    kpos = jnp.arange(L)

    def block(start):
        qb = lax.dynamic_slice_in_dim(q, start, BLOCK_Q, axis=1)
        qpos = start + jnp.arange(BLOCK_Q)
        logits = jnp.einsum('bqhd,bkhd->bhqk', qb, k).astype(jnp.float32) * scale
        mask = (kpos[None, :] < qpos[:, None]) & (kpos[None, :] >= N_PAD)
        log_beta = jax.nn.log_sigmoid(logits)
        log_1m = jnp.where(mask, jax.nn.log_sigmoid(-logits), 0.0)
        log_w = log_beta + lax.cumsum(log_1m, axis=3, reverse=True) - log_1m
        w = jnp.where(mask, jnp.exp(log_w), 0.0)
        return jnp.einsum('bhqk,bkhd->bqhd', w.astype(v.dtype), v)

    return sweep_blocks(block, L)


def differential_attention(q, k, v, lam):
    L = q.shape[1]
    scale = HEAD_DIM ** -0.5
    kpos = jnp.arange(L)

    def block(start):
        qb = lax.dynamic_slice_in_dim(q, start, BLOCK_Q, axis=1)
        qpos = start + jnp.arange(BLOCK_Q)
        logits = jnp.einsum('bqhcd,bkhcd->bhcqk', qb, k).astype(jnp.float32) * scale
        mask = (kpos[None, :] <= qpos[:, None]) & (kpos[None, :] >= N_PAD)
        p = jax.nn.softmax(jnp.where(mask, logits, NEG), axis=-1)
        w = p[:, :, 0] - lam * p[:, :, 1]
        return jnp.einsum('bhqk,bkhe->bqhe', w.astype(v.dtype), v)

    return sweep_blocks(block, L)


def forgetting_attention(q, k, v, log_f):
    L = q.shape[1]
    scale = HEAD_DIM ** -0.5
    kpos = jnp.arange(L)
    f_cum = jnp.transpose(jnp.cumsum(log_f, axis=1), (0, 2, 1))

    def block(start):
        qb = lax.dynamic_slice_in_dim(q, start, BLOCK_Q, axis=1)
        fq = lax.dynamic_slice_in_dim(f_cum, start, BLOCK_Q, axis=2)
        qpos = start + jnp.arange(BLOCK_Q)
        logits = (jnp.einsum('bqhd,bkhd->bhqk', qb, k).astype(jnp.float32) * scale
                  + fq[..., :, None] - f_cum[..., None, :])
        mask = (kpos[None, :] <= qpos[:, None]) & (kpos[None, :] >= N_PAD)
        p = jax.nn.softmax(jnp.where(mask, logits, NEG), axis=-1)
        return jnp.einsum('bhqk,bkhd->bqhd', p.astype(v.dtype), v)

    return sweep_blocks(block, L)


def s5_glu(u, lam_re, lam_im, log_dt, b_re, b_im, c_re, c_im, d_skip, w_glu, b_glu):
    bsz, L, _ = u.shape
    f32 = jnp.float32
    uf = u.astype(f32).reshape(bsz, L, S5_GROUPS, S5_GROUP)
    lre, lim = lam_re.astype(f32), lam_im.astype(f32)
    dt = jnp.exp(log_dt.astype(f32))[:, None]
    mag = jnp.exp(lre * dt)
    a_re, a_im = mag * jnp.cos(lim * dt), mag * jnp.sin(lim * dt)
    den = lre * lre + lim * lim
    g_re = ((a_re - 1.0) * lre + a_im * lim) / den
    g_im = (a_im * lre - (a_re - 1.0) * lim) / den
    br, bi = b_re.astype(f32), b_im.astype(f32)
    bb_re = g_re[..., None] * br - g_im[..., None] * bi
    bb_im = g_re[..., None] * bi + g_im[..., None] * br
    bu_re = jnp.einsum('blgh,gph->blgp', uf, bb_re)
    bu_im = jnp.einsum('blgh,gph->blgp', uf, bb_im)
    shape_a = (1, L, S5_GROUPS, S5_STATE)
    a_re_l = jnp.broadcast_to(a_re[None, None], shape_a)
    a_im_l = jnp.broadcast_to(a_im[None, None], shape_a)

    def combine(e1, e2):
        a1r, a1i, b1r, b1i = e1
        a2r, a2i, b2r, b2i = e2
        return (a2r * a1r - a2i * a1i, a2r * a1i + a2i * a1r,
                a2r * b1r - a2i * b1i + b2r, a2r * b1i + a2i * b1r + b2i)

    _, _, x_re, x_im = lax.associative_scan(combine, (a_re_l, a_im_l, bu_re, bu_im), axis=1)
    y = (jnp.einsum('blgp,ghp->blgh', x_re, c_re.astype(f32))
         - jnp.einsum('blgp,ghp->blgh', x_im, c_im.astype(f32))
         + d_skip.astype(f32) * uf).reshape(bsz, L, S5_CHANNELS)
    y = jax.nn.gelu(y)
    out = y * jax.nn.sigmoid(y @ w_glu.astype(f32) + b_glu.astype(f32))
    return out.astype(u.dtype)


def even_mixer(h, w_in, w_out, lam_q1, lam_k1, lam_q2, lam_k2, subln_g, lam_init):
    bsz, L, _ = h.shape
    proj = h @ w_in
    sb_q, sb_k, sb_v, df_q, df_k, df_v = jnp.split(
        proj, [SB_W, 2 * SB_W, 3 * SB_W, 3 * SB_W + DIFF_W, 3 * SB_W + 2 * DIFF_W], axis=-1)
    hd = (bsz, L, SB_HEADS, HEAD_DIM)
    sb = stick_breaking_attention(sb_q.reshape(hd), sb_k.reshape(hd), sb_v.reshape(hd))
    f32 = jnp.float32
    lam = (jnp.exp(jnp.sum(lam_q1.astype(f32) * lam_k1.astype(f32)))
           - jnp.exp(jnp.sum(lam_q2.astype(f32) * lam_k2.astype(f32))) + lam_init)
    dqk = (bsz, L, DIFF_HEADS, 2, HEAD_DIM)
    df = differential_attention(df_q.reshape(dqk), df_k.reshape(dqk),
                                df_v.reshape(bsz, L, DIFF_HEADS, 2 * HEAD_DIM), lam)
    df = rms_norm(df, subln_g) * (1.0 - lam_init)
    cat = jnp.concatenate([sb.reshape(bsz, L, SB_W), df.reshape(bsz, L, DIFF_W).astype(h.dtype)], axis=-1)
    return cat @ w_out


def odd_mixer(h, w_in, w_out, b_f, lam_re, lam_im, log_dt, b_re, b_im, c_re, c_im, d_skip, w_glu, b_glu):
    bsz, L, _ = h.shape
    proj = h @ w_in
    q, k, v, f_logit, u = jnp.split(
        proj, [FOX_W, 2 * FOX_W, 3 * FOX_W, 3 * FOX_W + FOX_HEADS], axis=-1)
    hd = (bsz, L, FOX_HEADS, HEAD_DIM)
    log_f = jax.nn.log_sigmoid(f_logit.astype(jnp.float32) + b_f.astype(jnp.float32))
    fox = forgetting_attention(q.reshape(hd), k.reshape(hd), v.reshape(hd), log_f)
    ssm = s5_glu(u, lam_re, lam_im, log_dt, b_re, b_im, c_re, c_im, d_skip, w_glu, b_glu)
    cat = jnp.concatenate([fox.reshape(bsz, L, FOX_W), ssm], axis=-1)
    return cat @ w_out


def swiglu(h, w_gate_up, w_down):
    g, u = jnp.split(h @ w_gate_up, 2, axis=-1)
    return (jax.nn.silu(g) * u) @ w_down


def setup_inputs(seed: int = 0) -> dict:
    key = jax.random.key(seed)
    ks = jax.random.split(key, 32)
    f32 = jnp.float32
    nrm = lambda k, s, sc: jax.random.normal(k, s, f32) * sc
    n_idx = jnp.arange(S5_STATE, dtype=f32)
    return {
        "x": nrm(ks[0], (BATCH, SEQ, D_MODEL), 1.0),
        "meta_tokens": nrm(ks[1], (N_META, D_MODEL), 1.0),
        "norm_mix_g": 1.0 + nrm(ks[2], (DEPTH, D_MODEL), 0.01),
        "norm_ffn_g": 1.0 + nrm(ks[3], (DEPTH, D_MODEL), 0.01),
        "final_norm_g": 1.0 + nrm(ks[4], (D_MODEL,), 0.01),
        "even_w_in": nrm(ks[5], (N_EVEN, D_MODEL, EVEN_IN), D_MODEL ** -0.5),
        "even_w_out": nrm(ks[6], (N_EVEN, SB_W + DIFF_W, D_MODEL), (SB_W + DIFF_W) ** -0.5),
        "diff_lam_q1": nrm(ks[7], (N_EVEN, HEAD_DIM), 0.1),
        "diff_lam_k1": nrm(ks[8], (N_EVEN, HEAD_DIM), 0.1),
        "diff_lam_q2": nrm(ks[9], (N_EVEN, HEAD_DIM), 0.1),
        "diff_lam_k2": nrm(ks[10], (N_EVEN, HEAD_DIM), 0.1),
        "diff_subln_g": 1.0 + nrm(ks[11], (N_EVEN, 2 * HEAD_DIM), 0.01),
        "odd_w_in": nrm(ks[12], (N_ODD, D_MODEL, ODD_IN), D_MODEL ** -0.5),
        "odd_w_out": nrm(ks[13], (N_ODD, FOX_W + S5_CHANNELS, D_MODEL), (FOX_W + S5_CHANNELS) ** -0.5),
        "fox_b_f": jax.random.uniform(ks[14], (N_ODD, FOX_HEADS), f32, 1.0, 4.0),
        "s5_lam_re": -0.5 + nrm(ks[15], (N_ODD, S5_GROUPS, S5_STATE), 0.01),
        "s5_lam_im": math.pi * n_idx + nrm(ks[16], (N_ODD, S5_GROUPS, S5_STATE), 0.01),
        "s5_log_dt": jax.random.uniform(ks[17], (N_ODD, S5_GROUPS), f32, math.log(1e-3), math.log(1e-1)),
        "s5_b_re": nrm(ks[18], (N_ODD, S5_GROUPS, S5_STATE, S5_GROUP), (2 * S5_GROUP) ** -0.5),
        "s5_b_im": nrm(ks[19], (N_ODD, S5_GROUPS, S5_STATE, S5_GROUP), (2 * S5_GROUP) ** -0.5),
        "s5_c_re": nrm(ks[20], (N_ODD, S5_GROUPS, S5_GROUP, S5_STATE), S5_STATE ** -0.5),
        "s5_c_im": nrm(ks[21], (N_ODD, S5_GROUPS, S5_GROUP, S5_STATE), S5_STATE ** -0.5),
        "s5_d": nrm(ks[22], (N_ODD, S5_GROUPS, S5_GROUP), 1.0),
        "s5_w_glu": nrm(ks[23], (N_ODD, S5_CHANNELS, S5_CHANNELS), S5_CHANNELS ** -0.5),
        "s5_b_glu": nrm(ks[24], (N_ODD, S5_CHANNELS), 0.01),
        "ffn_w_gate_up": nrm(ks[25], (DEPTH, D_MODEL, 2 * D_FF), D_MODEL ** -0.5),
        "ffn_w_down": nrm(ks[26], (DEPTH, D_FF, D_MODEL), D_FF ** -0.5),
    }


def reference(x, meta_tokens, norm_mix_g, norm_ffn_g, final_norm_g,
              even_w_in, even_w_out, diff_lam_q1, diff_lam_k1, diff_lam_q2, diff_lam_k2, diff_subln_g,
              odd_w_in, odd_w_out, fox_b_f, s5_lam_re, s5_lam_im, s5_log_dt, s5_b_re, s5_b_im,
              s5_c_re, s5_c_im, s5_d, s5_w_glu, s5_b_glu, ffn_w_gate_up, ffn_w_down):
    bsz = x.shape[0]
    pad = jnp.zeros((bsz, N_PAD, D_MODEL), x.dtype)
    meta = jnp.broadcast_to(meta_tokens[None].astype(x.dtype), (bsz, N_META, D_MODEL))
    h = jnp.concatenate([pad, meta, x], axis=1)
    L = h.shape[1]
    valid = (jnp.arange(L) >= N_PAD).astype(x.dtype)[None, :, None]
    for i in range(DEPTH):
        j = i // 2
        hn = rms_norm(h, norm_mix_g[i])
        if i % 2 == 0:
            lam_init = 0.8 - 0.6 * math.exp(-0.3 * i)
            mix = even_mixer(hn, even_w_in[j], even_w_out[j], diff_lam_q1[j], diff_lam_k1[j],
                             diff_lam_q2[j], diff_lam_k2[j], diff_subln_g[j], lam_init)
        else:
            mix = odd_mixer(hn, odd_w_in[j], odd_w_out[j], fox_b_f[j], s5_lam_re[j], s5_lam_im[j],
                            s5_log_dt[j], s5_b_re[j], s5_b_im[j], s5_c_re[j], s5_c_im[j], s5_d[j],
                            s5_w_glu[j], s5_b_glu[j])
        h = h + mix * valid
        h = h + swiglu(rms_norm(h, norm_ffn_g[i]), ffn_w_gate_up[i], ffn_w_down[i]) * valid
    h = rms_norm(h, final_norm_g)
    return h[:, BLOCK_Q:]
```

```cpp
#include <hip/hip_runtime.h>
#include <hip/hip_cooperative_groups.h>
#include <cstdio>
#include <cstdint>
namespace cg = cooperative_groups;

#define LAS __attribute__((address_space(3)))
constexpr int DM = 1024, NBATCH = 4, SEQ = 8192, LP = 8448, PADR = 240, NMETA = 16, MROWS = NBATCH * LP;
constexpr int DFF = 2816, NW = 8, NTHR = 512;
constexpr float C2 = 0.125f * 1.4426950408889634f;
constexpr float LOG2E = 1.4426950408889634f;
constexpr float RMS_EPS = 1e-6f;
constexpr int LDS_BYTES = 147456;

constexpr size_t MiB = 1u << 20;
constexpr size_t WS_CTL = 0;
constexpr size_t WS_SSQ = 1 * MiB;
constexpr size_t WS_F = 2 * MiB;
constexpr size_t WS_S5A = 4 * MiB;
constexpr size_t WS_S5BB = 4 * MiB + 65536;
constexpr size_t WS_S5CT = 4 * MiB + 65536 + 262144;
constexpr size_t WS_W1F = 4 * MiB + 65536 + 262144 + 131072;
constexpr size_t WS_W0IN = 6 * MiB, WS_W0OUT = 12 * MiB, WS_WGU0 = 14 * MiB, WS_WDN0 = 25 * MiB, WS_W1IN = 31 * MiB, WS_WGLU = 35 * MiB, WS_W1OUT = 36 * MiB, WS_WGU1 = 38 * MiB, WS_WDN1 = 49 * MiB;
constexpr size_t WS_H = 56 * MiB;
constexpr size_t WS_HB = 188 * MiB;
constexpr size_t WS_QKV = 254 * MiB;
constexpr size_t WS_Y = 386 * MiB;
constexpr size_t WS_E = 419 * MiB;
constexpr size_t WS_END = 452 * MiB;
constexpr size_t DO_CAT = 0, DO_STASH = 66 * MiB;

typedef unsigned short bf16_t;
typedef short bf16x8 __attribute__((ext_vector_type(8)));
typedef float f32x4 __attribute__((ext_vector_type(4)));
typedef float f32x16 __attribute__((ext_vector_type(16)));
typedef unsigned u32x4 __attribute__((ext_vector_type(4)));
typedef unsigned u32x2 __attribute__((ext_vector_type(2)));
typedef short v4i16_t __attribute__((ext_vector_type(4)));

__device__ __forceinline__ unsigned f2bf(float f) { unsigned u = __builtin_bit_cast(unsigned, f); return (u + 0x7fffu + ((u >> 16) & 1u)) >> 16; }
__device__ __forceinline__ unsigned pk2(float lo, float hi) { return f2bf(lo) | (f2bf(hi) << 16); }
__device__ __forceinline__ float bf2f(unsigned short b) { return __builtin_bit_cast(float, (unsigned)b << 16); }
__device__ __forceinline__ float bflo(unsigned w) { return __builtin_bit_cast(float, w << 16); }
__device__ __forceinline__ float bfhi(unsigned w) { return __builtin_bit_cast(float, w & 0xffff0000u); }
__device__ __forceinline__ float wave_sum(float v) {
#pragma unroll
    for (int o = 32; o >= 1; o >>= 1) v += __shfl_xor(v, o);
    return v;
}
__device__ __forceinline__ float fexp2(float x) { return __builtin_amdgcn_exp2f(x); }
__device__ __forceinline__ float flog2(float x) { return __builtin_amdgcn_logf(x); }
namespace pg8 {
#define PG8_LAS __attribute__((address_space(3)))
typedef unsigned short bf16_t;
typedef short bf16x8 __attribute__((ext_vector_type(8)));
typedef float f32x4 __attribute__((ext_vector_type(4)));
typedef unsigned u32x4 __attribute__((ext_vector_type(4)));
constexpr int BM = 256, BK = 64, HALF = 128, HTB = HALF * BK * 2  , STAGE_BYTES = 8 * HTB, NXCD = 8, WGM = 8;

__host__ __device__ __forceinline__ int lds_byte(int r, int c) { const int st = (r >> 4) * 2 + (c >> 5), rr = r & 15, cc = c & 31, ob = rr * 64 + cc * 2; return st * 1024 + (ob ^ (((ob >> 9) & 1) << 5)); }
__host__ __device__ __forceinline__ void stage_rc(int b, int& R, int& C) { const int st = b / 1024, sb = b % 1024, swz = sb ^ (((sb >> 9) & 1) << 5); R = (st >> 1) * 16 + swz / 64; C = (st & 1) * 32 + (swz % 64) / 2; }
__host__ __device__ __forceinline__ int perm32(int rho) { const int n = rho >> 4, i = rho & 15; return 8 * (i >> 2) + 4 * n + (i & 3); }

struct Unit { int pm, pn; };
struct Gemm { const bf16_t* A; const bf16_t* Bt; int M, N, K; };

struct StaticOrder {
    int nM, nN, nwg, G, c;
    __host__ __device__ void init(int M, int N, int G_, int c_) { nM = M / BM; nN = N / BM; nwg = nM * nN; G = G_; c = c_; }
    __host__ __device__ bool next(int i, Unit& u) const {
        const long L = (long)i * G + c; if (L >= nwg) return false;
        int wgid = (int)L; { const int q = nwg / NXCD, r = nwg % NXCD, xcd = wgid % NXCD, off = wgid / NXCD; wgid = (xcd < r ? xcd * (q + 1) : r * (q + 1) + (xcd - r) * q) + off; }
        const int nig = WGM * nN, gid = wgid / nig, fm = gid * WGM, gsz = (nM - fm) < WGM ? (nM - fm) : WGM;
        u.pm = fm + ((wgid % nig) % gsz); u.pn = (wgid % nig) / gsz; return true;
    }
    __device__ __forceinline__ void a_ready(const Unit&) const {}
    __device__ __forceinline__ void done(const Unit&) const {}
};
__device__ __forceinline__ unsigned cvt_pk_bf16(float lo, float hi) { unsigned r; asm volatile("v_cvt_pk_bf16_f32 %0, %1, %2" : "=v"(r) : "v"(lo), "v"(hi)); return r; }
typedef float f32x2 __attribute__((ext_vector_type(2)));
struct EpiScaleBf16 {
    static constexpr bool PERM = true, AFTER_DRAIN = false;
    bf16_t* O; int ldc; const float* ssq;
    __device__ __forceinline__ void operator()(const f32x4 (&acc)[2][2][4][2], const Unit& u, int wr, int wc, int fr, int fq) const {
        const int col0 = u.pn * BM + wc * 32 + 8 * fq;
#pragma unroll
        for (int ai = 0; ai < 2; ++ai)
#pragma unroll
            for (int m = 0; m < 4; ++m) {
                const int row = u.pm * BM + ai * HALF + wr * 64 + m * 16 + fr;
                const float rs = __builtin_amdgcn_rsqf(__hip_atomic_load(ssq + row, __ATOMIC_RELAXED, __HIP_MEMORY_SCOPE_AGENT) * (1.0f / 1024.0f) + 1e-6f);
                bf16_t* rowp = O + (size_t)row * ldc + col0;
#pragma unroll
                for (int bj = 0; bj < 2; ++bj) { const f32x4 v0 = acc[ai][bj][m][0] * rs, v1 = acc[ai][bj][m][1] * rs;
                    u32x4 w; w.x = cvt_pk_bf16(v0[0], v0[1]); w.y = cvt_pk_bf16(v0[2], v0[3]); w.z = cvt_pk_bf16(v1[0], v1[1]); w.w = cvt_pk_bf16(v1[2], v1[3]);
                    *(u32x4*)(rowp + bj * HALF) = w; } }
    }
};
struct EpiResid {
    static constexpr bool PERM = true, AFTER_DRAIN = false;
    float* h; bf16_t* hb; float* ssq;
    __device__ __forceinline__ void operator()(const f32x4 (&acc)[2][2][4][2], const Unit& u, int wr, int wc, int fr, int fq) const {
        const int col0 = u.pn * BM + wc * 32 + 8 * fq;
#pragma unroll
        for (int ai = 0; ai < 2; ++ai)
#pragma unroll
            for (int m = 0; m < 4; ++m) {
                const int row = u.pm * BM + ai * HALF + wr * 64 + m * 16 + fr;
                const bool valid = (row % 8448) >= 240;
                float ss = 0.f;
#pragma unroll
                for (int bj = 0; bj < 2; ++bj) {
                    float* hp = h + (size_t)row * 1024 + col0 + bj * HALF;
                    f32x4 v0 = *(const f32x4*)hp + acc[ai][bj][m][0], v1 = *(const f32x4*)(hp + 4) + acc[ai][bj][m][1];
                    if (!valid) { v0 = (f32x4){0.f, 0.f, 0.f, 0.f}; v1 = v0; }
                    *(f32x4*)hp = v0; *(f32x4*)(hp + 4) = v1;
                    u32x4 w; w.x = cvt_pk_bf16(v0[0], v0[1]); w.y = cvt_pk_bf16(v0[2], v0[3]); w.z = cvt_pk_bf16(v1[0], v1[1]); w.w = cvt_pk_bf16(v1[2], v1[3]);
                    *(u32x4*)(hb + (size_t)row * 1024 + col0 + bj * HALF) = w;
                    ss += (v0[0] * v0[0] + v0[1] * v0[1]) + (v0[2] * v0[2] + v0[3] * v0[3]) + (v1[0] * v1[0] + v1[1] * v1[1]) + (v1[2] * v1[2] + v1[3] * v1[3]);
                }
                ss += __shfl_xor(ss, 16); ss += __shfl_xor(ss, 32);
                if (fq == 0 && ssq) atomicAdd(ssq + row, ss);
            }
    }
};
struct EpiSwiGLU {
    static constexpr bool PERM = true, AFTER_DRAIN = false;
    bf16_t* O; const float* ssq;
    __device__ __forceinline__ void operator()(const f32x4 (&acc)[2][2][4][2], const Unit& u, int wr, int wc, int fr, int fq) const {
        const int col0 = u.pn * BM + wc * 32 + 8 * fq;
#pragma unroll
        for (int ai = 0; ai < 2; ++ai)
#pragma unroll
            for (int m = 0; m < 4; ++m) {
                const int row = u.pm * BM + ai * HALF + wr * 64 + m * 16 + fr;
                const float rs = __builtin_amdgcn_rsqf(__hip_atomic_load(ssq + row, __ATOMIC_RELAXED, __HIP_MEMORY_SCOPE_AGENT) * (1.0f / 1024.0f) + 1e-6f);
#pragma unroll
                for (int bj = 0; bj < 2; ++bj) { const f32x4 g = acc[ai][bj][m][0] * rs, up = acc[ai][bj][m][1] * rs; float a[4];
#pragma unroll
                    for (int e = 0; e < 4; ++e) a[e] = g[e] * __builtin_amdgcn_rcpf(1.0f + __builtin_amdgcn_exp2f(-1.4426950408889634f * g[e])) * up[e];
                    u32x2 w; w.x = cvt_pk_bf16(a[0], a[1]); w.y = cvt_pk_bf16(a[2], a[3]);
                    *(u32x2*)(O + (size_t)row * 2816 + ((col0 + bj * HALF) >> 1)) = w; } }
    }
};
struct EpiGLU {
    static constexpr bool PERM = true, AFTER_DRAIN = false;
    const bf16_t* Y; const float* bias; bf16_t* O;
    __device__ __forceinline__ void operator()(const f32x4 (&acc)[2][2][4][2], const Unit& u, int wr, int wc, int fr, int fq) const {
        const int col0 = u.pn * BM + wc * 32 + 8 * fq;
#pragma unroll
        for (int ai = 0; ai < 2; ++ai)
#pragma unroll
            for (int m = 0; m < 4; ++m) {
                const int row = u.pm * BM + ai * HALF + wr * 64 + m * 16 + fr;
#pragma unroll
                for (int bj = 0; bj < 2; ++bj) { const int col = col0 + bj * HALF;
                    const u32x4 yv = *(const u32x4*)(Y + (size_t)row * 512 + col);
                    const f32x4 b0 = *(const f32x4*)(bias + col), b1 = *(const f32x4*)(bias + col + 4);
                    const f32x4 z0 = acc[ai][bj][m][0] + b0, z1 = acc[ai][bj][m][1] + b1; float o[8];
                    const float yy[8] = {__builtin_bit_cast(float, yv.x << 16), __builtin_bit_cast(float, yv.x & 0xffff0000u), __builtin_bit_cast(float, yv.y << 16), __builtin_bit_cast(float, yv.y & 0xffff0000u),
                                         __builtin_bit_cast(float, yv.z << 16), __builtin_bit_cast(float, yv.z & 0xffff0000u), __builtin_bit_cast(float, yv.w << 16), __builtin_bit_cast(float, yv.w & 0xffff0000u)};
#pragma unroll
                    for (int e = 0; e < 4; ++e) { o[e] = yy[e] * __builtin_amdgcn_rcpf(1.0f + __builtin_amdgcn_exp2f(-1.4426950408889634f * z0[e])); o[4 + e] = yy[4 + e] * __builtin_amdgcn_rcpf(1.0f + __builtin_amdgcn_exp2f(-1.4426950408889634f * z1[e])); }
                    u32x4 w; w.x = cvt_pk_bf16(o[0], o[1]); w.y = cvt_pk_bf16(o[2], o[3]); w.z = cvt_pk_bf16(o[4], o[5]); w.w = cvt_pk_bf16(o[6], o[7]);
                    *(u32x4*)(O + (size_t)row * 1024 + 512 + col) = w; } }
    }
};
template <class Epi, class Sched, bool ALIGN_EPI = false, bool SP2 = false>
__device__ __forceinline__ void gemm_phase(PG8_LAS unsigned char* lds, const Gemm g, const Sched& S, const Epi& E) {
    int tid_l = threadIdx.x; asm volatile("" : "+v"(tid_l));
    const int tid = tid_l, wid = __builtin_amdgcn_readfirstlane(tid >> 6), lane = tid & 63, wr = wid >> 2, wc = wid & 3, fr = lane & 15, fq = lane >> 4;
    const int K = g.K, nt = K / BK;
    unsigned voffA[2], voffB[2];
#pragma unroll
    for (int i = 0; i < 2; ++i) { int R, C; stage_rc(tid * 16 + i * 8192, R, C); const int Rb = Epi::PERM ? ((R & ~31) + perm32(R & 31)) : R;
        voffA[i] = (unsigned)(R * K + C) * 2u; voffB[i] = (unsigned)(Rb * K + C) * 2u; }
    const size_t kstep = (size_t)(BK * 2);
    const size_t hstep = (size_t)HALF * K * 2;
    const size_t tstep = 2 * hstep;
    const unsigned ldsw = (unsigned)wid * 1024u;
    const int aoff = lds_byte(wr * 64 + fr, fq * 8), boff = lds_byte(wc * 32 + fr, fq * 8);
#define PG8_SA(b, h) (((b) * 2 + (h)) * HTB)
#define PG8_SB(b, h) ((4 + (b) * 2 + (h)) * HTB)
#define PG8_STAGE(bufoff, gbase, voff) do { _Pragma("unroll") for (int _i = 0; _i < 2; ++_i) \
        __builtin_amdgcn_global_load_lds((const unsigned*)((const char*)(gbase) + (voff)[_i]), (PG8_LAS unsigned*)(lds + (bufoff) + ldsw + _i * 8192), 16, 0, 0); } while (0)
#define PG8_LDA(dst, b, h) do { _Pragma("unroll") for (int m = 0; m < 4; ++m) _Pragma("unroll") for (int k = 0; k < 2; ++k) dst[m][k] = *(const PG8_LAS bf16x8*)(lds + PG8_SA(b, h) + aoff + m * 2048 + k * 1024); } while (0)
#define PG8_LDB(dst, b, h) do { _Pragma("unroll") for (int n = 0; n < 2; ++n) _Pragma("unroll") for (int k = 0; k < 2; ++k) dst[n][k] = *(const PG8_LAS bf16x8*)(lds + PG8_SB(b, h) + boff + n * 2048 + k * 1024); } while (0)
#define PG8_MMA(ai, bj, At, Bt) do { __builtin_amdgcn_s_setprio(1); _Pragma("unroll") for (int m = 0; m < 4; ++m) _Pragma("unroll") for (int n = 0; n < 2; ++n) _Pragma("unroll") for (int k = 0; k < 2; ++k) \
        acc[ai][bj][m][n] = __builtin_amdgcn_mfma_f32_16x16x32_bf16(Bt[n][k], At[m][k], acc[ai][bj][m][n], 0, 0, 0); __builtin_amdgcn_s_setprio(0); } while (0)
#define PG8_WAIT_V(n) asm volatile("s_waitcnt vmcnt(" #n ")" ::: "memory")
#define PG8_WAIT_L(n) asm volatile("s_waitcnt lgkmcnt(" #n ")" ::: "memory")
#define PG8_BAR __builtin_amdgcn_s_barrier()
#define PG8_SCHED __builtin_amdgcn_sched_barrier(0)
    Unit cur, nxt; int ui = 0;
    if (!S.next(0, cur)) return;
    f32x4 acc[2][2][4][2];
#pragma unroll
    for (int a = 0; a < 2; ++a)
#pragma unroll
        for (int b = 0; b < 2; ++b)
#pragma unroll
            for (int m = 0; m < 4; ++m)
#pragma unroll
                for (int n = 0; n < 2; ++n) acc[a][b][m][n] = (f32x4){0.f, 0.f, 0.f, 0.f};
    bf16x8 At[4][2], B0[2][2], B1[2][2];
    const char* cA = (const char*)g.A + (size_t)cur.pm * tstep; const char* cB = (const char*)g.Bt + (size_t)cur.pn * tstep;
    S.a_ready(cur);
    if constexpr (SP2) {
        PG8_STAGE(PG8_SB(0, 0), cB, voffB); PG8_STAGE(PG8_SB(0, 1), cB + hstep, voffB); PG8_STAGE(PG8_SA(0, 0), cA, voffA); PG8_STAGE(PG8_SA(0, 1), cA + hstep, voffA);
        if (wr == 1) PG8_BAR;
        PG8_WAIT_V(2); PG8_BAR;
        PG8_STAGE(PG8_SB(1, 0), cB + kstep, voffB); PG8_STAGE(PG8_SA(1, 0), cA + kstep, voffA); PG8_STAGE(PG8_SB(1, 1), cB + hstep + kstep, voffB);
        PG8_WAIT_V(6); PG8_BAR;
    } else {
        PG8_STAGE(PG8_SB(0, 0), cB, voffB); PG8_STAGE(PG8_SA(0, 0), cA, voffA); PG8_STAGE(PG8_SB(0, 1), cB + hstep, voffB); PG8_STAGE(PG8_SA(0, 1), cA + hstep, voffA);
        if (wr == 1) PG8_BAR;
        PG8_WAIT_V(4); PG8_BAR;
        PG8_STAGE(PG8_SB(1, 0), cB + kstep, voffB); PG8_STAGE(PG8_SA(1, 0), cA + kstep, voffA); PG8_STAGE(PG8_SB(1, 1), cB + hstep + kstep, voffB);
        PG8_WAIT_V(6); PG8_BAR;
    }
    for (;;) {
        const bool has_next = S.next(ui + 1, nxt);
        const char* nA = has_next ? (const char*)g.A + (size_t)nxt.pm * tstep : cA; const char* nB = has_next ? (const char*)g.Bt + (size_t)nxt.pn * tstep : cB;
        for (int t = 0; t < nt; t += 2) {
            const bool last = (t == nt - 2);
            const char* a1 = cA + (size_t)(t + 1) * kstep;
            const char* a2 = last ? nA : cA + (size_t)(t + 2) * kstep; const char* b2 = last ? nB : cB + (size_t)(t + 2) * kstep;
            const char* a3 = a2 + kstep; const char* b3 = b2 + kstep;
            if (last && has_next) S.a_ready(nxt);
            if constexpr (SP2) {
            PG8_LDB(B0, 0, 0); PG8_LDB(B1, 0, 1); PG8_SCHED; PG8_LDA(At, 0, 0); PG8_STAGE(PG8_SA(1, 1), a1 + hstep, voffA);
            PG8_WAIT_V(8); PG8_WAIT_L(0); PG8_BAR; PG8_MMA(0, 0, At, B0); PG8_MMA(0, 1, At, B1); PG8_BAR; PG8_SCHED;
            PG8_LDA(At, 0, 1); PG8_STAGE(PG8_SB(0, 0), b2, voffB); PG8_STAGE(PG8_SB(0, 1), b2 + hstep, voffB); PG8_STAGE(PG8_SA(0, 0), a2, voffA);
            PG8_WAIT_V(8); PG8_WAIT_L(0); PG8_BAR; PG8_MMA(1, 0, At, B0); PG8_MMA(1, 1, At, B1); PG8_BAR; PG8_SCHED;
            PG8_LDB(B0, 1, 0); PG8_LDB(B1, 1, 1); PG8_SCHED; PG8_LDA(At, 1, 0); PG8_STAGE(PG8_SA(0, 1), a2 + hstep, voffA);
            PG8_WAIT_V(8); PG8_WAIT_L(0); PG8_BAR; PG8_MMA(0, 0, At, B0); PG8_MMA(0, 1, At, B1); PG8_BAR; PG8_SCHED;
            PG8_LDA(At, 1, 1); PG8_STAGE(PG8_SB(1, 0), b3, voffB); PG8_STAGE(PG8_SB(1, 1), b3 + hstep, voffB); PG8_STAGE(PG8_SA(1, 0), a3, voffA);
            PG8_WAIT_V(8); PG8_WAIT_L(0); PG8_BAR; PG8_MMA(1, 0, At, B0); PG8_MMA(1, 1, At, B1); PG8_BAR; PG8_SCHED;
            } else {
            PG8_LDB(B0, 0, 0); PG8_SCHED; PG8_LDA(At, 0, 0); PG8_STAGE(PG8_SA(1, 1), a1 + hstep, voffA);
            PG8_WAIT_L(8); PG8_BAR; PG8_WAIT_L(0); PG8_MMA(0, 0, At, B0); PG8_BAR; PG8_SCHED;
            PG8_LDB(B1, 0, 1); PG8_STAGE(PG8_SB(0, 0), b2, voffB);
            PG8_BAR; PG8_WAIT_L(0); PG8_MMA(0, 1, At, B1); PG8_BAR;
            PG8_LDA(At, 0, 1); PG8_STAGE(PG8_SA(0, 0), a2, voffA);
            PG8_BAR; PG8_WAIT_L(0); PG8_MMA(1, 0, At, B0); PG8_BAR; PG8_SCHED;
            PG8_STAGE(PG8_SB(0, 1), b2 + hstep, voffB);
            PG8_WAIT_V(6); PG8_BAR; PG8_MMA(1, 1, At, B1); PG8_BAR;
            PG8_LDB(B0, 1, 0); PG8_SCHED; PG8_LDA(At, 1, 0); PG8_STAGE(PG8_SA(0, 1), a2 + hstep, voffA);
            PG8_WAIT_L(8); PG8_BAR; PG8_WAIT_L(0); PG8_MMA(0, 0, At, B0); PG8_BAR; PG8_SCHED;
            PG8_LDB(B1, 1, 1); PG8_STAGE(PG8_SB(1, 0), b3, voffB);
            PG8_BAR; PG8_WAIT_L(0); PG8_MMA(0, 1, At, B1); PG8_BAR;
            PG8_LDA(At, 1, 1); PG8_STAGE(PG8_SA(1, 0), a3, voffA);
            PG8_BAR; PG8_WAIT_L(0); PG8_MMA(1, 0, At, B0); PG8_BAR; PG8_SCHED;
            PG8_STAGE(PG8_SB(1, 1), b3 + hstep, voffB);
            PG8_WAIT_V(6); PG8_BAR; PG8_MMA(1, 1, At, B1); PG8_BAR;
            }
        }
        if constexpr (ALIGN_EPI) { if (wr == 0) PG8_BAR; }
        if constexpr (!Epi::AFTER_DRAIN) { E(acc, cur, wr, wc, fr, fq); S.done(cur); }
        if (!has_next) break;
#pragma unroll
        for (int a = 0; a < 2; ++a)
#pragma unroll
            for (int b = 0; b < 2; ++b)
#pragma unroll
                for (int m = 0; m < 4; ++m)
#pragma unroll
                    for (int n = 0; n < 2; ++n) acc[a][b][m][n] = (f32x4){0.f, 0.f, 0.f, 0.f};
        cur = nxt; cA = nA; cB = nB; ++ui;
        if constexpr (ALIGN_EPI) { if (wr == 1) PG8_BAR; }
    }
    PG8_WAIT_V(0);
    if constexpr (!ALIGN_EPI) { if (wr == 0) PG8_BAR; }
    PG8_BAR;
    if constexpr (Epi::AFTER_DRAIN) { E.fused(acc, cur, wr, wc, fr, fq, lds, wid, lane); S.done(cur); }
#undef PG8_SA
#undef PG8_SB
#undef PG8_STAGE
#undef PG8_LDA
#undef PG8_LDB
#undef PG8_MMA
#undef PG8_WAIT_V
#undef PG8_WAIT_L
#undef PG8_BAR
#undef PG8_SCHED
}
}
namespace att {
constexpr int KROW = 144, KBUF = 64 * KROW;
constexpr int VBUF = 16384;
constexpr int L_K = 0, L_V = 2 * KBUF, L_BIAS = L_V + 2 * VBUF, L_FLAG = L_BIAS + 2 * 64 * 4, L_MISC = L_FLAG + 64, L_END = L_MISC + 64;
__device__ __forceinline__ int crow(int r, int hi) { return (r & 3) + 8 * (r >> 2) + 4 * hi; }
__device__ __forceinline__ unsigned cvtpk(float lo, float hi) { unsigned r; asm volatile("v_cvt_pk_bf16_f32 %0, %1, %2" : "=v"(r) : "v"(lo), "v"(hi)); return r; }

struct Args { const bf16_t* qkv; int pitch; int rowb; int u; int qcol, kcol, vcol; const float* F; };

template <int MODE, int NDV, bool BIAS>
__device__ __forceinline__ void run(LAS unsigned char* lds, const Args& a, f32x16 (&o)[NDV], float& l_out) {
    int tid_l = threadIdx.x; asm volatile("" : "+v"(tid_l));
    const int tid = tid_l, lane = tid & 63, w = __builtin_amdgcn_readfirstlane(tid >> 6), r32 = lane & 31, hi = lane >> 5;
    const int qmin = 256 * a.u + 32 * w, qpos = qmin + r32;
    constexpr int NV = NDV / 2;
    bf16x8 qf[4];
    { const bf16_t* qp = a.qkv + (size_t)(a.rowb + qpos) * a.pitch + a.qcol + 8 * hi;
#pragma unroll
      for (int d0 = 0; d0 < 4; ++d0) qf[d0] = *(const bf16x8*)(qp + 16 * d0); }
    const int kr = tid >> 3, kc = tid & 7;
    const bf16_t* kg = a.qkv + (size_t)(a.rowb + kr) * a.pitch + a.kcol + 8 * kc;
    const unsigned klds = kr * KROW + kc * 16;
    const bf16_t* vg[NV]; unsigned vlds[NV];
#pragma unroll
    for (int j = 0; j < NV; ++j) {
        int vr, ch; if (NDV == 2) { vr = tid >> 3; ch = tid & 7; } else { vr = (tid >> 4) + 32 * j; ch = tid & 15; }
        vg[j] = a.qkv + (size_t)(a.rowb + vr) * a.pitch + a.vcol + 8 * ch;
        vlds[j] = (vr >> 3) * (NDV * 512) + (ch >> 2) * 512 + (vr & 7) * 64 + (ch & 3) * 16;
    }
    const size_t tstride = (size_t)64 * a.pitch;
    float fq0 = 0.f; if (BIAS) fq0 = a.F[256 * a.u];
    const int ntile = 4 * a.u + 1;
#define ATT_TILE(i) (MODE == 0 ? (4 * a.u + 3 - (i)) : (3 + (i)))
    u32x4 kreg, vreg[NV]; float breg = 0.f;
#define ATT_LOAD(kt) do { kreg = *(const u32x4*)(kg + (size_t)(kt) * tstride); _Pragma("unroll") for (int j_ = 0; j_ < NV; ++j_) vreg[j_] = *(const u32x4*)(vg[j_] + (size_t)(kt) * tstride); \
        if (BIAS) { if (tid < 64) breg = (fq0 - a.F[64 * (kt) + tid]) * LOG2E; } } while (0)
#define ATT_WRITE(b) do { *(LAS u32x4*)(lds + L_K + (b) * KBUF + klds) = kreg; _Pragma("unroll") for (int j_ = 0; j_ < NV; ++j_) *(LAS u32x4*)(lds + L_V + (b) * VBUF + vlds[j_]) = vreg[j_]; \
        if (BIAS) { if (tid < 64) *(LAS float*)(lds + L_BIAS + (b) * 256 + tid * 4) = breg; } } while (0)
#pragma unroll
    for (int c = 0; c < NDV; ++c)
#pragma unroll
        for (int r = 0; r < 16; ++r) o[c][r] = 0.f;
    float mrun = -1e30f, lrun = 0.f, carry = 0.f;
    const unsigned vlane = 64 * (4 * hi + ((lane & 15) >> 2)) + 32 * ((lane >> 4) & 1) + 8 * (lane & 3);
    ATT_LOAD(ATT_TILE(0)); ATT_WRITE(0);
    __syncthreads();
    for (int i = 0; i < ntile; ++i) {
        const int kt = ATT_TILE(i), buf = i & 1;
        if (i + 1 < ntile) ATT_LOAD(ATT_TILE(i + 1));
        const int tlo = 64 * kt;
        const bool skip = (MODE == 0) ? (tlo >= qmin + 31) : (tlo > qmin + 31);
        if (!skip) {
            const bool needmask = (kt == 3) || ((MODE == 0) ? (tlo + 63 >= qmin) : (tlo + 63 > qmin));
            const LAS unsigned char* kb = lds + L_K + buf * KBUF + r32 * KROW + 16 * hi;
            f32x16 x[2];
#pragma unroll
            for (int xt = 0; xt < 2; ++xt) {
                if (BIAS) {
                    const LAS float* bp = (const LAS float*)(lds + L_BIAS + buf * 256) + 32 * xt + 4 * hi;
#pragma unroll
                    for (int g = 0; g < 4; ++g) { const f32x4 bv = *(const LAS f32x4*)(bp + 8 * g); x[xt][4 * g] = bv[0]; x[xt][4 * g + 1] = bv[1]; x[xt][4 * g + 2] = bv[2]; x[xt][4 * g + 3] = bv[3]; }
                } else {
#pragma unroll
                    for (int r = 0; r < 16; ++r) x[xt][r] = 0.f;
                }
#pragma unroll
                for (int d0 = 0; d0 < 4; ++d0) { const bf16x8 kf = *(const LAS bf16x8*)(kb + xt * 32 * KROW + 32 * d0); x[xt] = __builtin_amdgcn_mfma_f32_32x32x16_bf16(kf, qf[d0], x[xt], 0, 0, 0); }
            }
            unsigned pk[4][4];
            if (MODE == 1) {
                if (needmask) {
#pragma unroll
                    for (int xt = 0; xt < 2; ++xt)
#pragma unroll
                        for (int r = 0; r < 16; ++r) { const int kvp = tlo + 32 * xt + crow(r, hi); if (kvp > qpos || kvp < PADR) x[xt][r] = -1e30f; }
                }
                float mx = x[0][0];
#pragma unroll
                for (int r = 1; r < 16; ++r) mx = fmaxf(mx, x[0][r]);
#pragma unroll
                for (int r = 0; r < 16; ++r) mx = fmaxf(mx, x[1][r]);
                mx = fmaxf(mx, __shfl_xor(mx, 32));
                const float mnew = fmaxf(mrun, mx), alpha = fexp2(mrun - mnew); mrun = mnew;
                float ps = 0.f;
#pragma unroll
                for (int xt = 0; xt < 2; ++xt)
#pragma unroll
                    for (int r = 0; r < 16; ++r) { const float pv = fexp2(x[xt][r] - mnew); x[xt][r] = pv; ps += pv; }
                lrun = lrun * alpha + ps;
                if (__any(alpha != 1.0f)) {
#pragma unroll
                    for (int c = 0; c < NDV; ++c)
#pragma unroll
                        for (int r = 0; r < 16; ++r) o[c][r] *= alpha;
                }
            } else {
#pragma unroll
                for (int xt = 1; xt >= 0; --xt) {
                    float lm[16], G[4], Gp[4];
#pragma unroll
                    for (int r = 0; r < 16; ++r) {
                        const float z = x[xt][r], sp = fmaxf(z, 0.f) + flog2(1.0f + fexp2(-fabsf(z)));
                        bool valid = true;
                        if (needmask) { const int kvp = tlo + 32 * xt + crow(r, hi); valid = (kvp < qpos) && (kvp >= PADR); }
                        lm[r] = valid ? -sp : 0.f;
                        x[xt][r] = valid ? (z - sp) : -1e30f;
                    }
#pragma unroll
                    for (int g = 0; g < 4; ++g) { G[g] = (lm[4 * g] + lm[4 * g + 1]) + (lm[4 * g + 2] + lm[4 * g + 3]); Gp[g] = __shfl_xor(G[g], 32); }
                    float runv = carry;
#pragma unroll
                    for (int g = 3; g >= 0; --g) {
                        const float g1 = hi ? G[g] : Gp[g], g0 = hi ? Gp[g] : G[g];
                        const float sg = hi ? runv : (runv + g1);
                        const float c3 = sg, c2 = c3 + lm[4 * g + 3], c1 = c2 + lm[4 * g + 2], c0 = c1 + lm[4 * g + 1];
                        x[xt][4 * g + 3] = fexp2(x[xt][4 * g + 3] + c3); x[xt][4 * g + 2] = fexp2(x[xt][4 * g + 2] + c2);
                        x[xt][4 * g + 1] = fexp2(x[xt][4 * g + 1] + c1); x[xt][4 * g] = fexp2(x[xt][4 * g] + c0);
                        runv = runv + (g1 + g0);
                    }
                    carry = runv;
                }
            }
#pragma unroll
            for (int ks = 0; ks < 4; ++ks)
#pragma unroll
                for (int j = 0; j < 4; ++j) pk[ks][j] = cvtpk(x[ks >> 1][8 * (ks & 1) + 2 * j], x[ks >> 1][8 * (ks & 1) + 2 * j + 1]);
            const LAS unsigned char* vb = lds + L_V + buf * VBUF + vlane;
#pragma unroll
            for (int ks = 0; ks < 4; ++ks) {
                asm volatile("" ::: "memory");
                bf16x8 pb; { u32x4 t4 = {pk[ks][0], pk[ks][1], pk[ks][2], pk[ks][3]}; pb = __builtin_bit_cast(bf16x8, t4); }
#pragma unroll
                for (int c = 0; c < NDV; ++c) {
                    const v4i16_t lo = __builtin_amdgcn_ds_read_tr16_b64_v4i16((LAS v4i16_t*)(vb + (2 * ks) * (NDV * 512) + 512 * c));
                    const v4i16_t hh = __builtin_amdgcn_ds_read_tr16_b64_v4i16((LAS v4i16_t*)(vb + (2 * ks + 1) * (NDV * 512) + 512 * c));
                    const bf16x8 va = {lo[0], lo[1], lo[2], lo[3], hh[0], hh[1], hh[2], hh[3]};
                    o[c] = __builtin_amdgcn_mfma_f32_32x32x16_bf16(va, pb, o[c], 0, 0, 0);
                }
            }
        }
        if (MODE == 0) { const int ok = __all(carry < -160.0f) ? 1 : 0; if (lane == 0) *(LAS int*)(lds + L_FLAG + (buf * 8 + w) * 4) = ok; }
        if (i + 1 < ntile) ATT_WRITE(buf ^ 1);
        __syncthreads();
        if (MODE == 0) {
            const LAS int* fl = (const LAS int*)(lds + L_FLAG + buf * 32);
            const int all = fl[0] & fl[1] & fl[2] & fl[3] & fl[4] & fl[5] & fl[6] & fl[7];
            if (all) break;
        }
    }
    __syncthreads();
    l_out = lrun + __shfl_xor(lrun, 32);
#undef ATT_TILE
#undef ATT_LOAD
#undef ATT_WRITE
}
}
struct Params { const float* in[27]; float* out; unsigned char* ws; int ph_lo, ph_hi; };

__device__ __forceinline__ float log_sigmoid_f(float x) { return -(fmaxf(-x, 0.f) + log1pf(expf(-fabsf(x)))); }
__device__ __forceinline__ float gelu_tanh_f(float x) { const float z = 0.7978845608028654f * (x + 0.044715f * x * x * x); const float t = 1.0f - 2.0f / (__expf(2.0f * z) + 1.0f); return 0.5f * x * (1.0f + t); }

__device__ __forceinline__ void map_col(int kind, int n, int& dr, float& sc) {
    sc = 1.0f; dr = n;
    if (kind == 1) { if (n < 512 || (n >= 1536 && n < 2048)) sc = C2; }
    else if (kind == 2) { if (n < 512) sc = C2; else if (n >= 1536 && n < 1544) dr = -1; else if (n >= 1544) dr = n - 8; }
    else if (kind == 3) { if (n < 2816) dr = 8 * (n >> 2) + (n & 3); else { const int j = n - 2816; dr = 8 * (j >> 2) + 4 + (j & 3); } }
}
__device__ __forceinline__ void transpose_item(const float* W, int K, int N, const float* gk, bf16_t* WT, int kind, LAS float* scr, int item, int lane) {
    const int nblk = (N + 31) / 32, kb = item / nblk, nb = item % nblk, k0 = 64 * kb, n0 = 32 * nb;
#pragma unroll 8
    for (int i = 0; i < 32; ++i) { const int kk = 2 * i + (lane >> 5), n = n0 + (lane & 31);
        float v = 0.f; if (n < N) { v = W[(size_t)(k0 + kk) * N + n]; if (gk) v *= gk[k0 + kk]; }
        scr[kk * 33 + (lane & 31)] = v; }
    asm volatile("s_waitcnt lgkmcnt(0)" ::: "memory");
    const int c = lane & 7;
#pragma unroll
    for (int j = 0; j < 4; ++j) { const int nl = (lane >> 3) + 8 * j, n = n0 + nl;
        if (n < N) { int dr; float sc; map_col(kind, n, dr, sc);
            if (dr >= 0) { const LAS float* s = scr + (8 * c) * 33 + nl;
                u32x4 o; o.x = pk2(s[0 * 33] * sc, s[1 * 33] * sc); o.y = pk2(s[2 * 33] * sc, s[3 * 33] * sc); o.z = pk2(s[4 * 33] * sc, s[5 * 33] * sc); o.w = pk2(s[6 * 33] * sc, s[7 * 33] * sc);
                *(u32x4*)(WT + (size_t)dr * K + k0 + 8 * c) = o; } } }
    asm volatile("s_waitcnt lgkmcnt(0)" ::: "memory");
}

template <bool FINAL>
__device__ __forceinline__ void s5_item(const Params& p, LAS unsigned char* wl  , int item, int lane) {
    const int g = item & 31, bc = item >> 5, c = bc % 132, b = bc / 132;
    const unsigned char* ws = p.ws;
    const bf16_t* qkv = (const bf16_t*)(ws + WS_QKV);
    const float* a_re_p = (const float*)(ws + WS_S5A); const float* a_im_p = a_re_p + 2048;
    const float* bbr = (const float*)(ws + WS_S5BB); const float* bbi = bbr + 2048 * 16;
    float2* E = (float2*)(ws + WS_E);
    const int gp = g * 64 + lane;
    const float ar = a_re_p[gp], ai = a_im_p[gp];
    LAS float* ub = (LAS float*)wl;
    { const size_t row = (size_t)b * LP + 64 * c + lane; const u32x4* up = (const u32x4*)(qkv + row * 2048 + 1536 + 16 * g);
      const u32x4 u0 = up[0], u1 = up[1];
      f32x4 f0 = {bflo(u0.x), bfhi(u0.x), bflo(u0.y), bfhi(u0.y)}, f1 = {bflo(u0.z), bfhi(u0.z), bflo(u0.w), bfhi(u0.w)};
      f32x4 f2 = {bflo(u1.x), bfhi(u1.x), bflo(u1.y), bfhi(u1.y)}, f3 = {bflo(u1.z), bfhi(u1.z), bflo(u1.w), bfhi(u1.w)};
      LAS f32x4* ur = (LAS f32x4*)(ub + lane * 16); ur[0] = f0; ur[1] = f1; ur[2] = f2; ur[3] = f3; }
    float br[16], bi[16];
    { const f32x4* pr = (const f32x4*)(bbr + (size_t)gp * 16); const f32x4* pi = (const f32x4*)(bbi + (size_t)gp * 16);
#pragma unroll
      for (int q = 0; q < 4; ++q) { const f32x4 vr = pr[q], vi = pi[q];
#pragma unroll
          for (int e = 0; e < 4; ++e) { br[4 * q + e] = vr[e]; bi[4 * q + e] = vi[e]; } } }
    float xr = 0.f, xi = 0.f;
    if (FINAL) {
        float pr_ = ar, pi_ = ai;
#pragma unroll
        for (int s = 0; s < 6; ++s) { const float nr = pr_ * pr_ - pi_ * pi_, ni = 2.0f * pr_ * pi_; pr_ = nr; pi_ = ni; }
        const float2* Eb = E + ((size_t)b * 132 * 32 + g) * 64 + lane;
        for (int cc = 0; cc < c; ++cc) { const float2 e = Eb[(size_t)cc * 32 * 64]; const float nr = pr_ * xr - pi_ * xi + e.x, ni = pr_ * xi + pi_ * xr + e.y; xr = nr; xi = ni; }
    }
    asm volatile("s_waitcnt lgkmcnt(0)" ::: "memory");
    bf16x8 cf[4];
    float dsk = 0.f;
    if (FINAL) {
        const bf16_t* ct = (const bf16_t*)(ws + WS_S5CT) + ((size_t)g * 16 + (lane & 15)) * 128 + 8 * (lane >> 4);
#pragma unroll
        for (int ks = 0; ks < 4; ++ks) cf[ks] = *(const bf16x8*)(ct + 32 * ks);
        dsk = p.in[22][g * 16 + (lane & 15)];
    }
    LAS bf16_t* X = (LAS bf16_t*)(wl + 4096);
#pragma unroll 1
    for (int sub = 0; sub < 2; ++sub) {
#pragma unroll 4
        for (int tt = 0; tt < 32; ++tt) {
            const LAS f32x4* ur = (const LAS f32x4*)(ub + (32 * sub + tt) * 16);
            float sr = 0.f, si = 0.f;
#pragma unroll
            for (int q = 0; q < 4; ++q) { const f32x4 uv = ur[q];
#pragma unroll
                for (int e = 0; e < 4; ++e) { sr += uv[e] * br[4 * q + e]; si += uv[e] * bi[4 * q + e]; } }
            const float nr = ar * xr - ai * xi + sr, ni = ar * xi + ai * xr + si; xr = nr; xi = ni;
            if (FINAL) { X[tt * 136 + lane] = (bf16_t)f2bf(xr); X[tt * 136 + 64 + lane] = (bf16_t)f2bf(xi); }
        }
        if (FINAL) {
            asm volatile("s_waitcnt lgkmcnt(0)" ::: "memory");
            bf16_t* Y = (bf16_t*)(ws + WS_Y);
#pragma unroll
            for (int mb = 0; mb < 2; ++mb) {
                f32x4 acc = {0.f, 0.f, 0.f, 0.f};
#pragma unroll
                for (int ks = 0; ks < 4; ++ks) { const bf16x8 af = *(const LAS bf16x8*)((const LAS unsigned char*)X + (16 * mb + (lane & 15)) * 272 + 64 * ks + 16 * (lane >> 4));
                    acc = __builtin_amdgcn_mfma_f32_16x16x32_bf16(af, cf[ks], acc, 0, 0, 0); }
#pragma unroll
                for (int i2 = 0; i2 < 4; ++i2) { const int t = 32 * sub + 16 * mb + 4 * (lane >> 4) + i2;
                    const float yv = acc[i2] + dsk * ub[t * 16 + (lane & 15)];
                    Y[((size_t)b * LP + 64 * c + t) * 512 + 16 * g + (lane & 15)] = (bf16_t)f2bf(gelu_tanh_f(yv)); }
            }
            asm volatile("s_waitcnt lgkmcnt(0)" ::: "memory");
        }
    }
    if (!FINAL) E[((size_t)(b * 132 + c) * 32 + g) * 64 + lane] = make_float2(xr, xi);
}
__global__ void __launch_bounds__(NTHR, 2) mega_fwd(Params p) {
    extern __shared__ __attribute__((aligned(16))) unsigned char lds_raw[];
    LAS unsigned char* lds = (LAS unsigned char*)lds_raw;
    cg::grid_group grid = cg::this_grid();
    const int tid = threadIdx.x, lane = tid & 63, wave = __builtin_amdgcn_readfirstlane(tid >> 6);
    const int G = gridDim.x, gw = blockIdx.x * NW + wave, NGW = G * NW;
    unsigned char* ws = p.ws;
    unsigned* ctl = (unsigned*)(ws + WS_CTL);
    float* ssq = (float*)(ws + WS_SSQ);
    float* Fb = (float*)(ws + WS_F);
    float* H = (float*)(ws + WS_H);
    bf16_t* HB = (bf16_t*)(ws + WS_HB);
    bf16_t* QKV = (bf16_t*)(ws + WS_QKV);
    bf16_t* CAT = (bf16_t*)((unsigned char*)p.out + DO_CAT);
    float* STASH = (float*)((unsigned char*)p.out + DO_STASH);
    const int lo = p.ph_lo, hi_ph = p.ph_hi;
#ifndef PHMASK
#define PHMASK 0x3fff
#endif
#define IN(k) (((PHMASK >> (k)) & 1) && lo <= (k) && (k) < hi_ph)
#define SEAM(k) do { if (IN(k) && IN((k) + 1)) grid.sync(); } while (0)

    if (IN(0)) {
        if (blockIdx.x == 0 && tid < 256) ctl[tid] = 0u;
        for (int i = blockIdx.x * NTHR + tid; i < 3 * MROWS; i += G * NTHR) ssq[MROWS + i] = 0.f;
        for (int row = gw; row < MROWS; row += NGW) {
            const int b = row / LP, pos = row % LP;
            f32x4 v[4]; float s = 0.f;
            if (pos < PADR) {
#pragma unroll
                for (int j = 0; j < 4; ++j) v[j] = (f32x4){0.f, 0.f, 0.f, 0.f};
            } else {
                const float* src = (pos < 256) ? (p.in[1] + (size_t)(pos - PADR) * DM) : (p.in[0] + ((size_t)b * SEQ + (pos - 256)) * DM);
#pragma unroll
                for (int j = 0; j < 4; ++j) { v[j] = ((const f32x4*)src)[lane + 64 * j]; s += (v[j][0] * v[j][0] + v[j][1] * v[j][1]) + (v[j][2] * v[j][2] + v[j][3] * v[j][3]); }
            }
            s = wave_sum(s);
#pragma unroll
            for (int j = 0; j < 4; ++j) { ((f32x4*)(H + (size_t)row * DM))[lane + 64 * j] = v[j];
                u32x2 w; w.x = pk2(v[j][0], v[j][1]); w.y = pk2(v[j][2], v[j][3]); ((u32x2*)(HB + (size_t)row * DM))[lane + 64 * j] = w; }
            if (lane == 0) ssq[row] = s;
        }
        {
            LAS float* scr = (LAS float*)(lds + wave * 16384);
            const float* nmg = p.in[2]; const float* nfg = p.in[3];
            constexpr int I0 = 16 * 96, I1 = 16 * 32, I2 = 16 * 176, I3 = 44 * 32, I4 = 16 * 65, I5 = 8 * 16, I6 = 16 * 32, I7 = 16 * 176, I8 = 44 * 32;
            constexpr int NIT = I0 + I1 + I2 + I3 + I4 + I5 + I6 + I7 + I8;
            for (int it = gw; it < NIT; it += NGW) {
                int r = it;
                if (r < I0) { transpose_item(p.in[5], 1024, 3072, nmg, (bf16_t*)(ws + WS_W0IN), 1, scr, r, lane); continue; } r -= I0;
                if (r < I1) { transpose_item(p.in[6], 1024, 1024, nullptr, (bf16_t*)(ws + WS_W0OUT), 0, scr, r, lane); continue; } r -= I1;
                if (r < I2) { transpose_item(p.in[25], 1024, 5632, nfg, (bf16_t*)(ws + WS_WGU0), 3, scr, r, lane); continue; } r -= I2;
                if (r < I3) { transpose_item(p.in[26], 2816, 1024, nullptr, (bf16_t*)(ws + WS_WDN0), 0, scr, r, lane); continue; } r -= I3;
                if (r < I4) { transpose_item(p.in[12], 1024, 2056, nmg + 1024, (bf16_t*)(ws + WS_W1IN), 2, scr, r, lane); continue; } r -= I4;
                if (r < I5) { transpose_item(p.in[23], 512, 512, nullptr, (bf16_t*)(ws + WS_WGLU), 0, scr, r, lane); continue; } r -= I5;
                if (r < I6) { transpose_item(p.in[13], 1024, 1024, nullptr, (bf16_t*)(ws + WS_W1OUT), 0, scr, r, lane); continue; } r -= I6;
                if (r < I7) { transpose_item(p.in[25] + (size_t)1024 * 5632, 1024, 5632, nfg + 1024, (bf16_t*)(ws + WS_WGU1), 3, scr, r, lane); continue; } r -= I7;
                transpose_item(p.in[26] + (size_t)2816 * 1024, 2816, 1024, nullptr, (bf16_t*)(ws + WS_WDN1), 0, scr, r, lane);
            }
        }
        for (int i = blockIdx.x * NTHR + tid; i < 2048; i += G * NTHR) {
            const int g = i >> 6;
            const float lre = p.in[15][i], lim = p.in[16][i], dt = expf(p.in[17][g]);
            const float mag = expf(lre * dt), are = mag * cosf(lim * dt), aim = mag * sinf(lim * dt), den = lre * lre + lim * lim;
            const float gre = ((are - 1.0f) * lre + aim * lim) / den, gim = (aim * lre - (are - 1.0f) * lim) / den;
            float* ap = (float*)(ws + WS_S5A); ap[i] = are; ap[2048 + i] = aim;
            float* bbr = (float*)(ws + WS_S5BB); float* bbi = bbr + 2048 * 16;
            for (int h = 0; h < 16; ++h) { const float br = p.in[18][i * 16 + h], bi = p.in[19][i * 16 + h]; bbr[i * 16 + h] = gre * br - gim * bi; bbi[i * 16 + h] = gre * bi + gim * br; }
        }
        for (int i = blockIdx.x * NTHR + tid; i < 32 * 16 * 128; i += G * NTHR) {
            const int pp = i & 127, gh = i >> 7;
            const float v = (pp < 64) ? p.in[20][gh * 64 + pp] : -p.in[21][gh * 64 + (pp - 64)];
            ((bf16_t*)(ws + WS_S5CT))[i] = (bf16_t)f2bf(v);
        }
        for (int i = blockIdx.x * NTHR + tid; i < 8 * 1024; i += G * NTHR) {
            const int j = i >> 10, k = i & 1023;
            ((float*)(ws + WS_W1F))[i] = p.in[12][(size_t)k * 2056 + 1536 + j] * p.in[2][1024 + k];
        }
    }
    SEAM(0);

    if (IN(1)) {
        pg8::Gemm g{HB, (const bf16_t*)(ws + WS_W0IN), MROWS, 3072, 1024}; pg8::StaticOrder S; S.init(MROWS, 3072, G, (int)blockIdx.x);
        pg8::EpiScaleBf16 E{QKV, 3072, ssq};
        pg8::gemm_phase<pg8::EpiScaleBf16, pg8::StaticOrder, true, true>(lds, g, S, E);
    }
    SEAM(1);

    if (IN(2)) {
        float lam;
        { const float a1 = wave_sum(p.in[7][lane] * p.in[8][lane]), a2 = wave_sum(p.in[9][lane] * p.in[10][lane]); lam = expf(a1) - expf(a2) + 0.2f; }
        constexpr int NDIFF = 16 * 33, NSB = 32 * 33;
        LAS int* misc = (LAS int*)(lds + att::L_MISC);
        for (;;) {
            if (tid == 0) misc[0] = (int)atomicAdd(ctl + 0, 1u);
            __syncthreads();
            const int idx = misc[0];
            __syncthreads();
            if (idx >= NDIFF + NSB) break;
            if (idx < NDIFF) {
#ifndef NO_DIFF
                const int u = 32 - idx / 16, bh = idx % 16, b = bh >> 2, hd = bh & 3;
                const int r32 = lane & 31, hi = lane >> 5;
                f32x4* st = (f32x4*)(STASH + ((size_t)blockIdx.x * NTHR + tid) * 64);
#pragma unroll 1
                for (int comp = 0; comp < 2; ++comp) {
                    att::Args a{QKV, 3072, b * LP, u, 1536 + hd * 128 + comp * 64, 2048 + hd * 128 + comp * 64, 2560 + hd * 128, nullptr};
                    f32x16 o[4]; float l;
                    att::run<1, 4, false>(lds, a, o, l);
                    const float inv = 1.0f / l;
                    if (comp == 0) {
#pragma unroll
                        for (int c = 0; c < 4; ++c)
#pragma unroll
                            for (int g4 = 0; g4 < 4; ++g4) st[c * 4 + g4] = (f32x4){o[c][4 * g4] * inv, o[c][4 * g4 + 1] * inv, o[c][4 * g4 + 2] * inv, o[c][4 * g4 + 3] * inv};
                    } else {
                        float ss = 0.f;
#pragma unroll
                        for (int c = 0; c < 4; ++c)
#pragma unroll
                            for (int g4 = 0; g4 < 4; ++g4) { const f32x4 sv = st[c * 4 + g4];
#pragma unroll
                                for (int e = 0; e < 4; ++e) { const float v = sv[e] - lam * (o[c][4 * g4 + e] * inv); o[c][4 * g4 + e] = v; ss += v * v; } }
                        ss += __shfl_xor(ss, 32);
                        const float rs = 0.8f * rsqrtf(ss * (1.0f / 128.0f) + RMS_EPS);
                        const float* sg = p.in[11];
                        bf16_t* op = CAT + (size_t)(b * LP + 256 * u + 32 * wave + r32) * DM + 512 + hd * 128;
#pragma unroll
                        for (int c = 0; c < 4; ++c)
#pragma unroll
                            for (int g4 = 0; g4 < 4; ++g4) { const int dv = 32 * c + 8 * g4 + 4 * hi; const f32x4 gv = *(const f32x4*)(sg + dv);
                                u32x2 w; w.x = pk2(o[c][4 * g4] * rs * gv[0], o[c][4 * g4 + 1] * rs * gv[1]); w.y = pk2(o[c][4 * g4 + 2] * rs * gv[2], o[c][4 * g4 + 3] * rs * gv[3]);
                                *(u32x2*)(op + dv) = w; }
                    }
                }
#endif
            } else {
#ifndef NO_SB
                const int i2 = idx - NDIFF, u = 32 - i2 / 32, bh = i2 % 32, b = bh >> 3, h = bh & 7;
                const int r32 = lane & 31, hi = lane >> 5;
                att::Args a{QKV, 3072, b * LP, u, h * 64, 512 + h * 64, 1024 + h * 64, nullptr};
                f32x16 o[2]; float l;
                att::run<0, 2, false>(lds, a, o, l);
                bf16_t* op = CAT + (size_t)(b * LP + 256 * u + 32 * wave + r32) * DM + h * 64;
#pragma unroll
                for (int c = 0; c < 2; ++c)
#pragma unroll
                    for (int g4 = 0; g4 < 4; ++g4) { const int dv = 32 * c + 8 * g4 + 4 * hi;
                        u32x2 w; w.x = pk2(o[c][4 * g4], o[c][4 * g4 + 1]); w.y = pk2(o[c][4 * g4 + 2], o[c][4 * g4 + 3]); *(u32x2*)(op + dv) = w; }
#endif
            }
        }
    }
    SEAM(2);

    if (IN(3)) {
        pg8::Gemm g{CAT, (const bf16_t*)(ws + WS_W0OUT), MROWS, 1024, 1024}; pg8::StaticOrder S; S.init(MROWS, 1024, G, (int)blockIdx.x);
        pg8::EpiResid E{H, HB, ssq + MROWS};
        pg8::gemm_phase<pg8::EpiResid, pg8::StaticOrder, true, true>(lds, g, S, E);
    }
    SEAM(3);
    if (IN(4)) {
        pg8::Gemm g{HB, (const bf16_t*)(ws + WS_WGU0), MROWS, 5632, 1024}; pg8::StaticOrder S; S.init(MROWS, 5632, G, (int)blockIdx.x);
        pg8::EpiSwiGLU E{QKV, ssq + MROWS};
        pg8::gemm_phase<pg8::EpiSwiGLU, pg8::StaticOrder, true, true>(lds, g, S, E);
    }
    SEAM(4);
    if (IN(5)) {
        pg8::Gemm g{QKV, (const bf16_t*)(ws + WS_WDN0), MROWS, 1024, 2816}; pg8::StaticOrder S; S.init(MROWS, 1024, G, (int)blockIdx.x);
        pg8::EpiResid E{H, HB, ssq + 2 * MROWS};
        pg8::gemm_phase<pg8::EpiResid, pg8::StaticOrder, true, true>(lds, g, S, E);
    }
    SEAM(5);
    if (IN(6)) {
        {
            pg8::Gemm g{HB, (const bf16_t*)(ws + WS_W1IN), MROWS, 2048, 1024}; pg8::StaticOrder S; S.init(MROWS, 2048, G, (int)blockIdx.x);
            pg8::EpiScaleBf16 E{QKV, 2048, ssq + 2 * MROWS};
            pg8::gemm_phase<pg8::EpiScaleBf16, pg8::StaticOrder, true, true>(lds, g, S, E);
        }
        const float* w1f = (const float*)(ws + WS_W1F);
        for (int row = gw; row < MROWS; row += NGW) {
            const int b = row / LP, pos = row % LP;
            f32x4 v[4];
#pragma unroll
            for (int j = 0; j < 4; ++j) v[j] = ((const f32x4*)(H + (size_t)row * DM))[lane + 64 * j];
            const float rs = rsqrtf(ssq[2 * MROWS + row] * (1.0f / 1024.0f) + RMS_EPS);
            float mine = 0.f;
#pragma unroll
            for (int hh = 0; hh < 8; ++hh) {
                float d = 0.f;
#pragma unroll
                for (int j = 0; j < 4; ++j) { const f32x4 wv = ((const f32x4*)(w1f + hh * 1024))[lane + 64 * j]; d += (v[j][0] * wv[0] + v[j][1] * wv[1]) + (v[j][2] * wv[2] + v[j][3] * wv[3]); }
                d = wave_sum(d);
                if (lane == hh) mine = d;
            }
            if (lane < 8) Fb[((size_t)b * 8 + lane) * LP + pos] = log_sigmoid_f(mine * rs + p.in[14][lane]);
        }
    }
    SEAM(6);
    if (IN(7)) {
        LAS float* sc = (LAS float*)lds;
        for (int chain = blockIdx.x; chain < 32; chain += G) {
            float* Fc = Fb + (size_t)chain * LP;
            float loc[17]; float run = 0.f;
#pragma unroll
            for (int j = 0; j < 17; ++j) { const int idx = tid * 17 + j; const float v = (idx < LP) ? Fc[idx] : 0.f; run += v; loc[j] = run; }
            sc[tid] = run;
            __syncthreads();
            for (int off = 1; off < NTHR; off <<= 1) { const float v = sc[tid] + ((tid >= off) ? sc[tid - off] : 0.f); __syncthreads(); sc[tid] = v; __syncthreads(); }
            const float base = sc[tid] - run;
#pragma unroll
            for (int j = 0; j < 17; ++j) { const int idx = tid * 17 + j; if (idx < LP) Fc[idx] = base + loc[j]; }
            __syncthreads();
        }
        __syncthreads();
        for (int it = gw; it < 4 * 132 * 32; it += NGW) s5_item<false>(p, lds + 1024 * 16 + wave * 13312, it, lane);
    }
    SEAM(7);
    if (IN(8)) {
        for (int it = gw; it < 4 * 132 * 32; it += NGW) s5_item<true>(p, lds + 1024 * 16 + wave * 13312, it, lane);
        __syncthreads();
        constexpr int NFOX = 32 * 33;
        LAS int* misc = (LAS int*)(lds + att::L_MISC);
        for (;;) {
            if (tid == 0) misc[0] = (int)atomicAdd(ctl + 64, 1u);
            __syncthreads();
            const int idx = misc[0];
            __syncthreads();
            if (idx >= NFOX) break;
            const int u = 32 - idx / 32, bh = idx % 32, b = bh >> 3, h = bh & 7;
            const int r32 = lane & 31, hi = lane >> 5;
            att::Args a{QKV, 2048, b * LP, u, h * 64, 512 + h * 64, 1024 + h * 64, Fb + (size_t)bh * LP};
            f32x16 o[2]; float l;
            att::run<1, 2, true>(lds, a, o, l);
            const float inv = 1.0f / l;
            bf16_t* op = CAT + (size_t)(b * LP + 256 * u + 32 * wave + r32) * DM + h * 64;
#pragma unroll
            for (int c = 0; c < 2; ++c)
#pragma unroll
                for (int g4 = 0; g4 < 4; ++g4) { const int dv = 32 * c + 8 * g4 + 4 * hi;
                    u32x2 w; w.x = pk2(o[c][4 * g4] * inv, o[c][4 * g4 + 1] * inv); w.y = pk2(o[c][4 * g4 + 2] * inv, o[c][4 * g4 + 3] * inv); *(u32x2*)(op + dv) = w; }
        }
    }
    SEAM(8);
    if (IN(9)) {
        pg8::Gemm g{(const bf16_t*)(ws + WS_Y), (const bf16_t*)(ws + WS_WGLU), MROWS, 512, 512}; pg8::StaticOrder S; S.init(MROWS, 512, G, (int)blockIdx.x);
        pg8::EpiGLU E{(const bf16_t*)(ws + WS_Y), p.in[24], CAT};
        pg8::gemm_phase<pg8::EpiGLU, pg8::StaticOrder, true, true>(lds, g, S, E);
    }
    SEAM(9);
    if (IN(10)) {
        pg8::Gemm g{CAT, (const bf16_t*)(ws + WS_W1OUT), MROWS, 1024, 1024}; pg8::StaticOrder S; S.init(MROWS, 1024, G, (int)blockIdx.x);
        pg8::EpiResid E{H, HB, ssq + 3 * MROWS};
        pg8::gemm_phase<pg8::EpiResid, pg8::StaticOrder, true, true>(lds, g, S, E);
    }
    SEAM(10);
    if (IN(11)) {
        pg8::Gemm g{HB, (const bf16_t*)(ws + WS_WGU1), MROWS, 5632, 1024}; pg8::StaticOrder S; S.init(MROWS, 5632, G, (int)blockIdx.x);
        pg8::EpiSwiGLU E{QKV, ssq + 3 * MROWS};
        pg8::gemm_phase<pg8::EpiSwiGLU, pg8::StaticOrder, true, true>(lds, g, S, E);
    }
    SEAM(11);
    if (IN(12)) {
        pg8::Gemm g{QKV, (const bf16_t*)(ws + WS_WDN1), MROWS, 1024, 2816}; pg8::StaticOrder S; S.init(MROWS, 1024, G, (int)blockIdx.x);
        pg8::EpiResid E{H, HB, nullptr};
        pg8::gemm_phase<pg8::EpiResid, pg8::StaticOrder, true, true>(lds, g, S, E);
    }
    SEAM(12);
    if (IN(13)) {
        const float* fg = p.in[4];
        for (int r = gw; r < NBATCH * SEQ; r += NGW) {
            const int b = r / SEQ, t = r % SEQ; const size_t row = (size_t)b * LP + 256 + t;
            f32x4 v[4]; float s = 0.f;
#pragma unroll
            for (int j = 0; j < 4; ++j) { v[j] = ((const f32x4*)(H + row * DM))[lane + 64 * j]; s += (v[j][0] * v[j][0] + v[j][1] * v[j][1]) + (v[j][2] * v[j][2] + v[j][3] * v[j][3]); }
            const float rs = rsqrtf(wave_sum(s) * (1.0f / 1024.0f) + RMS_EPS);
#pragma unroll
            for (int j = 0; j < 4; ++j) { const f32x4 gv = ((const f32x4*)fg)[lane + 64 * j]; ((f32x4*)(p.out + (size_t)r * DM))[lane + 64 * j] = v[j] * rs * gv; }
        }
    }
#undef IN
#undef SEAM
}

#ifndef N_LAUNCH_MODE
#define N_LAUNCH_MODE 1
#endif
extern "C" void kernel_launch(void* const* d_in, const int* in_sizes, int n_in, void* d_out, int out_size, void* d_ws, size_t ws_size, hipStream_t stream) {
    static int grid = 0;
    if (grid == 0) {
        if (n_in != 27 || ws_size < WS_END || out_size != NBATCH * SEQ * DM) { fprintf(stderr, "kernel_launch: unexpected shapes (n_in %d, ws %zu, out %d)\n", n_in, ws_size, out_size); grid = -1; return; }
        int dev = 0, cus = 0, per_cu = 0;
        (void)hipGetDevice(&dev); (void)hipDeviceGetAttribute(&cus, hipDeviceAttributeMultiprocessorCount, dev);
        if (hipFuncSetAttribute((const void*)mega_fwd, hipFuncAttributeMaxDynamicSharedMemorySize, LDS_BYTES) != hipSuccess) { fprintf(stderr, "kernel_launch: hipFuncSetAttribute failed\n"); grid = -1; return; }
        if (hipOccupancyMaxActiveBlocksPerMultiprocessor(&per_cu, (const void*)mega_fwd, NTHR, LDS_BYTES) != hipSuccess || per_cu < 1) { fprintf(stderr, "kernel_launch: occupancy query says %d\n", per_cu); per_cu = 1; }
        (void)hipGetLastError();
        grid = cus * 1;
        if (grid <= 0) grid = 256;
    }
    if (grid < 0) return;
    Params p{};
    for (int i = 0; i < 27; ++i) p.in[i] = (const float*)d_in[i];
    p.out = (float*)d_out; p.ws = (unsigned char*)d_ws;
#if N_LAUNCH_MODE == 1
    p.ph_lo = 0; p.ph_hi = 14;
    void* args[] = {&p};
    hipError_t e = hipLaunchCooperativeKernel((const void*)mega_fwd, dim3(grid), dim3(NTHR), args, LDS_BYTES, stream);
    if (e != hipSuccess) fprintf(stderr, "cooperative launch failed: %s (grid %d)\n", hipGetErrorString(e), grid);
#else
    for (int ph = 0; ph < 14; ++ph) { p.ph_lo = ph; p.ph_hi = ph + 1; hipLaunchKernelGGL(mega_fwd, dim3(grid), dim3(NTHR), LDS_BYTES, stream, p); }
#endif
}
```

```cpp
#include <hip/hip_runtime.h>
#include <hip/hip_cooperative_groups.h>
#include <cstdio>
#include <cstdint>
namespace cg = cooperative_groups;

#define LAS __attribute__((address_space(3)))
constexpr int DM = 1024, NBATCH = 4, SEQ = 8192, LP = 8448, PADR = 240, NMETA = 16, MROWS = NBATCH * LP;
constexpr int DFF = 2816, NW = 8, NTHR = 512;
constexpr float C2 = 0.125f * 1.4426950408889634f;
constexpr float LOG2E = 1.4426950408889634f;
constexpr float RMS_EPS = 1e-6f;
constexpr int LDS_BYTES = 147456;

constexpr size_t MiB = 1u << 20;
constexpr size_t WS_CTL = 0;
constexpr size_t WS_SSQ = 1 * MiB;
constexpr size_t WS_F = 2 * MiB;
constexpr size_t WS_S5A = 4 * MiB;
constexpr size_t WS_S5BB = 4 * MiB + 65536;
constexpr size_t WS_S5CT = 4 * MiB + 65536 + 262144;
constexpr size_t WS_W1F = 4 * MiB + 65536 + 262144 + 131072;
constexpr size_t WS_W0IN = 6 * MiB, WS_W0OUT = 12 * MiB, WS_WGU0 = 14 * MiB, WS_WDN0 = 25 * MiB, WS_W1IN = 31 * MiB, WS_WGLU = 35 * MiB, WS_W1OUT = 36 * MiB, WS_WGU1 = 38 * MiB, WS_WDN1 = 49 * MiB;
constexpr size_t WS_H = 56 * MiB;
constexpr size_t WS_HB = 188 * MiB;
constexpr size_t WS_QKV = 254 * MiB;
constexpr size_t WS_Y = 386 * MiB;
constexpr size_t WS_E = 419 * MiB;
constexpr size_t WS_END = 452 * MiB;
constexpr size_t DO_CAT = 0, DO_STASH = 66 * MiB;

typedef unsigned short bf16_t;
typedef short bf16x8 __attribute__((ext_vector_type(8)));
typedef float f32x4 __attribute__((ext_vector_type(4)));
typedef float f32x16 __attribute__((ext_vector_type(16)));
typedef unsigned u32x4 __attribute__((ext_vector_type(4)));
typedef unsigned u32x2 __attribute__((ext_vector_type(2)));
typedef short v4i16_t __attribute__((ext_vector_type(4)));

__device__ __forceinline__ unsigned f2bf(float f) { unsigned u = __builtin_bit_cast(unsigned, f); return (u + 0x7fffu + ((u >> 16) & 1u)) >> 16; }
__device__ __forceinline__ unsigned pk2(float lo, float hi) { return f2bf(lo) | (f2bf(hi) << 16); }
__device__ __forceinline__ float bf2f(unsigned short b) { return __builtin_bit_cast(float, (unsigned)b << 16); }
__device__ __forceinline__ float bflo(unsigned w) { return __builtin_bit_cast(float, w << 16); }
__device__ __forceinline__ float bfhi(unsigned w) { return __builtin_bit_cast(float, w & 0xffff0000u); }
__device__ __forceinline__ float wave_sum(float v) {
#pragma unroll
    for (int o = 32; o >= 1; o >>= 1) v += __shfl_xor(v, o);
    return v;
}
__device__ __forceinline__ float fexp2(float x) { return __builtin_amdgcn_exp2f(x); }
__device__ __forceinline__ float flog2(float x) { return __builtin_amdgcn_logf(x); }
namespace pg8 {
#define PG8_LAS __attribute__((address_space(3)))
typedef unsigned short bf16_t;
typedef short bf16x8 __attribute__((ext_vector_type(8)));
typedef float f32x4 __attribute__((ext_vector_type(4)));
typedef unsigned u32x4 __attribute__((ext_vector_type(4)));
constexpr int BM = 256, BK = 64, HALF = 128, HTB = HALF * BK * 2  , STAGE_BYTES = 8 * HTB, NXCD = 8, WGM = 8;

__host__ __device__ __forceinline__ int lds_byte(int r, int c) { const int st = (r >> 4) * 2 + (c >> 5), rr = r & 15, cc = c & 31, ob = rr * 64 + cc * 2; return st * 1024 + (ob ^ (((ob >> 9) & 1) << 5)); }
__host__ __device__ __forceinline__ void stage_rc(int b, int& R, int& C) { const int st = b / 1024, sb = b % 1024, swz = sb ^ (((sb >> 9) & 1) << 5); R = (st >> 1) * 16 + swz / 64; C = (st & 1) * 32 + (swz % 64) / 2; }
__host__ __device__ __forceinline__ int perm32(int rho) { const int n = rho >> 4, i = rho & 15; return 8 * (i >> 2) + 4 * n + (i & 3); }

struct Unit { int pm, pn; };
struct Gemm { const bf16_t* A; const bf16_t* Bt; int M, N, K; };

struct StaticOrder {
    int nM, nN, nwg, G, c;
    __host__ __device__ void init(int M, int N, int G_, int c_) { nM = M / BM; nN = N / BM; nwg = nM * nN; G = G_; c = c_; }
    __host__ __device__ bool next(int i, Unit& u) const {
        const long L = (long)i * G + c; if (L >= nwg) return false;
        int wgid = (int)L; { const int q = nwg / NXCD, r = nwg % NXCD, xcd = wgid % NXCD, off = wgid / NXCD; wgid = (xcd < r ? xcd * (q + 1) : r * (q + 1) + (xcd - r) * q) + off; }
        const int nig = WGM * nN, gid = wgid / nig, fm = gid * WGM, gsz = (nM - fm) < WGM ? (nM - fm) : WGM;
        u.pm = fm + ((wgid % nig) % gsz); u.pn = (wgid % nig) / gsz; return true;
    }
    __device__ __forceinline__ void a_ready(const Unit&) const {}
    __device__ __forceinline__ void done(const Unit&) const {}
};
__device__ __forceinline__ unsigned cvt_pk_bf16(float lo, float hi) { unsigned r; asm volatile("v_cvt_pk_bf16_f32 %0, %1, %2" : "=v"(r) : "v"(lo), "v"(hi)); return r; }
typedef float f32x2 __attribute__((ext_vector_type(2)));
struct EpiScaleBf16 {
    static constexpr bool PERM = true, AFTER_DRAIN = false;
    bf16_t* O; int ldc; const float* ssq;
    __device__ __forceinline__ void operator()(const f32x4 (&acc)[2][2][4][2], const Unit& u, int wr, int wc, int fr, int fq) const {
        const int col0 = u.pn * BM + wc * 32 + 8 * fq;
#pragma unroll
        for (int ai = 0; ai < 2; ++ai)
#pragma unroll
            for (int m = 0; m < 4; ++m) {
                const int row = u.pm * BM + ai * HALF + wr * 64 + m * 16 + fr;
                const float rs = __builtin_amdgcn_rsqf(__hip_atomic_load(ssq + row, __ATOMIC_RELAXED, __HIP_MEMORY_SCOPE_AGENT) * (1.0f / 1024.0f) + 1e-6f);
                bf16_t* rowp = O + (size_t)row * ldc + col0;
#pragma unroll
                for (int bj = 0; bj < 2; ++bj) { const f32x4 v0 = acc[ai][bj][m][0] * rs, v1 = acc[ai][bj][m][1] * rs;
                    u32x4 w; w.x = cvt_pk_bf16(v0[0], v0[1]); w.y = cvt_pk_bf16(v0[2], v0[3]); w.z = cvt_pk_bf16(v1[0], v1[1]); w.w = cvt_pk_bf16(v1[2], v1[3]);
                    *(u32x4*)(rowp + bj * HALF) = w; } }
    }
};
struct EpiResid {
    static constexpr bool PERM = true, AFTER_DRAIN = false;
    float* h; bf16_t* hb; float* ssq;
    __device__ __forceinline__ void operator()(const f32x4 (&acc)[2][2][4][2], const Unit& u, int wr, int wc, int fr, int fq) const {
        const int col0 = u.pn * BM + wc * 32 + 8 * fq;
#pragma unroll
        for (int ai = 0; ai < 2; ++ai)
#pragma unroll
            for (int m = 0; m < 4; ++m) {
                const int row = u.pm * BM + ai * HALF + wr * 64 + m * 16 + fr;
                const bool valid = (row % 8448) >= 240;
                float ss = 0.f;
#pragma unroll
                for (int bj = 0; bj < 2; ++bj) {
                    float* hp = h + (size_t)row * 1024 + col0 + bj * HALF;
                    f32x4 v0 = *(const f32x4*)hp + acc[ai][bj][m][0], v1 = *(const f32x4*)(hp + 4) + acc[ai][bj][m][1];
                    if (!valid) { v0 = (f32x4){0.f, 0.f, 0.f, 0.f}; v1 = v0; }
                    *(f32x4*)hp = v0; *(f32x4*)(hp + 4) = v1;
                    u32x4 w; w.x = cvt_pk_bf16(v0[0], v0[1]); w.y = cvt_pk_bf16(v0[2], v0[3]); w.z = cvt_pk_bf16(v1[0], v1[1]); w.w = cvt_pk_bf16(v1[2], v1[3]);
                    *(u32x4*)(hb + (size_t)row * 1024 + col0 + bj * HALF) = w;
                    ss += (v0[0] * v0[0] + v0[1] * v0[1]) + (v0[2] * v0[2] + v0[3] * v0[3]) + (v1[0] * v1[0] + v1[1] * v1[1]) + (v1[2] * v1[2] + v1[3] * v1[3]);
                }
                ss += __shfl_xor(ss, 16); ss += __shfl_xor(ss, 32);
                if (fq == 0 && ssq) atomicAdd(ssq + row, ss);
            }
    }
};
struct EpiSwiGLU {
    static constexpr bool PERM = true, AFTER_DRAIN = false;
    bf16_t* O; const float* ssq;
    __device__ __forceinline__ void operator()(const f32x4 (&acc)[2][2][4][2], const Unit& u, int wr, int wc, int fr, int fq) const {
        const int col0 = u.pn * BM + wc * 32 + 8 * fq;
#pragma unroll
        for (int ai = 0; ai < 2; ++ai)
#pragma unroll
            for (int m = 0; m < 4; ++m) {
                const int row = u.pm * BM + ai * HALF + wr * 64 + m * 16 + fr;
                const float rs = __builtin_amdgcn_rsqf(__hip_atomic_load(ssq + row, __ATOMIC_RELAXED, __HIP_MEMORY_SCOPE_AGENT) * (1.0f / 1024.0f) + 1e-6f);
#pragma unroll
                for (int bj = 0; bj < 2; ++bj) { const f32x4 g = acc[ai][bj][m][0] * rs, up = acc[ai][bj][m][1] * rs; float a[4];
#pragma unroll
                    for (int e = 0; e < 4; ++e) a[e] = g[e] * __builtin_amdgcn_rcpf(1.0f + __builtin_amdgcn_exp2f(-1.4426950408889634f * g[e])) * up[e];
                    u32x2 w; w.x = cvt_pk_bf16(a[0], a[1]); w.y = cvt_pk_bf16(a[2], a[3]);
                    *(u32x2*)(O + (size_t)row * 2816 + ((col0 + bj * HALF) >> 1)) = w; } }
    }
};
struct EpiGLU {
    static constexpr bool PERM = true, AFTER_DRAIN = false;
    const bf16_t* Y; const float* bias; bf16_t* O;
    __device__ __forceinline__ void operator()(const f32x4 (&acc)[2][2][4][2], const Unit& u, int wr, int wc, int fr, int fq) const {
        const int col0 = u.pn * BM + wc * 32 + 8 * fq;
#pragma unroll
        for (int ai = 0; ai < 2; ++ai)
#pragma unroll
            for (int m = 0; m < 4; ++m) {
                const int row = u.pm * BM + ai * HALF + wr * 64 + m * 16 + fr;
#pragma unroll
                for (int bj = 0; bj < 2; ++bj) { const int col = col0 + bj * HALF;
                    const u32x4 yv = *(const u32x4*)(Y + (size_t)row * 512 + col);
                    const f32x4 b0 = *(const f32x4*)(bias + col), b1 = *(const f32x4*)(bias + col + 4);
                    const f32x4 z0 = acc[ai][bj][m][0] + b0, z1 = acc[ai][bj][m][1] + b1; float o[8];
                    const float yy[8] = {__builtin_bit_cast(float, yv.x << 16), __builtin_bit_cast(float, yv.x & 0xffff0000u), __builtin_bit_cast(float, yv.y << 16), __builtin_bit_cast(float, yv.y & 0xffff0000u),
                                         __builtin_bit_cast(float, yv.z << 16), __builtin_bit_cast(float, yv.z & 0xffff0000u), __builtin_bit_cast(float, yv.w << 16), __builtin_bit_cast(float, yv.w & 0xffff0000u)};
#pragma unroll
                    for (int e = 0; e < 4; ++e) { o[e] = yy[e] * __builtin_amdgcn_rcpf(1.0f + __builtin_amdgcn_exp2f(-1.4426950408889634f * z0[e])); o[4 + e] = yy[4 + e] * __builtin_amdgcn_rcpf(1.0f + __builtin_amdgcn_exp2f(-1.4426950408889634f * z1[e])); }
                    u32x4 w; w.x = cvt_pk_bf16(o[0], o[1]); w.y = cvt_pk_bf16(o[2], o[3]); w.z = cvt_pk_bf16(o[4], o[5]); w.w = cvt_pk_bf16(o[6], o[7]);
                    *(u32x4*)(O + (size_t)row * 1024 + 512 + col) = w; } }
    }
};
template <class Epi, class Sched, bool ALIGN_EPI = false, bool SP2 = false>
__device__ __forceinline__ void gemm_phase(PG8_LAS unsigned char* lds, const Gemm g, const Sched& S, const Epi& E) {
    int tid_l = threadIdx.x; asm volatile("" : "+v"(tid_l));
    const int tid = tid_l, wid = __builtin_amdgcn_readfirstlane(tid >> 6), lane = tid & 63, wr = wid >> 2, wc = wid & 3, fr = lane & 15, fq = lane >> 4;
    const int K = g.K, nt = K / BK;
    unsigned voffA[2], voffB[2];
#pragma unroll
    for (int i = 0; i < 2; ++i) { int R, C; stage_rc(tid * 16 + i * 8192, R, C); const int Rb = Epi::PERM ? ((R & ~31) + perm32(R & 31)) : R;
        voffA[i] = (unsigned)(R * K + C) * 2u; voffB[i] = (unsigned)(Rb * K + C) * 2u; }
    const size_t kstep = (size_t)(BK * 2);
    const size_t hstep = (size_t)HALF * K * 2;
    const size_t tstep = 2 * hstep;
    const unsigned ldsw = (unsigned)wid * 1024u;
    const int aoff = lds_byte(wr * 64 + fr, fq * 8), boff = lds_byte(wc * 32 + fr, fq * 8);
#define PG8_SA(b, h) (((b) * 2 + (h)) * HTB)
#define PG8_SB(b, h) ((4 + (b) * 2 + (h)) * HTB)
#define PG8_STAGE(bufoff, gbase, voff) do { _Pragma("unroll") for (int _i = 0; _i < 2; ++_i) \
        __builtin_amdgcn_global_load_lds((const unsigned*)((const char*)(gbase) + (voff)[_i]), (PG8_LAS unsigned*)(lds + (bufoff) + ldsw + _i * 8192), 16, 0, 0); } while (0)
#define PG8_LDA(dst, b, h) do { _Pragma("unroll") for (int m = 0; m < 4; ++m) _Pragma("unroll") for (int k = 0; k < 2; ++k) dst[m][k] = *(const PG8_LAS bf16x8*)(lds + PG8_SA(b, h) + aoff + m * 2048 + k * 1024); } while (0)
#define PG8_LDB(dst, b, h) do { _Pragma("unroll") for (int n = 0; n < 2; ++n) _Pragma("unroll") for (int k = 0; k < 2; ++k) dst[n][k] = *(const PG8_LAS bf16x8*)(lds + PG8_SB(b, h) + boff + n * 2048 + k * 1024); } while (0)
#define PG8_MMA(ai, bj, At, Bt) do { __builtin_amdgcn_s_setprio(1); _Pragma("unroll") for (int m = 0; m < 4; ++m) _Pragma("unroll") for (int n = 0; n < 2; ++n) _Pragma("unroll") for (int k = 0; k < 2; ++k) \
        acc[ai][bj][m][n] = __builtin_amdgcn_mfma_f32_16x16x32_bf16(Bt[n][k], At[m][k], acc[ai][bj][m][n], 0, 0, 0); __builtin_amdgcn_s_setprio(0); } while (0)
#define PG8_WAIT_V(n) asm volatile("s_waitcnt vmcnt(" #n ")" ::: "memory")
#define PG8_WAIT_L(n) asm volatile("s_waitcnt lgkmcnt(" #n ")" ::: "memory")
#define PG8_BAR __builtin_amdgcn_s_barrier()
#define PG8_SCHED __builtin_amdgcn_sched_barrier(0)
    Unit cur, nxt; int ui = 0;
    if (!S.next(0, cur)) return;
    f32x4 acc[2][2][4][2];
#pragma unroll
    for (int a = 0; a < 2; ++a)
#pragma unroll
        for (int b = 0; b < 2; ++b)
#pragma unroll
            for (int m = 0; m < 4; ++m)
#pragma unroll
                for (int n = 0; n < 2; ++n) acc[a][b][m][n] = (f32x4){0.f, 0.f, 0.f, 0.f};
    bf16x8 At[4][2], B0[2][2], B1[2][2];
    const char* cA = (const char*)g.A + (size_t)cur.pm * tstep; const char* cB = (const char*)g.Bt + (size_t)cur.pn * tstep;
    S.a_ready(cur);
    if constexpr (SP2) {
        PG8_STAGE(PG8_SB(0, 0), cB, voffB); PG8_STAGE(PG8_SB(0, 1), cB + hstep, voffB); PG8_STAGE(PG8_SA(0, 0), cA, voffA); PG8_STAGE(PG8_SA(0, 1), cA + hstep, voffA);
        if (wr == 1) PG8_BAR;
        PG8_WAIT_V(2); PG8_BAR;
        PG8_STAGE(PG8_SB(1, 0), cB + kstep, voffB); PG8_STAGE(PG8_SA(1, 0), cA + kstep, voffA); PG8_STAGE(PG8_SB(1, 1), cB + hstep + kstep, voffB);
        PG8_WAIT_V(6); PG8_BAR;
    } else {
        PG8_STAGE(PG8_SB(0, 0), cB, voffB); PG8_STAGE(PG8_SA(0, 0), cA, voffA); PG8_STAGE(PG8_SB(0, 1), cB + hstep, voffB); PG8_STAGE(PG8_SA(0, 1), cA + hstep, voffA);
        if (wr == 1) PG8_BAR;
        PG8_WAIT_V(4); PG8_BAR;
        PG8_STAGE(PG8_SB(1, 0), cB + kstep, voffB); PG8_STAGE(PG8_SA(1, 0), cA + kstep, voffA); PG8_STAGE(PG8_SB(1, 1), cB + hstep + kstep, voffB);
        PG8_WAIT_V(6); PG8_BAR;
    }
    for (;;) {
        const bool has_next = S.next(ui + 1, nxt);
        const char* nA = has_next ? (const char*)g.A + (size_t)nxt.pm * tstep : cA; const char* nB = has_next ? (const char*)g.Bt + (size_t)nxt.pn * tstep : cB;
        for (int t = 0; t < nt; t += 2) {
            const bool last = (t == nt - 2);
            const char* a1 = cA + (size_t)(t + 1) * kstep;
            const char* a2 = last ? nA : cA + (size_t)(t + 2) * kstep; const char* b2 = last ? nB : cB + (size_t)(t + 2) * kstep;
            const char* a3 = a2 + kstep; const char* b3 = b2 + kstep;
            if (last && has_next) S.a_ready(nxt);
            if constexpr (SP2) {
            PG8_LDB(B0, 0, 0); PG8_LDB(B1, 0, 1); PG8_SCHED; PG8_LDA(At, 0, 0); PG8_STAGE(PG8_SA(1, 1), a1 + hstep, voffA);
            PG8_WAIT_V(8); PG8_WAIT_L(0); PG8_BAR; PG8_MMA(0, 0, At, B0); PG8_MMA(0, 1, At, B1); PG8_BAR; PG8_SCHED;
            PG8_LDA(At, 0, 1); PG8_STAGE(PG8_SB(0, 0), b2, voffB); PG8_STAGE(PG8_SB(0, 1), b2 + hstep, voffB); PG8_STAGE(PG8_SA(0, 0), a2, voffA);
            PG8_WAIT_V(8); PG8_WAIT_L(0); PG8_BAR; PG8_MMA(1, 0, At, B0); PG8_MMA(1, 1, At, B1); PG8_BAR; PG8_SCHED;
            PG8_LDB(B0, 1, 0); PG8_LDB(B1, 1, 1); PG8_SCHED; PG8_LDA(At, 1, 0); PG8_STAGE(PG8_SA(0, 1), a2 + hstep, voffA);
            PG8_WAIT_V(8); PG8_WAIT_L(0); PG8_BAR; PG8_MMA(0, 0, At, B0); PG8_MMA(0, 1, At, B1); PG8_BAR; PG8_SCHED;
            PG8_LDA(At, 1, 1); PG8_STAGE(PG8_SB(1, 0), b3, voffB); PG8_STAGE(PG8_SB(1, 1), b3 + hstep, voffB); PG8_STAGE(PG8_SA(1, 0), a3, voffA);
            PG8_WAIT_V(8); PG8_WAIT_L(0); PG8_BAR; PG8_MMA(1, 0, At, B0); PG8_MMA(1, 1, At, B1); PG8_BAR; PG8_SCHED;
            } else {
            PG8_LDB(B0, 0, 0); PG8_SCHED; PG8_LDA(At, 0, 0); PG8_STAGE(PG8_SA(1, 1), a1 + hstep, voffA);
            PG8_WAIT_L(8); PG8_BAR; PG8_WAIT_L(0); PG8_MMA(0, 0, At, B0); PG8_BAR; PG8_SCHED;
            PG8_LDB(B1, 0, 1); PG8_STAGE(PG8_SB(0, 0), b2, voffB);
            PG8_BAR; PG8_WAIT_L(0); PG8_MMA(0, 1, At, B1); PG8_BAR;
            PG8_LDA(At, 0, 1); PG8_STAGE(PG8_SA(0, 0), a2, voffA);
            PG8_BAR; PG8_WAIT_L(0); PG8_MMA(1, 0, At, B0); PG8_BAR; PG8_SCHED;
            PG8_STAGE(PG8_SB(0, 1), b2 + hstep, voffB);
            PG8_WAIT_V(6); PG8_BAR; PG8_MMA(1, 1, At, B1); PG8_BAR;
            PG8_LDB(B0, 1, 0); PG8_SCHED; PG8_LDA(At, 1, 0); PG8_STAGE(PG8_SA(0, 1), a2 + hstep, voffA);
            PG8_WAIT_L(8); PG8_BAR; PG8_WAIT_L(0); PG8_MMA(0, 0, At, B0); PG8_BAR; PG8_SCHED;
            PG8_LDB(B1, 1, 1); PG8_STAGE(PG8_SB(1, 0), b3, voffB);
            PG8_BAR; PG8_WAIT_L(0); PG8_MMA(0, 1, At, B1); PG8_BAR;
            PG8_LDA(At, 1, 1); PG8_STAGE(PG8_SA(1, 0), a3, voffA);
            PG8_BAR; PG8_WAIT_L(0); PG8_MMA(1, 0, At, B0); PG8_BAR; PG8_SCHED;
            PG8_STAGE(PG8_SB(1, 1), b3 + hstep, voffB);
            PG8_WAIT_V(6); PG8_BAR; PG8_MMA(1, 1, At, B1); PG8_BAR;
            }
        }
        if constexpr (ALIGN_EPI) { if (wr == 0) PG8_BAR; }
        if constexpr (!Epi::AFTER_DRAIN) { E(acc, cur, wr, wc, fr, fq); S.done(cur); }
        if (!has_next) break;
#pragma unroll
        for (int a = 0; a < 2; ++a)
#pragma unroll
            for (int b = 0; b < 2; ++b)
#pragma unroll
                for (int m = 0; m < 4; ++m)
#pragma unroll
                    for (int n = 0; n < 2; ++n) acc[a][b][m][n] = (f32x4){0.f, 0.f, 0.f, 0.f};
        cur = nxt; cA = nA; cB = nB; ++ui;
        if constexpr (ALIGN_EPI) { if (wr == 1) PG8_BAR; }
    }
    PG8_WAIT_V(0);
    if constexpr (!ALIGN_EPI) { if (wr == 0) PG8_BAR; }
    PG8_BAR;
    if constexpr (Epi::AFTER_DRAIN) { E.fused(acc, cur, wr, wc, fr, fq, lds, wid, lane); S.done(cur); }
#undef PG8_SA
#undef PG8_SB
#undef PG8_STAGE
#undef PG8_LDA
#undef PG8_LDB
#undef PG8_MMA
#undef PG8_WAIT_V
#undef PG8_WAIT_L
#undef PG8_BAR
#undef PG8_SCHED
}
}
namespace att {
constexpr int KROW = 144, KBUF = 64 * KROW;
constexpr int VBUF = 16384;
constexpr int L_K = 0, L_V = 2 * KBUF, L_BIAS = L_V + 2 * VBUF, L_FLAG = L_BIAS + 2 * 64 * 4, L_MISC = L_FLAG + 64, L_END = L_MISC + 64;
__device__ __forceinline__ int crow(int r, int hi) { return (r & 3) + 8 * (r >> 2) + 4 * hi; }
__device__ __forceinline__ unsigned cvtpk(float lo, float hi) { unsigned r; asm volatile("v_cvt_pk_bf16_f32 %0, %1, %2" : "=v"(r) : "v"(lo), "v"(hi)); return r; }

struct Args { const bf16_t* qkv; int pitch; int rowb; int u; int qcol, kcol, vcol; const float* F; float kmax; };

template <int MODE, int NDV, bool BIAS>
__device__ __forceinline__ void run(LAS unsigned char* lds, const Args& a, f32x16 (&o)[NDV], float& l_out) {
    int tid_l = threadIdx.x; asm volatile("" : "+v"(tid_l));
    const int tid = tid_l, lane = tid & 63, w = __builtin_amdgcn_readfirstlane(tid >> 6), r32 = lane & 31, hi = lane >> 5;
    const int qmin = 256 * a.u + 32 * w, qpos = qmin + r32;
    constexpr int NV = NDV / 2;
    bf16x8 qf[4];
    { const bf16_t* qp = a.qkv + (size_t)(a.rowb + qpos) * a.pitch + a.qcol + 8 * hi;
#pragma unroll
      for (int d0 = 0; d0 < 4; ++d0) qf[d0] = *(const bf16x8*)(qp + 16 * d0); }
    float qkb = 0.f;
    if (BIAS) { float s2 = 0.f;
#pragma unroll
        for (int d0 = 0; d0 < 4; ++d0)
#pragma unroll
            for (int j = 0; j < 8; ++j) { const float qv = bf2f((unsigned short)qf[d0][j]); s2 += qv * qv; }
        s2 += __shfl_xor(s2, 32); qkb = sqrtf(s2) * a.kmax * 1.001f + 1e-3f; }
    const int kr = tid >> 3, kc = tid & 7;
    const bf16_t* kg = a.qkv + (size_t)(a.rowb + kr) * a.pitch + a.kcol + 8 * kc;
    const unsigned klds = kr * KROW + kc * 16;
    const bf16_t* vg[NV]; unsigned vlds[NV];
#pragma unroll
    for (int j = 0; j < NV; ++j) {
        int vr, ch; if (NDV == 2) { vr = tid >> 3; ch = tid & 7; } else { vr = (tid >> 4) + 32 * j; ch = tid & 15; }
        vg[j] = a.qkv + (size_t)(a.rowb + vr) * a.pitch + a.vcol + 8 * ch;
        vlds[j] = (vr >> 3) * (NDV * 512) + (ch >> 2) * 512 + (vr & 7) * 64 + (ch & 3) * 16;
    }
    const size_t tstride = (size_t)64 * a.pitch;
    float fq0 = 0.f; if (BIAS) fq0 = a.F[256 * a.u];
    const int ntile = 4 * a.u + 1;
#define ATT_TILE(i) ((MODE == 0 || BIAS) ? (4 * a.u + 3 - (i)) : (3 + (i)))
    u32x4 kreg, vreg[NV]; float breg = 0.f, ubn = 0.f;
#define ATT_LOAD(kt) do { kreg = *(const u32x4*)(kg + (size_t)(kt) * tstride); _Pragma("unroll") for (int j_ = 0; j_ < NV; ++j_) vreg[j_] = *(const u32x4*)(vg[j_] + (size_t)(kt) * tstride); \
        if (BIAS) { if (tid < 64) breg = (fq0 - a.F[64 * (kt) + tid]) * LOG2E; ubn = (fq0 - a.F[64 * (kt) + 63]) * LOG2E; } } while (0)
#define ATT_WRITE(b) do { *(LAS u32x4*)(lds + L_K + (b) * KBUF + klds) = kreg; _Pragma("unroll") for (int j_ = 0; j_ < NV; ++j_) *(LAS u32x4*)(lds + L_V + (b) * VBUF + vlds[j_]) = vreg[j_]; \
        if (BIAS) { if (tid < 64) *(LAS float*)(lds + L_BIAS + (b) * 256 + tid * 4) = breg; } } while (0)
#pragma unroll
    for (int c = 0; c < NDV; ++c)
#pragma unroll
        for (int r = 0; r < 16; ++r) o[c][r] = 0.f;
    float mrun = -1e30f, lrun = 0.f, carry = 0.f;
    const unsigned vlane = 64 * (4 * hi + ((lane & 15) >> 2)) + 32 * ((lane >> 4) & 1) + 8 * (lane & 3);
    ATT_LOAD(ATT_TILE(0)); ATT_WRITE(0);
    __syncthreads();
    for (int i = 0; i < ntile; ++i) {
        const int kt = ATT_TILE(i), buf = i & 1;
        if (i + 1 < ntile) ATT_LOAD(ATT_TILE(i + 1));
        const int tlo = 64 * kt;
        const bool skip = (MODE == 0) ? (tlo >= qmin + 31) : (tlo > qmin + 31);
        if (!skip) {
            const bool needmask = (kt == 3) || ((MODE == 0) ? (tlo + 63 >= qmin) : (tlo + 63 > qmin));
            const LAS unsigned char* kb = lds + L_K + buf * KBUF + r32 * KROW + 16 * hi;
            f32x16 x[2];
#pragma unroll
            for (int xt = 0; xt < 2; ++xt) {
                if (BIAS) {
                    const LAS float* bp = (const LAS float*)(lds + L_BIAS + buf * 256) + 32 * xt + 4 * hi;
#pragma unroll
                    for (int g = 0; g < 4; ++g) { const f32x4 bv = *(const LAS f32x4*)(bp + 8 * g); x[xt][4 * g] = bv[0]; x[xt][4 * g + 1] = bv[1]; x[xt][4 * g + 2] = bv[2]; x[xt][4 * g + 3] = bv[3]; }
                } else {
#pragma unroll
                    for (int r = 0; r < 16; ++r) x[xt][r] = 0.f;
                }
#pragma unroll
                for (int d0 = 0; d0 < 4; ++d0) { const bf16x8 kf = *(const LAS bf16x8*)(kb + xt * 32 * KROW + 32 * d0); x[xt] = __builtin_amdgcn_mfma_f32_32x32x16_bf16(kf, qf[d0], x[xt], 0, 0, 0); }
            }
            unsigned pk[4][4];
            if (MODE == 1) {
                if (needmask) {
#pragma unroll
                    for (int xt = 0; xt < 2; ++xt)
#pragma unroll
                        for (int r = 0; r < 16; ++r) { const int kvp = tlo + 32 * xt + crow(r, hi); if (kvp > qpos || kvp < PADR) x[xt][r] = -1e30f; }
                }
                float mx = x[0][0];
#pragma unroll
                for (int r = 1; r < 16; ++r) mx = fmaxf(mx, x[0][r]);
#pragma unroll
                for (int r = 0; r < 16; ++r) mx = fmaxf(mx, x[1][r]);
                mx = fmaxf(mx, __shfl_xor(mx, 32));
                const float mnew = fmaxf(mrun, mx), alpha = fexp2(mrun - mnew); mrun = mnew;
                float ps = 0.f;
#pragma unroll
                for (int xt = 0; xt < 2; ++xt)
#pragma unroll
                    for (int r = 0; r < 16; ++r) { const float pv = fexp2(x[xt][r] - mnew); x[xt][r] = pv; ps += pv; }
                lrun = lrun * alpha + ps;
                if (__any(alpha != 1.0f)) {
#pragma unroll
                    for (int c = 0; c < NDV; ++c)
#pragma unroll
                        for (int r = 0; r < 16; ++r) o[c][r] *= alpha;
                }
            } else {
#pragma unroll
                for (int xt = 1; xt >= 0; --xt) {
                    float lm[16], G[4], Gp[4];
#pragma unroll
                    for (int r = 0; r < 16; ++r) {
                        const float z = x[xt][r], sp = fmaxf(z, 0.f) + flog2(1.0f + fexp2(-fabsf(z)));
                        bool valid = true;
                        if (needmask) { const int kvp = tlo + 32 * xt + crow(r, hi); valid = (kvp < qpos) && (kvp >= PADR); }
                        lm[r] = valid ? -sp : 0.f;
                        x[xt][r] = valid ? (z - sp) : -1e30f;
                    }
#pragma unroll
                    for (int g = 0; g < 4; ++g) { G[g] = (lm[4 * g] + lm[4 * g + 1]) + (lm[4 * g + 2] + lm[4 * g + 3]); Gp[g] = __shfl_xor(G[g], 32); }
                    float runv = carry;
#pragma unroll
                    for (int g = 3; g >= 0; --g) {
                        const float g1 = hi ? G[g] : Gp[g], g0 = hi ? Gp[g] : G[g];
                        const float sg = hi ? runv : (runv + g1);
                        const float c3 = sg, c2 = c3 + lm[4 * g + 3], c1 = c2 + lm[4 * g + 2], c0 = c1 + lm[4 * g + 1];
                        x[xt][4 * g + 3] = fexp2(x[xt][4 * g + 3] + c3); x[xt][4 * g + 2] = fexp2(x[xt][4 * g + 2] + c2);
                        x[xt][4 * g + 1] = fexp2(x[xt][4 * g + 1] + c1); x[xt][4 * g] = fexp2(x[xt][4 * g] + c0);
                        runv = runv + (g1 + g0);
                    }
                    carry = runv;
                }
            }
#pragma unroll
            for (int ks = 0; ks < 4; ++ks)
#pragma unroll
                for (int j = 0; j < 4; ++j) pk[ks][j] = cvtpk(x[ks >> 1][8 * (ks & 1) + 2 * j], x[ks >> 1][8 * (ks & 1) + 2 * j + 1]);
            const LAS unsigned char* vb = lds + L_V + buf * VBUF + vlane;
#pragma unroll
            for (int ks = 0; ks < 4; ++ks) {
                asm volatile("" ::: "memory");
                bf16x8 pb; { u32x4 t4 = {pk[ks][0], pk[ks][1], pk[ks][2], pk[ks][3]}; pb = __builtin_bit_cast(bf16x8, t4); }
#pragma unroll
                for (int c = 0; c < NDV; ++c) {
                    const v4i16_t lo = __builtin_amdgcn_ds_read_tr16_b64_v4i16((LAS v4i16_t*)(vb + (2 * ks) * (NDV * 512) + 512 * c));
                    const v4i16_t hh = __builtin_amdgcn_ds_read_tr16_b64_v4i16((LAS v4i16_t*)(vb + (2 * ks + 1) * (NDV * 512) + 512 * c));
                    const bf16x8 va = {lo[0], lo[1], lo[2], lo[3], hh[0], hh[1], hh[2], hh[3]};
                    o[c] = __builtin_amdgcn_mfma_f32_32x32x16_bf16(va, pb, o[c], 0, 0, 0);
                }
            }
        }
        if (MODE == 0) { const int ok = __all(carry < -160.0f) ? 1 : 0; if (lane == 0) *(LAS int*)(lds + L_FLAG + (buf * 8 + w) * 4) = ok; }
        if (i + 1 < ntile) ATT_WRITE(buf ^ 1);
        if (BIAS) {
            const int ok = __all(qkb + ubn - mrun < -160.0f) ? 1 : 0; if (lane == 0) *(LAS int*)(lds + L_FLAG + (buf * 8 + w) * 4) = ok;
        }
        __syncthreads();
        if (MODE == 0 || BIAS) {
            const LAS int* fl = (const LAS int*)(lds + L_FLAG + buf * 32);
            const int all = fl[0] & fl[1] & fl[2] & fl[3] & fl[4] & fl[5] & fl[6] & fl[7];
            if (all) break;
        }
    }
    __syncthreads();
    l_out = lrun + __shfl_xor(lrun, 32);
#undef ATT_TILE
#undef ATT_LOAD
#undef ATT_WRITE
}
}
struct Params { const float* in[27]; float* out; unsigned char* ws; int ph_lo, ph_hi; };

__device__ __forceinline__ float log_sigmoid_f(float x) { return -(fmaxf(-x, 0.f) + log1pf(expf(-fabsf(x)))); }
__device__ __forceinline__ float gelu_tanh_f(float x) { const float z = 0.7978845608028654f * (x + 0.044715f * x * x * x); const float t = 1.0f - 2.0f / (__expf(2.0f * z) + 1.0f); return 0.5f * x * (1.0f + t); }

__device__ __forceinline__ void map_col(int kind, int n, int& dr, float& sc) {
    sc = 1.0f; dr = n;
    if (kind == 1) { if (n < 512 || (n >= 1536 && n < 2048)) sc = C2; }
    else if (kind == 2) { if (n < 512) sc = C2; else if (n >= 1536 && n < 1544) dr = -1; else if (n >= 1544) dr = n - 8; }
    else if (kind == 3) { if (n < 2816) dr = 8 * (n >> 2) + (n & 3); else { const int j = n - 2816; dr = 8 * (j >> 2) + 4 + (j & 3); } }
}
__device__ __forceinline__ void transpose_item(const float* W, int K, int N, const float* gk, bf16_t* WT, int kind, LAS float* scr, int item, int lane) {
    const int nblk = (N + 31) / 32, kb = item / nblk, nb = item % nblk, k0 = 64 * kb, n0 = 32 * nb;
#pragma unroll 8
    for (int i = 0; i < 32; ++i) { const int kk = 2 * i + (lane >> 5), n = n0 + (lane & 31);
        float v = 0.f; if (n < N) { v = W[(size_t)(k0 + kk) * N + n]; if (gk) v *= gk[k0 + kk]; }
        scr[kk * 33 + (lane & 31)] = v; }
    asm volatile("s_waitcnt lgkmcnt(0)" ::: "memory");
    const int c = lane & 7;
#pragma unroll
    for (int j = 0; j < 4; ++j) { const int nl = (lane >> 3) + 8 * j, n = n0 + nl;
        if (n < N) { int dr; float sc; map_col(kind, n, dr, sc);
            if (dr >= 0) { const LAS float* s = scr + (8 * c) * 33 + nl;
                u32x4 o; o.x = pk2(s[0 * 33] * sc, s[1 * 33] * sc); o.y = pk2(s[2 * 33] * sc, s[3 * 33] * sc); o.z = pk2(s[4 * 33] * sc, s[5 * 33] * sc); o.w = pk2(s[6 * 33] * sc, s[7 * 33] * sc);
                *(u32x4*)(WT + (size_t)dr * K + k0 + 8 * c) = o; } } }
    asm volatile("s_waitcnt lgkmcnt(0)" ::: "memory");
}

template <bool FINAL>
__device__ __forceinline__ void s5_item(const Params& p, LAS unsigned char* wl  , int item, int lane) {
    const int g = item & 31, bc = item >> 5, c = bc % 132, b = bc / 132;
    const unsigned char* ws = p.ws;
    const bf16_t* qkv = (const bf16_t*)(ws + WS_QKV);
    const float* a_re_p = (const float*)(ws + WS_S5A); const float* a_im_p = a_re_p + 2048;
    const float* bbr = (const float*)(ws + WS_S5BB); const float* bbi = bbr + 2048 * 16;
    float2* E = (float2*)(ws + WS_E);
    const int gp = g * 64 + lane;
    const float ar = a_re_p[gp], ai = a_im_p[gp];
    LAS float* ub = (LAS float*)wl;
    { const size_t row = (size_t)b * LP + 64 * c + lane; const u32x4* up = (const u32x4*)(qkv + row * 2048 + 1536 + 16 * g);
      const u32x4 u0 = up[0], u1 = up[1];
      f32x4 f0 = {bflo(u0.x), bfhi(u0.x), bflo(u0.y), bfhi(u0.y)}, f1 = {bflo(u0.z), bfhi(u0.z), bflo(u0.w), bfhi(u0.w)};
      f32x4 f2 = {bflo(u1.x), bfhi(u1.x), bflo(u1.y), bfhi(u1.y)}, f3 = {bflo(u1.z), bfhi(u1.z), bflo(u1.w), bfhi(u1.w)};
      LAS f32x4* ur = (LAS f32x4*)(ub + lane * 16); ur[0] = f0; ur[1] = f1; ur[2] = f2; ur[3] = f3; }
    float br[16], bi[16];
    { const f32x4* pr = (const f32x4*)(bbr + (size_t)gp * 16); const f32x4* pi = (const f32x4*)(bbi + (size_t)gp * 16);
#pragma unroll
      for (int q = 0; q < 4; ++q) { const f32x4 vr = pr[q], vi = pi[q];
#pragma unroll
          for (int e = 0; e < 4; ++e) { br[4 * q + e] = vr[e]; bi[4 * q + e] = vi[e]; } } }
    float xr = 0.f, xi = 0.f;
    if (FINAL) {
        float pr_ = ar, pi_ = ai;
#pragma unroll
        for (int s = 0; s < 6; ++s) { const float nr = pr_ * pr_ - pi_ * pi_, ni = 2.0f * pr_ * pi_; pr_ = nr; pi_ = ni; }
        const float2* Eb = E + ((size_t)b * 132 * 32 + g) * 64 + lane;
        for (int cc = 0; cc < c; ++cc) { const float2 e = Eb[(size_t)cc * 32 * 64]; const float nr = pr_ * xr - pi_ * xi + e.x, ni = pr_ * xi + pi_ * xr + e.y; xr = nr; xi = ni; }
    }
    asm volatile("s_waitcnt lgkmcnt(0)" ::: "memory");
    bf16x8 cf[4];
    float dsk = 0.f;
    if (FINAL) {
        const bf16_t* ct = (const bf16_t*)(ws + WS_S5CT) + ((size_t)g * 16 + (lane & 15)) * 128 + 8 * (lane >> 4);
#pragma unroll
        for (int ks = 0; ks < 4; ++ks) cf[ks] = *(const bf16x8*)(ct + 32 * ks);
        dsk = p.in[22][g * 16 + (lane & 15)];
    }
    LAS bf16_t* X = (LAS bf16_t*)(wl + 4096);
#pragma unroll 1
    for (int sub = 0; sub < 2; ++sub) {
#pragma unroll 4
        for (int tt = 0; tt < 32; ++tt) {
            const LAS f32x4* ur = (const LAS f32x4*)(ub + (32 * sub + tt) * 16);
            float sr = 0.f, si = 0.f;
#pragma unroll
            for (int q = 0; q < 4; ++q) { const f32x4 uv = ur[q];
#pragma unroll
                for (int e = 0; e < 4; ++e) { sr += uv[e] * br[4 * q + e]; si += uv[e] * bi[4 * q + e]; } }
            const float nr = ar * xr - ai * xi + sr, ni = ar * xi + ai * xr + si; xr = nr; xi = ni;
            if (FINAL) { X[tt * 136 + lane] = (bf16_t)f2bf(xr); X[tt * 136 + 64 + lane] = (bf16_t)f2bf(xi); }
        }
        if (FINAL) {
            asm volatile("s_waitcnt lgkmcnt(0)" ::: "memory");
            bf16_t* Y = (bf16_t*)(ws + WS_Y);
#pragma unroll
            for (int mb = 0; mb < 2; ++mb) {
                f32x4 acc = {0.f, 0.f, 0.f, 0.f};
#pragma unroll
                for (int ks = 0; ks < 4; ++ks) { const bf16x8 af = *(const LAS bf16x8*)((const LAS unsigned char*)X + (16 * mb + (lane & 15)) * 272 + 64 * ks + 16 * (lane >> 4));
                    acc = __builtin_amdgcn_mfma_f32_16x16x32_bf16(af, cf[ks], acc, 0, 0, 0); }
#pragma unroll
                for (int i2 = 0; i2 < 4; ++i2) { const int t = 32 * sub + 16 * mb + 4 * (lane >> 4) + i2;
                    const float yv = acc[i2] + dsk * ub[t * 16 + (lane & 15)];
                    Y[((size_t)b * LP + 64 * c + t) * 512 + 16 * g + (lane & 15)] = (bf16_t)f2bf(gelu_tanh_f(yv)); }
            }
            asm volatile("s_waitcnt lgkmcnt(0)" ::: "memory");
        }
    }
    if (!FINAL) E[((size_t)(b * 132 + c) * 32 + g) * 64 + lane] = make_float2(xr, xi);
}
#ifndef REP1
#define REP1 1
#endif
#ifndef REP2
#define REP2 1
#endif
#ifndef REP4
#define REP4 1
#endif
#ifndef REP6
#define REP6 1
#endif
#ifndef REP7
#define REP7 1
#endif
#ifndef REP8
#define REP8 1
#endif
#ifndef REP9
#define REP9 1
#endif
#ifndef REP11
#define REP11 1
#endif
__global__ void __launch_bounds__(NTHR, 2) mega_fwd(Params p) {
    extern __shared__ __attribute__((aligned(16))) unsigned char lds_raw[];
    LAS unsigned char* lds = (LAS unsigned char*)lds_raw;
    cg::grid_group grid = cg::this_grid();
    const int tid = threadIdx.x, lane = tid & 63, wave = __builtin_amdgcn_readfirstlane(tid >> 6);
    const int G = gridDim.x, gw = blockIdx.x * NW + wave, NGW = G * NW;
    unsigned char* ws = p.ws;
    unsigned* ctl = (unsigned*)(ws + WS_CTL);
    float* ssq = (float*)(ws + WS_SSQ);
    float* Fb = (float*)(ws + WS_F);
    float* H = (float*)(ws + WS_H);
    bf16_t* HB = (bf16_t*)(ws + WS_HB);
    bf16_t* QKV = (bf16_t*)(ws + WS_QKV);
    bf16_t* CAT = (bf16_t*)((unsigned char*)p.out + DO_CAT);
    float* STASH = (float*)((unsigned char*)p.out + DO_STASH);
    const int lo = p.ph_lo, hi_ph = p.ph_hi;
#ifndef PHMASK
#define PHMASK 0x3fff
#endif
#define IN(k) (((PHMASK >> (k)) & 1) && lo <= (k) && (k) < hi_ph)
#define SEAM(k) do { if (IN(k) && IN((k) + 1)) grid.sync(); } while (0)

    if (IN(0)) {
        if (blockIdx.x == 0 && tid < 256) ctl[tid] = 0u;
        for (int i = blockIdx.x * NTHR + tid; i < 3 * MROWS; i += G * NTHR) ssq[MROWS + i] = 0.f;
        for (int row = gw; row < MROWS; row += NGW) {
            const int b = row / LP, pos = row % LP;
            f32x4 v[4]; float s = 0.f;
            if (pos < PADR) {
#pragma unroll
                for (int j = 0; j < 4; ++j) v[j] = (f32x4){0.f, 0.f, 0.f, 0.f};
            } else {
                const float* src = (pos < 256) ? (p.in[1] + (size_t)(pos - PADR) * DM) : (p.in[0] + ((size_t)b * SEQ + (pos - 256)) * DM);
#pragma unroll
                for (int j = 0; j < 4; ++j) { v[j] = ((const f32x4*)src)[lane + 64 * j]; s += (v[j][0] * v[j][0] + v[j][1] * v[j][1]) + (v[j][2] * v[j][2] + v[j][3] * v[j][3]); }
            }
            s = wave_sum(s);
#pragma unroll
            for (int j = 0; j < 4; ++j) { ((f32x4*)(H + (size_t)row * DM))[lane + 64 * j] = v[j];
                u32x2 w; w.x = pk2(v[j][0], v[j][1]); w.y = pk2(v[j][2], v[j][3]); ((u32x2*)(HB + (size_t)row * DM))[lane + 64 * j] = w; }
            if (lane == 0) ssq[row] = s;
        }
        {
            LAS float* scr = (LAS float*)(lds + wave * 16384);
            const float* nmg = p.in[2]; const float* nfg = p.in[3];
            constexpr int I0 = 16 * 96, I1 = 16 * 32, I2 = 16 * 176, I3 = 44 * 32, I4 = 16 * 65, I5 = 8 * 16, I6 = 16 * 32, I7 = 16 * 176, I8 = 44 * 32;
            constexpr int NIT = I0 + I1 + I2 + I3 + I4 + I5 + I6 + I7 + I8;
            for (int it = gw; it < NIT; it += NGW) {
                int r = it;
                if (r < I0) { transpose_item(p.in[5], 1024, 3072, nmg, (bf16_t*)(ws + WS_W0IN), 1, scr, r, lane); continue; } r -= I0;
                if (r < I1) { transpose_item(p.in[6], 1024, 1024, nullptr, (bf16_t*)(ws + WS_W0OUT), 0, scr, r, lane); continue; } r -= I1;
                if (r < I2) { transpose_item(p.in[25], 1024, 5632, nfg, (bf16_t*)(ws + WS_WGU0), 3, scr, r, lane); continue; } r -= I2;
                if (r < I3) { transpose_item(p.in[26], 2816, 1024, nullptr, (bf16_t*)(ws + WS_WDN0), 0, scr, r, lane); continue; } r -= I3;
                if (r < I4) { transpose_item(p.in[12], 1024, 2056, nmg + 1024, (bf16_t*)(ws + WS_W1IN), 2, scr, r, lane); continue; } r -= I4;
                if (r < I5) { transpose_item(p.in[23], 512, 512, nullptr, (bf16_t*)(ws + WS_WGLU), 0, scr, r, lane); continue; } r -= I5;
                if (r < I6) { transpose_item(p.in[13], 1024, 1024, nullptr, (bf16_t*)(ws + WS_W1OUT), 0, scr, r, lane); continue; } r -= I6;
                if (r < I7) { transpose_item(p.in[25] + (size_t)1024 * 5632, 1024, 5632, nfg + 1024, (bf16_t*)(ws + WS_WGU1), 3, scr, r, lane); continue; } r -= I7;
                transpose_item(p.in[26] + (size_t)2816 * 1024, 2816, 1024, nullptr, (bf16_t*)(ws + WS_WDN1), 0, scr, r, lane);
            }
        }
        for (int i = blockIdx.x * NTHR + tid; i < 2048; i += G * NTHR) {
            const int g = i >> 6;
            const float lre = p.in[15][i], lim = p.in[16][i], dt = expf(p.in[17][g]);
            const float mag = expf(lre * dt), are = mag * cosf(lim * dt), aim = mag * sinf(lim * dt), den = lre * lre + lim * lim;
            const float gre = ((are - 1.0f) * lre + aim * lim) / den, gim = (aim * lre - (are - 1.0f) * lim) / den;
            float* ap = (float*)(ws + WS_S5A); ap[i] = are; ap[2048 + i] = aim;
            float* bbr = (float*)(ws + WS_S5BB); float* bbi = bbr + 2048 * 16;
            for (int h = 0; h < 16; ++h) { const float br = p.in[18][i * 16 + h], bi = p.in[19][i * 16 + h]; bbr[i * 16 + h] = gre * br - gim * bi; bbi[i * 16 + h] = gre * bi + gim * br; }
        }
        for (int i = blockIdx.x * NTHR + tid; i < 32 * 16 * 128; i += G * NTHR) {
            const int pp = i & 127, gh = i >> 7;
            const float v = (pp < 64) ? p.in[20][gh * 64 + pp] : -p.in[21][gh * 64 + (pp - 64)];
            ((bf16_t*)(ws + WS_S5CT))[i] = (bf16_t)f2bf(v);
        }
        for (int i = blockIdx.x * NTHR + tid; i < 8 * 1024; i += G * NTHR) {
            const int j = i >> 10, k = i & 1023;
            ((float*)(ws + WS_W1F))[i] = p.in[12][(size_t)k * 2056 + 1536 + j] * p.in[2][1024 + k];
        }
    }
    SEAM(0);

    for (int rep = 0; rep < (IN(1) ? REP1 : 0); ++rep) {
        pg8::Gemm g{HB, (const bf16_t*)(ws + WS_W0IN), MROWS, 3072, 1024}; pg8::StaticOrder S; S.init(MROWS, 3072, G, (int)blockIdx.x);
        pg8::EpiScaleBf16 E{QKV, 3072, ssq};
        pg8::gemm_phase<pg8::EpiScaleBf16, pg8::StaticOrder, true, true>(lds, g, S, E);
    }
    SEAM(1);

    for (int rep = 0; rep < (IN(2) ? REP2 : 0); ++rep) {
        float lam;
        { const float a1 = wave_sum(p.in[7][lane] * p.in[8][lane]), a2 = wave_sum(p.in[9][lane] * p.in[10][lane]); lam = expf(a1) - expf(a2) + 0.2f; }
        constexpr int NDIFF = 16 * 33, NSB = 32 * 33;
        LAS int* misc = (LAS int*)(lds + att::L_MISC);
        for (;;) {
            if (tid == 0) misc[0] = (int)atomicAdd(ctl + rep, 1u);
            __syncthreads();
            const int idx = misc[0];
            __syncthreads();
            if (idx >= NDIFF + NSB) break;
            if (idx < NDIFF) {
#ifndef NO_DIFF
                const int u = 32 - idx / 16, bh = idx % 16, b = bh >> 2, hd = bh & 3;
                const int r32 = lane & 31, hi = lane >> 5;
                f32x4* st = (f32x4*)(STASH + ((size_t)blockIdx.x * NTHR + tid) * 64);
#pragma unroll 1
                for (int comp = 0; comp < 2; ++comp) {
                    att::Args a{QKV, 3072, b * LP, u, 1536 + hd * 128 + comp * 64, 2048 + hd * 128 + comp * 64, 2560 + hd * 128, nullptr, 0.f};
                    f32x16 o[4]; float l;
                    att::run<1, 4, false>(lds, a, o, l);
                    const float inv = 1.0f / l;
                    if (comp == 0) {
#pragma unroll
                        for (int c = 0; c < 4; ++c)
#pragma unroll
                            for (int g4 = 0; g4 < 4; ++g4) st[c * 4 + g4] = (f32x4){o[c][4 * g4] * inv, o[c][4 * g4 + 1] * inv, o[c][4 * g4 + 2] * inv, o[c][4 * g4 + 3] * inv};
                    } else {
                        float ss = 0.f;
#pragma unroll
                        for (int c = 0; c < 4; ++c)
#pragma unroll
                            for (int g4 = 0; g4 < 4; ++g4) { const f32x4 sv = st[c * 4 + g4];
#pragma unroll
                                for (int e = 0; e < 4; ++e) { const float v = sv[e] - lam * (o[c][4 * g4 + e] * inv); o[c][4 * g4 + e] = v; ss += v * v; } }
                        ss += __shfl_xor(ss, 32);
                        const float rs = 0.8f * rsqrtf(ss * (1.0f / 128.0f) + RMS_EPS);
                        const float* sg = p.in[11];
                        bf16_t* op = CAT + (size_t)(b * LP + 256 * u + 32 * wave + r32) * DM + 512 + hd * 128;
#pragma unroll
                        for (int c = 0; c < 4; ++c)
#pragma unroll
                            for (int g4 = 0; g4 < 4; ++g4) { const int dv = 32 * c + 8 * g4 + 4 * hi; const f32x4 gv = *(const f32x4*)(sg + dv);
                                u32x2 w; w.x = pk2(o[c][4 * g4] * rs * gv[0], o[c][4 * g4 + 1] * rs * gv[1]); w.y = pk2(o[c][4 * g4 + 2] * rs * gv[2], o[c][4 * g4 + 3] * rs * gv[3]);
                                *(u32x2*)(op + dv) = w; }
                    }
                }
#endif
            } else {
#ifndef NO_SB
                const int i2 = idx - NDIFF, u = 32 - i2 / 32, bh = i2 % 32, b = bh >> 3, h = bh & 7;
                const int r32 = lane & 31, hi = lane >> 5;
                att::Args a{QKV, 3072, b * LP, u, h * 64, 512 + h * 64, 1024 + h * 64, nullptr, 0.f};
                f32x16 o[2]; float l;
                att::run<0, 2, false>(lds, a, o, l);
                bf16_t* op = CAT + (size_t)(b * LP + 256 * u + 32 * wave + r32) * DM + h * 64;
#pragma unroll
                for (int c = 0; c < 2; ++c)
#pragma unroll
                    for (int g4 = 0; g4 < 4; ++g4) { const int dv = 32 * c + 8 * g4 + 4 * hi;
                        u32x2 w; w.x = pk2(o[c][4 * g4], o[c][4 * g4 + 1]); w.y = pk2(o[c][4 * g4 + 2], o[c][4 * g4 + 3]); *(u32x2*)(op + dv) = w; }
#endif
            }
        }
    }
    SEAM(2);

    if (IN(3)) {
        pg8::Gemm g{CAT, (const bf16_t*)(ws + WS_W0OUT), MROWS, 1024, 1024}; pg8::StaticOrder S; S.init(MROWS, 1024, G, (int)blockIdx.x);
        pg8::EpiResid E{H, HB, ssq + MROWS};
        pg8::gemm_phase<pg8::EpiResid, pg8::StaticOrder, true, true>(lds, g, S, E);
    }
    SEAM(3);
    for (int rep = 0; rep < (IN(4) ? REP4 : 0); ++rep) {
        pg8::Gemm g{HB, (const bf16_t*)(ws + WS_WGU0), MROWS, 5632, 1024}; pg8::StaticOrder S; S.init(MROWS, 5632, G, (int)blockIdx.x);
        pg8::EpiSwiGLU E{QKV, ssq + MROWS};
        pg8::gemm_phase<pg8::EpiSwiGLU, pg8::StaticOrder, true, true>(lds, g, S, E);
    }
    SEAM(4);
    if (IN(5)) {
        pg8::Gemm g{QKV, (const bf16_t*)(ws + WS_WDN0), MROWS, 1024, 2816}; pg8::StaticOrder S; S.init(MROWS, 1024, G, (int)blockIdx.x);
        pg8::EpiResid E{H, HB, ssq + 2 * MROWS};
        pg8::gemm_phase<pg8::EpiResid, pg8::StaticOrder, true, true>(lds, g, S, E);
    }
    SEAM(5);
    for (int rep = 0; rep < (IN(6) ? REP6 : 0); ++rep) {
        {
            pg8::Gemm g{HB, (const bf16_t*)(ws + WS_W1IN), MROWS, 2048, 1024}; pg8::StaticOrder S; S.init(MROWS, 2048, G, (int)blockIdx.x);
            pg8::EpiScaleBf16 E{QKV, 2048, ssq + 2 * MROWS};
            pg8::gemm_phase<pg8::EpiScaleBf16, pg8::StaticOrder, true, true>(lds, g, S, E);
        }
        const float* w1f = (const float*)(ws + WS_W1F);
        for (int row = gw; row < MROWS; row += NGW) {
            const int b = row / LP, pos = row % LP;
            f32x4 v[4];
#pragma unroll
            for (int j = 0; j < 4; ++j) v[j] = ((const f32x4*)(H + (size_t)row * DM))[lane + 64 * j];
            const float rs = rsqrtf(ssq[2 * MROWS + row] * (1.0f / 1024.0f) + RMS_EPS);
            float mine = 0.f;
#pragma unroll
            for (int hh = 0; hh < 8; ++hh) {
                float d = 0.f;
#pragma unroll
                for (int j = 0; j < 4; ++j) { const f32x4 wv = ((const f32x4*)(w1f + hh * 1024))[lane + 64 * j]; d += (v[j][0] * wv[0] + v[j][1] * wv[1]) + (v[j][2] * wv[2] + v[j][3] * wv[3]); }
                d = wave_sum(d);
                if (lane == hh) mine = d;
            }
            if (lane < 8) Fb[((size_t)b * 8 + lane) * LP + pos] = log_sigmoid_f(mine * rs + p.in[14][lane]);
        }
    }
    SEAM(6);
    for (int rep = 0; rep < (IN(7) ? REP7 : 0); ++rep) {
        LAS float* sc = (LAS float*)lds;
        for (int chain = blockIdx.x; chain < (rep == 0 ? 32 : 0); chain += G) {
            float* Fc = Fb + (size_t)chain * LP;
            { float km = 0.f; const int cb = chain >> 3, ch = chain & 7;
              for (int j = 0; j < 17; ++j) { const int idx = tid * 17 + j; if (idx < LP) { const u32x4* kp = (const u32x4*)(QKV + ((size_t)cb * LP + idx) * 2048 + 512 + ch * 64); float s2 = 0.f;
#pragma unroll
                  for (int q4 = 0; q4 < 8; ++q4) { const u32x4 kv = kp[q4]; const float e0 = bflo(kv.x), e1 = bfhi(kv.x), e2 = bflo(kv.y), e3 = bfhi(kv.y), e4 = bflo(kv.z), e5 = bfhi(kv.z), e6 = bflo(kv.w), e7 = bfhi(kv.w);
                      s2 += (e0 * e0 + e1 * e1) + (e2 * e2 + e3 * e3) + (e4 * e4 + e5 * e5) + (e6 * e6 + e7 * e7); }
                  km = fmaxf(km, s2); } }
#pragma unroll
              for (int o2 = 32; o2 >= 1; o2 >>= 1) km = fmaxf(km, __shfl_xor(km, o2));
              if (lane == 0) sc[512 + wave] = km;
              __syncthreads();
              if (tid == 0) { float m8 = sc[512]; for (int w8 = 1; w8 < 8; ++w8) m8 = fmaxf(m8, sc[512 + w8]); ((float*)(ws + WS_CTL + 4096))[chain] = m8; }
              __syncthreads(); }
            float loc[17]; float run = 0.f;
#pragma unroll
            for (int j = 0; j < 17; ++j) { const int idx = tid * 17 + j; const float v = (idx < LP) ? Fc[idx] : 0.f; run += v; loc[j] = run; }
            sc[tid] = run;
            __syncthreads();
            for (int off = 1; off < NTHR; off <<= 1) { const float v = sc[tid] + ((tid >= off) ? sc[tid - off] : 0.f); __syncthreads(); sc[tid] = v; __syncthreads(); }
            const float base = sc[tid] - run;
#pragma unroll
            for (int j = 0; j < 17; ++j) { const int idx = tid * 17 + j; if (idx < LP) Fc[idx] = base + loc[j]; }
            __syncthreads();
        }
        __syncthreads();
        for (int it = gw; it < 4 * 132 * 32; it += NGW) s5_item<false>(p, lds + 1024 * 16 + wave * 13312, it, lane);
    }
    SEAM(7);
    for (int rep = 0; rep < (IN(8) ? REP8 : 0); ++rep) {
        for (int it = gw; it < 4 * 132 * 32; it += NGW) s5_item<true>(p, lds + 1024 * 16 + wave * 13312, it, lane);
        __syncthreads();
        constexpr int NFOX = 32 * 33;
        LAS int* misc = (LAS int*)(lds + att::L_MISC);
        for (;;) {
            if (tid == 0) misc[0] = (int)atomicAdd(ctl + 64 + rep, 1u);
            __syncthreads();
            const int idx = misc[0];
            __syncthreads();
            if (idx >= NFOX) break;
            const int u = 32 - idx / 32, bh = idx % 32, b = bh >> 3, h = bh & 7;
            const int r32 = lane & 31, hi = lane >> 5;
            att::Args a{QKV, 2048, b * LP, u, h * 64, 512 + h * 64, 1024 + h * 64, Fb + (size_t)bh * LP, sqrtf(((const float*)(ws + WS_CTL + 4096))[bh])};
            f32x16 o[2]; float l;
            att::run<1, 2, true>(lds, a, o, l);
            const float inv = 1.0f / l;
            bf16_t* op = CAT + (size_t)(b * LP + 256 * u + 32 * wave + r32) * DM + h * 64;
#pragma unroll
            for (int c = 0; c < 2; ++c)
#pragma unroll
                for (int g4 = 0; g4 < 4; ++g4) { const int dv = 32 * c + 8 * g4 + 4 * hi;
                    u32x2 w; w.x = pk2(o[c][4 * g4] * inv, o[c][4 * g4 + 1] * inv); w.y = pk2(o[c][4 * g4 + 2] * inv, o[c][4 * g4 + 3] * inv); *(u32x2*)(op + dv) = w; }
        }
    }
    SEAM(8);
    for (int rep = 0; rep < (IN(9) ? REP9 : 0); ++rep) {
        pg8::Gemm g{(const bf16_t*)(ws + WS_Y), (const bf16_t*)(ws + WS_WGLU), MROWS, 512, 512}; pg8::StaticOrder S; S.init(MROWS, 512, G, (int)blockIdx.x);
        pg8::EpiGLU E{(const bf16_t*)(ws + WS_Y), p.in[24], CAT};
        pg8::gemm_phase<pg8::EpiGLU, pg8::StaticOrder, true, true>(lds, g, S, E);
    }
    SEAM(9);
    if (IN(10)) {
        pg8::Gemm g{CAT, (const bf16_t*)(ws + WS_W1OUT), MROWS, 1024, 1024}; pg8::StaticOrder S; S.init(MROWS, 1024, G, (int)blockIdx.x);
        pg8::EpiResid E{H, HB, ssq + 3 * MROWS};
        pg8::gemm_phase<pg8::EpiResid, pg8::StaticOrder, true, true>(lds, g, S, E);
    }
    SEAM(10);
    for (int rep = 0; rep < (IN(11) ? REP11 : 0); ++rep) {
        pg8::Gemm g{HB, (const bf16_t*)(ws + WS_WGU1), MROWS, 5632, 1024}; pg8::StaticOrder S; S.init(MROWS, 5632, G, (int)blockIdx.x);
        pg8::EpiSwiGLU E{QKV, ssq + 3 * MROWS};
        pg8::gemm_phase<pg8::EpiSwiGLU, pg8::StaticOrder, true, true>(lds, g, S, E);
    }
    SEAM(11);
    if (IN(12)) {
        pg8::Gemm g{QKV, (const bf16_t*)(ws + WS_WDN1), MROWS, 1024, 2816}; pg8::StaticOrder S; S.init(MROWS, 1024, G, (int)blockIdx.x);
        pg8::EpiResid E{H, HB, nullptr};
        pg8::gemm_phase<pg8::EpiResid, pg8::StaticOrder, true, true>(lds, g, S, E);
    }
    SEAM(12);
    if (IN(13)) {
        const float* fg = p.in[4];
        for (int r = gw; r < NBATCH * SEQ; r += NGW) {
            const int b = r / SEQ, t = r % SEQ; const size_t row = (size_t)b * LP + 256 + t;
            f32x4 v[4]; float s = 0.f;
#pragma unroll
            for (int j = 0; j < 4; ++j) { v[j] = ((const f32x4*)(H + row * DM))[lane + 64 * j]; s += (v[j][0] * v[j][0] + v[j][1] * v[j][1]) + (v[j][2] * v[j][2] + v[j][3] * v[j][3]); }
            const float rs = rsqrtf(wave_sum(s) * (1.0f / 1024.0f) + RMS_EPS);
#pragma unroll
            for (int j = 0; j < 4; ++j) { const f32x4 gv = ((const f32x4*)fg)[lane + 64 * j]; ((f32x4*)(p.out + (size_t)r * DM))[lane + 64 * j] = v[j] * rs * gv; }
        }
    }
#undef IN
#undef SEAM
}

#ifndef N_LAUNCH_MODE
#define N_LAUNCH_MODE 1
#endif
extern "C" void kernel_launch(void* const* d_in, const int* in_sizes, int n_in, void* d_out, int out_size, void* d_ws, size_t ws_size, hipStream_t stream) {
    static int grid = 0;
    if (grid == 0) {
        if (n_in != 27 || ws_size < WS_END || out_size != NBATCH * SEQ * DM) { fprintf(stderr, "kernel_launch: unexpected shapes (n_in %d, ws %zu, out %d)\n", n_in, ws_size, out_size); grid = -1; return; }
        int dev = 0, cus = 0, per_cu = 0;
        (void)hipGetDevice(&dev); (void)hipDeviceGetAttribute(&cus, hipDeviceAttributeMultiprocessorCount, dev);
        if (hipFuncSetAttribute((const void*)mega_fwd, hipFuncAttributeMaxDynamicSharedMemorySize, LDS_BYTES) != hipSuccess) { fprintf(stderr, "kernel_launch: hipFuncSetAttribute failed\n"); grid = -1; return; }
        if (hipOccupancyMaxActiveBlocksPerMultiprocessor(&per_cu, (const void*)mega_fwd, NTHR, LDS_BYTES) != hipSuccess || per_cu < 1) { fprintf(stderr, "kernel_launch: occupancy query says %d\n", per_cu); per_cu = 1; }
        (void)hipGetLastError();
        grid = cus * 1;
        if (grid <= 0) grid = 256;
    }
    if (grid < 0) return;
    Params p{};
    for (int i = 0; i < 27; ++i) p.in[i] = (const float*)d_in[i];
    p.out = (float*)d_out; p.ws = (unsigned char*)d_ws;
#if N_LAUNCH_MODE == 1
    p.ph_lo = 0; p.ph_hi = 14;
    void* args[] = {&p};
    hipError_t e = hipLaunchCooperativeKernel((const void*)mega_fwd, dim3(grid), dim3(NTHR), args, LDS_BYTES, stream);
    if (e != hipSuccess) fprintf(stderr, "cooperative launch failed: %s (grid %d)\n", hipGetErrorString(e), grid);
#else
    for (int ph = 0; ph < 14; ++ph) { p.ph_lo = ph; p.ph_hi = ph + 1; hipLaunchKernelGGL(mega_fwd, dim3(grid), dim3(NTHR), LDS_BYTES, stream, p); }
#endif
}
```

```cpp
#include <hip/hip_runtime.h>
#include <hip/hip_cooperative_groups.h>
#include <cstdio>
#include <cstdint>
namespace cg = cooperative_groups;

#define LAS __attribute__((address_space(3)))
constexpr int DM = 1024, NBATCH = 4, SEQ = 8192, LP = 8448, PADR = 240, NMETA = 16, MROWS = NBATCH * LP;
constexpr int DFF = 2816, NW = 8, NTHR = 512;
constexpr float C2 = 0.125f * 1.4426950408889634f;
constexpr float LOG2E = 1.4426950408889634f;
constexpr float RMS_EPS = 1e-6f;
constexpr int LDS_BYTES = 147456;

constexpr size_t MiB = 1u << 20;
constexpr size_t WS_CTL = 0;
constexpr size_t WS_SSQ = 1 * MiB;
constexpr size_t WS_F = 2 * MiB;
constexpr size_t WS_S5A = 4 * MiB;
constexpr size_t WS_S5BB = 4 * MiB + 65536;
constexpr size_t WS_S5CT = 4 * MiB + 65536 + 262144;
constexpr size_t WS_W1F = 4 * MiB + 65536 + 262144 + 131072;
constexpr size_t WS_W0IN = 6 * MiB, WS_W0OUT = 12 * MiB, WS_WGU0 = 14 * MiB, WS_WDN0 = 25 * MiB, WS_W1IN = 31 * MiB, WS_WGLU = 35 * MiB, WS_W1OUT = 36 * MiB, WS_WGU1 = 38 * MiB, WS_WDN1 = 49 * MiB;
constexpr size_t WS_H = 56 * MiB;
constexpr size_t WS_HB = 188 * MiB;
constexpr size_t WS_QKV = 254 * MiB;
constexpr size_t WS_Y = 386 * MiB;
constexpr size_t WS_E = 419 * MiB;
constexpr size_t WS_END = 452 * MiB;
constexpr size_t DO_CAT = 0, DO_STASH = 66 * MiB;

typedef unsigned short bf16_t;
typedef short bf16x8 __attribute__((ext_vector_type(8)));
typedef float f32x4 __attribute__((ext_vector_type(4)));
typedef float f32x16 __attribute__((ext_vector_type(16)));
typedef unsigned u32x4 __attribute__((ext_vector_type(4)));
typedef unsigned u32x2 __attribute__((ext_vector_type(2)));
typedef short v4i16_t __attribute__((ext_vector_type(4)));

__device__ __forceinline__ unsigned f2bf(float f) { unsigned u = __builtin_bit_cast(unsigned, f); return (u + 0x7fffu + ((u >> 16) & 1u)) >> 16; }
__device__ __forceinline__ unsigned pk2(float lo, float hi) { return f2bf(lo) | (f2bf(hi) << 16); }
__device__ __forceinline__ float bf2f(unsigned short b) { return __builtin_bit_cast(float, (unsigned)b << 16); }
__device__ __forceinline__ float bflo(unsigned w) { return __builtin_bit_cast(float, w << 16); }
__device__ __forceinline__ float bfhi(unsigned w) { return __builtin_bit_cast(float, w & 0xffff0000u); }
__device__ __forceinline__ float wave_sum(float v) {
#pragma unroll
    for (int o = 32; o >= 1; o >>= 1) v += __shfl_xor(v, o);
    return v;
}
__device__ __forceinline__ float fexp2(float x) { return __builtin_amdgcn_exp2f(x); }
__device__ __forceinline__ float flog2(float x) { return __builtin_amdgcn_logf(x); }
namespace pg8 {
#define PG8_LAS __attribute__((address_space(3)))
typedef unsigned short bf16_t;
typedef short bf16x8 __attribute__((ext_vector_type(8)));
typedef float f32x4 __attribute__((ext_vector_type(4)));
typedef unsigned u32x4 __attribute__((ext_vector_type(4)));
constexpr int BM = 256, BK = 64, HALF = 128, HTB = HALF * BK * 2  , STAGE_BYTES = 8 * HTB, NXCD = 8, WGM = 8;

__host__ __device__ __forceinline__ int lds_byte(int r, int c) { const int st = (r >> 4) * 2 + (c >> 5), rr = r & 15, cc = c & 31, ob = rr * 64 + cc * 2; return st * 1024 + (ob ^ (((ob >> 9) & 1) << 5)); }
__host__ __device__ __forceinline__ void stage_rc(int b, int& R, int& C) { const int st = b / 1024, sb = b % 1024, swz = sb ^ (((sb >> 9) & 1) << 5); R = (st >> 1) * 16 + swz / 64; C = (st & 1) * 32 + (swz % 64) / 2; }
__host__ __device__ __forceinline__ int perm32(int rho) { const int n = rho >> 4, i = rho & 15; return 8 * (i >> 2) + 4 * n + (i & 3); }

struct Unit { int pm, pn; };
struct Gemm { const bf16_t* A; const bf16_t* Bt; int M, N, K; };

struct StaticOrder {
    int nM, nN, nwg, G, c;
    __host__ __device__ void init(int M, int N, int G_, int c_) { nM = M / BM; nN = N / BM; nwg = nM * nN; G = G_; c = c_; }
    __host__ __device__ bool next(int i, Unit& u) const {
        const long L = (long)i * G + c; if (L >= nwg) return false;
        int wgid = (int)L; { const int q = nwg / NXCD, r = nwg % NXCD, xcd = wgid % NXCD, off = wgid / NXCD; wgid = (xcd < r ? xcd * (q + 1) : r * (q + 1) + (xcd - r) * q) + off; }
        const int nig = WGM * nN, gid = wgid / nig, fm = gid * WGM, gsz = (nM - fm) < WGM ? (nM - fm) : WGM;
        u.pm = fm + ((wgid % nig) % gsz); u.pn = (wgid % nig) / gsz;
        u.pm = u.pm + (u.pm >> 5) + 1;
        return true;
    }
    __device__ __forceinline__ void a_ready(const Unit&) const {}
    __device__ __forceinline__ void done(const Unit&) const {}
};
__device__ __forceinline__ unsigned cvt_pk_bf16(float lo, float hi) { unsigned r; asm volatile("v_cvt_pk_bf16_f32 %0, %1, %2" : "=v"(r) : "v"(lo), "v"(hi)); return r; }
typedef float f32x2 __attribute__((ext_vector_type(2)));
struct EpiScaleBf16 {
    static constexpr bool PERM = true, AFTER_DRAIN = false;
    bf16_t* O; int ldc; const float* ssq;
    __device__ __forceinline__ void operator()(const f32x4 (&acc)[2][2][4][2], const Unit& u, int wr, int wc, int fr, int fq) const {
        const int col0 = u.pn * BM + wc * 32 + 8 * fq;
#pragma unroll
        for (int ai = 0; ai < 2; ++ai)
#pragma unroll
            for (int m = 0; m < 4; ++m) {
                const int row = u.pm * BM + ai * HALF + wr * 64 + m * 16 + fr;
                const float rs = __builtin_amdgcn_rsqf(__hip_atomic_load(ssq + row, __ATOMIC_RELAXED, __HIP_MEMORY_SCOPE_AGENT) * (1.0f / 1024.0f) + 1e-6f);
                bf16_t* rowp = O + (size_t)row * ldc + col0;
#pragma unroll
                for (int bj = 0; bj < 2; ++bj) { const f32x4 v0 = acc[ai][bj][m][0] * rs, v1 = acc[ai][bj][m][1] * rs;
                    u32x4 w; w.x = cvt_pk_bf16(v0[0], v0[1]); w.y = cvt_pk_bf16(v0[2], v0[3]); w.z = cvt_pk_bf16(v1[0], v1[1]); w.w = cvt_pk_bf16(v1[2], v1[3]);
                    *(u32x4*)(rowp + bj * HALF) = w; } }
    }
};
struct EpiResid {
    static constexpr bool PERM = true, AFTER_DRAIN = false;
    float* h; bf16_t* hb; float* ssq;
    __device__ __forceinline__ void operator()(const f32x4 (&acc)[2][2][4][2], const Unit& u, int wr, int wc, int fr, int fq) const {
        const int col0 = u.pn * BM + wc * 32 + 8 * fq;
#pragma unroll
        for (int ai = 0; ai < 2; ++ai)
#pragma unroll
            for (int m = 0; m < 4; ++m) {
                const int row = u.pm * BM + ai * HALF + wr * 64 + m * 16 + fr;
                const bool valid = (row % 8448) >= 240;
                float ss = 0.f;
#pragma unroll
                for (int bj = 0; bj < 2; ++bj) {
                    float* hp = h + (size_t)row * 1024 + col0 + bj * HALF;
                    f32x4 v0 = *(const f32x4*)hp + acc[ai][bj][m][0], v1 = *(const f32x4*)(hp + 4) + acc[ai][bj][m][1];
                    if (!valid) { v0 = (f32x4){0.f, 0.f, 0.f, 0.f}; v1 = v0; }
                    *(f32x4*)hp = v0; *(f32x4*)(hp + 4) = v1;
                    u32x4 w; w.x = cvt_pk_bf16(v0[0], v0[1]); w.y = cvt_pk_bf16(v0[2], v0[3]); w.z = cvt_pk_bf16(v1[0], v1[1]); w.w = cvt_pk_bf16(v1[2], v1[3]);
                    *(u32x4*)(hb + (size_t)row * 1024 + col0 + bj * HALF) = w;
                    ss += (v0[0] * v0[0] + v0[1] * v0[1]) + (v0[2] * v0[2] + v0[3] * v0[3]) + (v1[0] * v1[0] + v1[1] * v1[1]) + (v1[2] * v1[2] + v1[3] * v1[3]);
                }
                ss += __shfl_xor(ss, 16); ss += __shfl_xor(ss, 32);
                if (fq == 0 && ssq) atomicAdd(ssq + row, ss);
            }
    }
};
struct EpiSwiGLU {
    static constexpr bool PERM = true, AFTER_DRAIN = false;
    bf16_t* O; const float* ssq;
    __device__ __forceinline__ void operator()(const f32x4 (&acc)[2][2][4][2], const Unit& u, int wr, int wc, int fr, int fq) const {
        const int col0 = u.pn * BM + wc * 32 + 8 * fq;
#pragma unroll
        for (int ai = 0; ai < 2; ++ai)
#pragma unroll
            for (int m = 0; m < 4; ++m) {
                const int row = u.pm * BM + ai * HALF + wr * 64 + m * 16 + fr;
                const float rs = __builtin_amdgcn_rsqf(__hip_atomic_load(ssq + row, __ATOMIC_RELAXED, __HIP_MEMORY_SCOPE_AGENT) * (1.0f / 1024.0f) + 1e-6f);
#pragma unroll
                for (int bj = 0; bj < 2; ++bj) { const f32x4 g = acc[ai][bj][m][0] * rs, up = acc[ai][bj][m][1] * rs; float a[4];
#pragma unroll
                    for (int e = 0; e < 4; ++e) a[e] = g[e] * __builtin_amdgcn_rcpf(1.0f + __builtin_amdgcn_exp2f(-1.4426950408889634f * g[e])) * up[e];
                    u32x2 w; w.x = cvt_pk_bf16(a[0], a[1]); w.y = cvt_pk_bf16(a[2], a[3]);
                    *(u32x2*)(O + (size_t)row * 2816 + ((col0 + bj * HALF) >> 1)) = w; } }
    }
};
struct EpiGLU {
    static constexpr bool PERM = true, AFTER_DRAIN = false;
    const bf16_t* Y; const float* bias; bf16_t* O;
    __device__ __forceinline__ void operator()(const f32x4 (&acc)[2][2][4][2], const Unit& u, int wr, int wc, int fr, int fq) const {
        const int col0 = u.pn * BM + wc * 32 + 8 * fq;
#pragma unroll
        for (int ai = 0; ai < 2; ++ai)
#pragma unroll
            for (int m = 0; m < 4; ++m) {
                const int row = u.pm * BM + ai * HALF + wr * 64 + m * 16 + fr;
#pragma unroll
                for (int bj = 0; bj < 2; ++bj) { const int col = col0 + bj * HALF;
                    const u32x4 yv = *(const u32x4*)(Y + (size_t)row * 512 + col);
                    const f32x4 b0 = *(const f32x4*)(bias + col), b1 = *(const f32x4*)(bias + col + 4);
                    const f32x4 z0 = acc[ai][bj][m][0] + b0, z1 = acc[ai][bj][m][1] + b1; float o[8];
                    const float yy[8] = {__builtin_bit_cast(float, yv.x << 16), __builtin_bit_cast(float, yv.x & 0xffff0000u), __builtin_bit_cast(float, yv.y << 16), __builtin_bit_cast(float, yv.y & 0xffff0000u),
                                         __builtin_bit_cast(float, yv.z << 16), __builtin_bit_cast(float, yv.z & 0xffff0000u), __builtin_bit_cast(float, yv.w << 16), __builtin_bit_cast(float, yv.w & 0xffff0000u)};
#pragma unroll
                    for (int e = 0; e < 4; ++e) { o[e] = yy[e] * __builtin_amdgcn_rcpf(1.0f + __builtin_amdgcn_exp2f(-1.4426950408889634f * z0[e])); o[4 + e] = yy[4 + e] * __builtin_amdgcn_rcpf(1.0f + __builtin_amdgcn_exp2f(-1.4426950408889634f * z1[e])); }
                    u32x4 w; w.x = cvt_pk_bf16(o[0], o[1]); w.y = cvt_pk_bf16(o[2], o[3]); w.z = cvt_pk_bf16(o[4], o[5]); w.w = cvt_pk_bf16(o[6], o[7]);
                    *(u32x4*)(O + (size_t)row * 1024 + 512 + col) = w; } }
    }
};
template <class Epi, class Sched, bool ALIGN_EPI = false, bool SP2 = false>
__device__ __forceinline__ void gemm_phase(PG8_LAS unsigned char* lds, const Gemm g, const Sched& S, const Epi& E) {
    int tid_l = threadIdx.x; asm volatile("" : "+v"(tid_l));
    const int tid = tid_l, wid = __builtin_amdgcn_readfirstlane(tid >> 6), lane = tid & 63, wr = wid >> 2, wc = wid & 3, fr = lane & 15, fq = lane >> 4;
    const int K = g.K, nt = K / BK;
    unsigned voffA[2], voffB[2];
#pragma unroll
    for (int i = 0; i < 2; ++i) { int R, C; stage_rc(tid * 16 + i * 8192, R, C); const int Rb = Epi::PERM ? ((R & ~31) + perm32(R & 31)) : R;
        voffA[i] = (unsigned)(R * K + C) * 2u; voffB[i] = (unsigned)(Rb * K + C) * 2u; }
    const size_t kstep = (size_t)(BK * 2);
    const size_t hstep = (size_t)HALF * K * 2;
    const size_t tstep = 2 * hstep;
    const unsigned ldsw = (unsigned)wid * 1024u;
    const int aoff = lds_byte(wr * 64 + fr, fq * 8), boff = lds_byte(wc * 32 + fr, fq * 8);
#define PG8_SA(b, h) (((b) * 2 + (h)) * HTB)
#define PG8_SB(b, h) ((4 + (b) * 2 + (h)) * HTB)
#define PG8_STAGE(bufoff, gbase, voff) do { _Pragma("unroll") for (int _i = 0; _i < 2; ++_i) \
        __builtin_amdgcn_global_load_lds((const unsigned*)((const char*)(gbase) + (voff)[_i]), (PG8_LAS unsigned*)(lds + (bufoff) + ldsw + _i * 8192), 16, 0, 0); } while (0)
#define PG8_LDA(dst, b, h) do { _Pragma("unroll") for (int m = 0; m < 4; ++m) _Pragma("unroll") for (int k = 0; k < 2; ++k) dst[m][k] = *(const PG8_LAS bf16x8*)(lds + PG8_SA(b, h) + aoff + m * 2048 + k * 1024); } while (0)
#define PG8_LDB(dst, b, h) do { _Pragma("unroll") for (int n = 0; n < 2; ++n) _Pragma("unroll") for (int k = 0; k < 2; ++k) dst[n][k] = *(const PG8_LAS bf16x8*)(lds + PG8_SB(b, h) + boff + n * 2048 + k * 1024); } while (0)
#define PG8_MMA(ai, bj, At, Bt) do { __builtin_amdgcn_s_setprio(1); _Pragma("unroll") for (int m = 0; m < 4; ++m) _Pragma("unroll") for (int n = 0; n < 2; ++n) _Pragma("unroll") for (int k = 0; k < 2; ++k) \
        acc[ai][bj][m][n] = __builtin_amdgcn_mfma_f32_16x16x32_bf16(Bt[n][k], At[m][k], acc[ai][bj][m][n], 0, 0, 0); __builtin_amdgcn_s_setprio(0); } while (0)
#define PG8_WAIT_V(n) asm volatile("s_waitcnt vmcnt(" #n ")" ::: "memory")
#define PG8_WAIT_L(n) asm volatile("s_waitcnt lgkmcnt(" #n ")" ::: "memory")
#define PG8_BAR __builtin_amdgcn_s_barrier()
#define PG8_SCHED __builtin_amdgcn_sched_barrier(0)
    Unit cur, nxt; int ui = 0;
    if (!S.next(0, cur)) return;
    f32x4 acc[2][2][4][2];
#pragma unroll
    for (int a = 0; a < 2; ++a)
#pragma unroll
        for (int b = 0; b < 2; ++b)
#pragma unroll
            for (int m = 0; m < 4; ++m)
#pragma unroll
                for (int n = 0; n < 2; ++n) acc[a][b][m][n] = (f32x4){0.f, 0.f, 0.f, 0.f};
    bf16x8 At[4][2], B0[2][2], B1[2][2];
    const char* cA = (const char*)g.A + (size_t)cur.pm * tstep; const char* cB = (const char*)g.Bt + (size_t)cur.pn * tstep;
    S.a_ready(cur);
    if constexpr (SP2) {
        PG8_STAGE(PG8_SB(0, 0), cB, voffB); PG8_STAGE(PG8_SB(0, 1), cB + hstep, voffB); PG8_STAGE(PG8_SA(0, 0), cA, voffA); PG8_STAGE(PG8_SA(0, 1), cA + hstep, voffA);
        if (wr == 1) PG8_BAR;
        PG8_WAIT_V(2); PG8_BAR;
        PG8_STAGE(PG8_SB(1, 0), cB + kstep, voffB); PG8_STAGE(PG8_SA(1, 0), cA + kstep, voffA); PG8_STAGE(PG8_SB(1, 1), cB + hstep + kstep, voffB);
        PG8_WAIT_V(6); PG8_BAR;
    } else {
        PG8_STAGE(PG8_SB(0, 0), cB, voffB); PG8_STAGE(PG8_SA(0, 0), cA, voffA); PG8_STAGE(PG8_SB(0, 1), cB + hstep, voffB); PG8_STAGE(PG8_SA(0, 1), cA + hstep, voffA);
        if (wr == 1) PG8_BAR;
        PG8_WAIT_V(4); PG8_BAR;
        PG8_STAGE(PG8_SB(1, 0), cB + kstep, voffB); PG8_STAGE(PG8_SA(1, 0), cA + kstep, voffA); PG8_STAGE(PG8_SB(1, 1), cB + hstep + kstep, voffB);
        PG8_WAIT_V(6); PG8_BAR;
    }
    for (;;) {
        const bool has_next = S.next(ui + 1, nxt);
        const char* nA = has_next ? (const char*)g.A + (size_t)nxt.pm * tstep : cA; const char* nB = has_next ? (const char*)g.Bt + (size_t)nxt.pn * tstep : cB;
        for (int t = 0; t < nt; t += 2) {
            const bool last = (t == nt - 2);
            const char* a1 = cA + (size_t)(t + 1) * kstep;
            const char* a2 = last ? nA : cA + (size_t)(t + 2) * kstep; const char* b2 = last ? nB : cB + (size_t)(t + 2) * kstep;
            const char* a3 = a2 + kstep; const char* b3 = b2 + kstep;
            if (last && has_next) S.a_ready(nxt);
            if constexpr (SP2) {
            PG8_LDB(B0, 0, 0); PG8_LDB(B1, 0, 1); PG8_SCHED; PG8_LDA(At, 0, 0); PG8_STAGE(PG8_SA(1, 1), a1 + hstep, voffA);
            PG8_WAIT_V(8); PG8_WAIT_L(0); PG8_BAR; PG8_MMA(0, 0, At, B0); PG8_MMA(0, 1, At, B1); PG8_BAR; PG8_SCHED;
            PG8_LDA(At, 0, 1); PG8_STAGE(PG8_SB(0, 0), b2, voffB); PG8_STAGE(PG8_SB(0, 1), b2 + hstep, voffB); PG8_STAGE(PG8_SA(0, 0), a2, voffA);
            PG8_WAIT_V(8); PG8_WAIT_L(0); PG8_BAR; PG8_MMA(1, 0, At, B0); PG8_MMA(1, 1, At, B1); PG8_BAR; PG8_SCHED;
            PG8_LDB(B0, 1, 0); PG8_LDB(B1, 1, 1); PG8_SCHED; PG8_LDA(At, 1, 0); PG8_STAGE(PG8_SA(0, 1), a2 + hstep, voffA);
            PG8_WAIT_V(8); PG8_WAIT_L(0); PG8_BAR; PG8_MMA(0, 0, At, B0); PG8_MMA(0, 1, At, B1); PG8_BAR; PG8_SCHED;
            PG8_LDA(At, 1, 1); PG8_STAGE(PG8_SB(1, 0), b3, voffB); PG8_STAGE(PG8_SB(1, 1), b3 + hstep, voffB); PG8_STAGE(PG8_SA(1, 0), a3, voffA);
            PG8_WAIT_V(8); PG8_WAIT_L(0); PG8_BAR; PG8_MMA(1, 0, At, B0); PG8_MMA(1, 1, At, B1); PG8_BAR; PG8_SCHED;
            } else {
            PG8_LDB(B0, 0, 0); PG8_SCHED; PG8_LDA(At, 0, 0); PG8_STAGE(PG8_SA(1, 1), a1 + hstep, voffA);
            PG8_WAIT_L(8); PG8_BAR; PG8_WAIT_L(0); PG8_MMA(0, 0, At, B0); PG8_BAR; PG8_SCHED;
            PG8_LDB(B1, 0, 1); PG8_STAGE(PG8_SB(0, 0), b2, voffB);
            PG8_BAR; PG8_WAIT_L(0); PG8_MMA(0, 1, At, B1); PG8_BAR;
            PG8_LDA(At, 0, 1); PG8_STAGE(PG8_SA(0, 0), a2, voffA);
            PG8_BAR; PG8_WAIT_L(0); PG8_MMA(1, 0, At, B0); PG8_BAR; PG8_SCHED;
            PG8_STAGE(PG8_SB(0, 1), b2 + hstep, voffB);
            PG8_WAIT_V(6); PG8_BAR; PG8_MMA(1, 1, At, B1); PG8_BAR;
            PG8_LDB(B0, 1, 0); PG8_SCHED; PG8_LDA(At, 1, 0); PG8_STAGE(PG8_SA(0, 1), a2 + hstep, voffA);
            PG8_WAIT_L(8); PG8_BAR; PG8_WAIT_L(0); PG8_MMA(0, 0, At, B0); PG8_BAR; PG8_SCHED;
            PG8_LDB(B1, 1, 1); PG8_STAGE(PG8_SB(1, 0), b3, voffB);
            PG8_BAR; PG8_WAIT_L(0); PG8_MMA(0, 1, At, B1); PG8_BAR;
            PG8_LDA(At, 1, 1); PG8_STAGE(PG8_SA(1, 0), a3, voffA);
            PG8_BAR; PG8_WAIT_L(0); PG8_MMA(1, 0, At, B0); PG8_BAR; PG8_SCHED;
            PG8_STAGE(PG8_SB(1, 1), b3 + hstep, voffB);
            PG8_WAIT_V(6); PG8_BAR; PG8_MMA(1, 1, At, B1); PG8_BAR;
            }
        }
        if constexpr (ALIGN_EPI) { if (wr == 0) PG8_BAR; }
        if constexpr (!Epi::AFTER_DRAIN) { E(acc, cur, wr, wc, fr, fq); S.done(cur); }
        if (!has_next) break;
#pragma unroll
        for (int a = 0; a < 2; ++a)
#pragma unroll
            for (int b = 0; b < 2; ++b)
#pragma unroll
                for (int m = 0; m < 4; ++m)
#pragma unroll
                    for (int n = 0; n < 2; ++n) acc[a][b][m][n] = (f32x4){0.f, 0.f, 0.f, 0.f};
        cur = nxt; cA = nA; cB = nB; ++ui;
        if constexpr (ALIGN_EPI) { if (wr == 1) PG8_BAR; }
    }
    PG8_WAIT_V(0);
    if constexpr (!ALIGN_EPI) { if (wr == 0) PG8_BAR; }
    PG8_BAR;
    if constexpr (Epi::AFTER_DRAIN) { E.fused(acc, cur, wr, wc, fr, fq, lds, wid, lane); S.done(cur); }
#undef PG8_SA
#undef PG8_SB
#undef PG8_STAGE
#undef PG8_LDA
#undef PG8_LDB
#undef PG8_MMA
#undef PG8_WAIT_V
#undef PG8_WAIT_L
#undef PG8_BAR
#undef PG8_SCHED
}
}
namespace att {
constexpr int KROW = 144, KBUF = 64 * KROW;
constexpr int VBUF = 16384;
constexpr int L_K = 0, L_V = 2 * KBUF, L_BIAS = L_V + 3 * VBUF, L_FLAG = L_BIAS + 2 * 64 * 4, L_MISC = L_FLAG + 64, L_END = L_MISC + 64;
__device__ __forceinline__ int crow(int r, int hi) { return (r & 3) + 8 * (r >> 2) + 4 * hi; }
__device__ __forceinline__ unsigned cvtpk(float lo, float hi) { unsigned r; asm volatile("v_cvt_pk_bf16_f32 %0, %1, %2" : "=v"(r) : "v"(lo), "v"(hi)); return r; }

struct Args { const bf16_t* qkv; int pitch; int rowb; int u; int qcol, kcol, vcol; const float* F; float kmax; };

template <int MODE, int NDV, bool BIAS>
__device__ __forceinline__ void run(LAS unsigned char* lds, const Args& a, f32x16 (&o)[NDV], float& l_out) {
    int tid_l = threadIdx.x; asm volatile("" : "+v"(tid_l));
    const int tid = tid_l, lane = tid & 63, w = __builtin_amdgcn_readfirstlane(tid >> 6), r32 = lane & 31, hi = lane >> 5;
    const int qmin = 256 * a.u + 32 * w, qpos = qmin + r32;
    constexpr int NV = NDV / 2;
    bf16x8 qf[4];
    { const bf16_t* qp = a.qkv + (size_t)(a.rowb + qpos) * a.pitch + a.qcol + 8 * hi;
#pragma unroll
      for (int d0 = 0; d0 < 4; ++d0) qf[d0] = *(const bf16x8*)(qp + 16 * d0); }
    float qkb = 0.f;
    if (BIAS) { float s2 = 0.f;
#pragma unroll
        for (int d0 = 0; d0 < 4; ++d0)
#pragma unroll
            for (int j = 0; j < 8; ++j) { const float qv = bf2f((unsigned short)qf[d0][j]); s2 += qv * qv; }
        s2 += __shfl_xor(s2, 32); qkb = sqrtf(s2) * a.kmax * 1.001f + 1e-3f; }
    const int kr = tid >> 3, kc = tid & 7;
    const bf16_t* kg = a.qkv + (size_t)(a.rowb + kr) * a.pitch + a.kcol + 8 * kc;
    const unsigned klds = kr * KROW + kc * 16;
    const bf16_t* vg[NV]; unsigned vlds[NV];
#pragma unroll
    for (int j = 0; j < NV; ++j) {
        int vr, ch; if (NDV == 2) { vr = tid >> 3; ch = tid & 7; } else { vr = (tid >> 4) + 32 * j; ch = tid & 15; }
        vg[j] = a.qkv + (size_t)(a.rowb + vr) * a.pitch + a.vcol + 8 * ch;
        vlds[j] = (vr >> 3) * (NDV * 512) + (ch >> 2) * 512 + (vr & 7) * 64 + (ch & 3) * 16;
    }
    const size_t tstride = (size_t)64 * a.pitch;
    float fq0 = 0.f; if (BIAS) fq0 = a.F[256 * a.u];
    const int ntile = 4 * a.u + 1;
#define ATT_TILE(i) ((MODE == 0 || BIAS) ? (4 * a.u + 3 - (i)) : (3 + (i)))
    u32x4 kreg, vreg[NV]; float breg = 0.f, ubn = 0.f;
#define ATT_LOAD(kt) do { kreg = *(const u32x4*)(kg + (size_t)(kt) * tstride); _Pragma("unroll") for (int j_ = 0; j_ < NV; ++j_) vreg[j_] = *(const u32x4*)(vg[j_] + (size_t)(kt) * tstride); \
        if (BIAS) { if (tid < 64) breg = (fq0 - a.F[64 * (kt) + tid]) * LOG2E; ubn = (fq0 - a.F[64 * (kt) + 63]) * LOG2E; } } while (0)
#define ATT_WRITE(b, vs_) do { *(LAS u32x4*)(lds + L_K + (b) * KBUF + klds) = kreg; _Pragma("unroll") for (int j_ = 0; j_ < NV; ++j_) *(LAS u32x4*)(lds + L_V + (vs_) * VBUF + vlds[j_]) = vreg[j_]; \
        if (BIAS) { if (tid < 64) *(LAS float*)(lds + L_BIAS + (b) * 256 + tid * 4) = breg; } } while (0)
#pragma unroll
    for (int c = 0; c < NDV; ++c)
#pragma unroll
        for (int r = 0; r < 16; ++r) o[c][r] = 0.f;
    float mrun = -1e30f, lrun = 0.f, carry = 0.f;
    const unsigned vlane = 64 * (4 * hi + ((lane & 15) >> 2)) + 32 * ((lane >> 4) & 1) + 8 * (lane & 3);
    ATT_LOAD(ATT_TILE(0)); ATT_WRITE(0, 0);
    asm volatile("" :: "v"(qf[0]), "v"(qf[1]), "v"(qf[2]), "v"(qf[3]));
    __syncthreads();
    unsigned pk[4][4];
#pragma unroll
    for (int a_ = 0; a_ < 4; ++a_)
#pragma unroll
        for (int b_ = 0; b_ < 4; ++b_) pk[a_][b_] = 0u;
    bool pend = false; int vsp = 0, vs = 0;
#define ATT_PV(VS_) do { const LAS unsigned char* vb = lds + L_V + (VS_) * VBUF + vlane; \
        _Pragma("unroll") for (int ks = 0; ks < 4; ++ks) { asm volatile("" ::: "memory"); \
            bf16x8 pb; { u32x4 t4 = {pk[ks][0], pk[ks][1], pk[ks][2], pk[ks][3]}; pb = __builtin_bit_cast(bf16x8, t4); } \
            _Pragma("unroll") for (int c = 0; c < NDV; ++c) { \
                const v4i16_t lo = __builtin_amdgcn_ds_read_tr16_b64_v4i16((LAS v4i16_t*)(vb + (2 * ks) * (NDV * 512) + 512 * c)); \
                const v4i16_t hh = __builtin_amdgcn_ds_read_tr16_b64_v4i16((LAS v4i16_t*)(vb + (2 * ks + 1) * (NDV * 512) + 512 * c)); \
                const bf16x8 va = {lo[0], lo[1], lo[2], lo[3], hh[0], hh[1], hh[2], hh[3]}; \
                o[c] = __builtin_amdgcn_mfma_f32_32x32x16_bf16(va, pb, o[c], 0, 0, 0); } } } while (0)
    for (int i = 0; i < ntile; ++i) {
        const int kt = ATT_TILE(i), buf = i & 1;
        vs = i % 3;
        if (i + 1 < ntile) ATT_LOAD(ATT_TILE(i + 1));
        if (w >= 4) { if (pend) ATT_PV(vsp); }
        const int tlo = 64 * kt;
        const bool skip = (MODE == 0) ? (tlo >= qmin + 31) : (tlo > qmin + 31);
        if (!skip) {
            const bool needmask = (kt == 3) || ((MODE == 0) ? (tlo + 63 >= qmin) : (tlo + 63 > qmin));
            const LAS unsigned char* kb = lds + L_K + buf * KBUF + r32 * KROW + 16 * hi;
            f32x16 x[2];
#pragma unroll
            for (int xt = 0; xt < 2; ++xt) {
                if (BIAS) {
                    const LAS float* bp = (const LAS float*)(lds + L_BIAS + buf * 256) + 32 * xt + 4 * hi;
#pragma unroll
                    for (int g = 0; g < 4; ++g) { const f32x4 bv = *(const LAS f32x4*)(bp + 8 * g); x[xt][4 * g] = bv[0]; x[xt][4 * g + 1] = bv[1]; x[xt][4 * g + 2] = bv[2]; x[xt][4 * g + 3] = bv[3]; }
                } else {
#pragma unroll
                    for (int r = 0; r < 16; ++r) x[xt][r] = 0.f;
                }
#pragma unroll
                for (int d0 = 0; d0 < 4; ++d0) { const bf16x8 kf = *(const LAS bf16x8*)(kb + xt * 32 * KROW + 32 * d0); x[xt] = __builtin_amdgcn_mfma_f32_32x32x16_bf16(kf, qf[d0], x[xt], 0, 0, 0); }
            }
            if (MODE == 1) {
                if (needmask) {
#pragma unroll
                    for (int xt = 0; xt < 2; ++xt)
#pragma unroll
                        for (int r = 0; r < 16; ++r) { const int kvp = tlo + 32 * xt + crow(r, hi); if (kvp > qpos || kvp < PADR) x[xt][r] = -1e30f; }
                }
                float mx = x[0][0];
#pragma unroll
                for (int r = 1; r < 16; ++r) mx = fmaxf(mx, x[0][r]);
#pragma unroll
                for (int r = 0; r < 16; ++r) mx = fmaxf(mx, x[1][r]);
                mx = fmaxf(mx, __shfl_xor(mx, 32));
                const float mnew = fmaxf(mrun, mx), alpha = fexp2(mrun - mnew); mrun = mnew;
                float ps = 0.f;
#pragma unroll
                for (int xt = 0; xt < 2; ++xt)
#pragma unroll
                    for (int r = 0; r < 16; ++r) { const float pv = fexp2(x[xt][r] - mnew); x[xt][r] = pv; ps += pv; }
                lrun = lrun * alpha + ps;
                if (__any(alpha != 1.0f)) {
#pragma unroll
                    for (int c = 0; c < NDV; ++c)
#pragma unroll
                        for (int r = 0; r < 16; ++r) o[c][r] *= alpha;
                }
            } else {
#pragma unroll
                for (int xt = 1; xt >= 0; --xt) {
                    float lm[16], G[4], Gp[4];
#pragma unroll
                    for (int r = 0; r < 16; ++r) {
                        const float z = x[xt][r], sp = fmaxf(z, 0.f) + flog2(1.0f + fexp2(-fabsf(z)));
                        bool valid = true;
                        if (needmask) { const int kvp = tlo + 32 * xt + crow(r, hi); valid = (kvp < qpos) && (kvp >= PADR); }
                        lm[r] = valid ? -sp : 0.f;
                        x[xt][r] = valid ? (z - sp) : -1e30f;
                    }
#pragma unroll
                    for (int g = 0; g < 4; ++g) { G[g] = (lm[4 * g] + lm[4 * g + 1]) + (lm[4 * g + 2] + lm[4 * g + 3]); Gp[g] = __shfl_xor(G[g], 32); }
                    float runv = carry;
#pragma unroll
                    for (int g = 3; g >= 0; --g) {
                        const float g1 = hi ? G[g] : Gp[g], g0 = hi ? Gp[g] : G[g];
                        const float sg = hi ? runv : (runv + g1);
                        const float c3 = sg, c2 = c3 + lm[4 * g + 3], c1 = c2 + lm[4 * g + 2], c0 = c1 + lm[4 * g + 1];
                        x[xt][4 * g + 3] = fexp2(x[xt][4 * g + 3] + c3); x[xt][4 * g + 2] = fexp2(x[xt][4 * g + 2] + c2);
                        x[xt][4 * g + 1] = fexp2(x[xt][4 * g + 1] + c1); x[xt][4 * g] = fexp2(x[xt][4 * g] + c0);
                        runv = runv + (g1 + g0);
                    }
                    carry = runv;
                }
            }
#pragma unroll
            for (int ks = 0; ks < 4; ++ks)
#pragma unroll
                for (int j = 0; j < 4; ++j) pk[ks][j] = cvtpk(x[ks >> 1][8 * (ks & 1) + 2 * j], x[ks >> 1][8 * (ks & 1) + 2 * j + 1]);
            if (w < 4) ATT_PV(vs);
        }
        pend = !skip; vsp = vs;
        if (MODE == 0) { const int ok = __all(carry < -160.0f) ? 1 : 0; if (lane == 0) *(LAS int*)(lds + L_FLAG + (buf * 8 + w) * 4) = ok; }
        if (i + 1 < ntile) ATT_WRITE(buf ^ 1, (i + 1) % 3);
        if (BIAS) {
            const int ok = __all(qkb + ubn - mrun < -160.0f) ? 1 : 0; if (lane == 0) *(LAS int*)(lds + L_FLAG + (buf * 8 + w) * 4) = ok;
        }
        __syncthreads();
        if (MODE == 0 || BIAS) {
            const LAS int* fl = (const LAS int*)(lds + L_FLAG + buf * 32);
            const int all = fl[0] & fl[1] & fl[2] & fl[3] & fl[4] & fl[5] & fl[6] & fl[7];
            if (all) break;
        }
    }
    if (w >= 4) { if (pend) ATT_PV(vsp); }
    __syncthreads();
    l_out = lrun + __shfl_xor(lrun, 32);
#undef ATT_TILE
#undef ATT_LOAD
#undef ATT_WRITE
#undef ATT_PV
}
}
struct Params { const float* in[27]; float* out; unsigned char* ws; int ph_lo, ph_hi; };

__device__ __forceinline__ float log_sigmoid_f(float x) { return -(fmaxf(-x, 0.f) + log1pf(expf(-fabsf(x)))); }
__device__ __forceinline__ float gelu_tanh_f(float x) { const float z = 0.7978845608028654f * (x + 0.044715f * x * x * x); const float t = 1.0f - 2.0f / (__expf(2.0f * z) + 1.0f); return 0.5f * x * (1.0f + t); }

__device__ __forceinline__ void map_col(int kind, int n, int& dr, float& sc) {
    sc = 1.0f; dr = n;
    if (kind == 1) { if (n < 512 || (n >= 1536 && n < 2048)) sc = C2; }
    else if (kind == 2) { if (n < 512) sc = C2; else if (n >= 1536 && n < 1544) dr = -1; else if (n >= 1544) dr = n - 8; }
    else if (kind == 3) { if (n < 2816) dr = 8 * (n >> 2) + (n & 3); else { const int j = n - 2816; dr = 8 * (j >> 2) + 4 + (j & 3); } }
}
__device__ __forceinline__ void transpose_item(const float* W, int K, int N, const float* gk, bf16_t* WT, int kind, LAS float* scr, int item, int lane) {
    const int nblk = (N + 31) / 32, kb = item / nblk, nb = item % nblk, k0 = 64 * kb, n0 = 32 * nb;
#pragma unroll 8
    for (int i = 0; i < 32; ++i) { const int kk = 2 * i + (lane >> 5), n = n0 + (lane & 31);
        float v = 0.f; if (n < N) { v = W[(size_t)(k0 + kk) * N + n]; if (gk) v *= gk[k0 + kk]; }
        scr[kk * 33 + (lane & 31)] = v; }
    asm volatile("s_waitcnt lgkmcnt(0)" ::: "memory");
    const int c = lane & 7;
#pragma unroll
    for (int j = 0; j < 4; ++j) { const int nl = (lane >> 3) + 8 * j, n = n0 + nl;
        if (n < N) { int dr; float sc; map_col(kind, n, dr, sc);
            if (dr >= 0) { const LAS float* s = scr + (8 * c) * 33 + nl;
                u32x4 o; o.x = pk2(s[0 * 33] * sc, s[1 * 33] * sc); o.y = pk2(s[2 * 33] * sc, s[3 * 33] * sc); o.z = pk2(s[4 * 33] * sc, s[5 * 33] * sc); o.w = pk2(s[6 * 33] * sc, s[7 * 33] * sc);
                *(u32x4*)(WT + (size_t)dr * K + k0 + 8 * c) = o; } } }
    asm volatile("s_waitcnt lgkmcnt(0)" ::: "memory");
}

template <bool FINAL>
__device__ __forceinline__ void s5_item(const Params& p, LAS unsigned char* wl  , int item, int lane) {
    const int g = item & 31, bc = item >> 5, c = bc % 132, b = bc / 132;
    const unsigned char* ws = p.ws;
    const bf16_t* qkv = (const bf16_t*)(ws + WS_QKV);
    const float* a_re_p = (const float*)(ws + WS_S5A); const float* a_im_p = a_re_p + 2048;
    const float* bbr = (const float*)(ws + WS_S5BB); const float* bbi = bbr + 2048 * 16;
    float2* E = (float2*)(ws + WS_E);
    const int gp = g * 64 + lane;
    const float ar = a_re_p[gp], ai = a_im_p[gp];
    LAS float* ub = (LAS float*)wl;
    { const size_t row = (size_t)b * LP + 64 * c + lane; const u32x4* up = (const u32x4*)(qkv + row * 2048 + 1536 + 16 * g);
      const u32x4 u0 = up[0], u1 = up[1];
      f32x4 f0 = {bflo(u0.x), bfhi(u0.x), bflo(u0.y), bfhi(u0.y)}, f1 = {bflo(u0.z), bfhi(u0.z), bflo(u0.w), bfhi(u0.w)};
      f32x4 f2 = {bflo(u1.x), bfhi(u1.x), bflo(u1.y), bfhi(u1.y)}, f3 = {bflo(u1.z), bfhi(u1.z), bflo(u1.w), bfhi(u1.w)};
      LAS f32x4* ur = (LAS f32x4*)(ub + lane * 16); ur[0] = f0; ur[1] = f1; ur[2] = f2; ur[3] = f3; }
    float br[16], bi[16];
    { const f32x4* pr = (const f32x4*)(bbr + (size_t)gp * 16); const f32x4* pi = (const f32x4*)(bbi + (size_t)gp * 16);
#pragma unroll
      for (int q = 0; q < 4; ++q) { const f32x4 vr = pr[q], vi = pi[q];
#pragma unroll
          for (int e = 0; e < 4; ++e) { br[4 * q + e] = vr[e]; bi[4 * q + e] = vi[e]; } } }
    float xr = 0.f, xi = 0.f;
    if (FINAL) {
        float pr_ = ar, pi_ = ai;
#pragma unroll
        for (int s = 0; s < 6; ++s) { const float nr = pr_ * pr_ - pi_ * pi_, ni = 2.0f * pr_ * pi_; pr_ = nr; pi_ = ni; }
        const float2* Eb = E + ((size_t)b * 132 * 32 + g) * 64 + lane;
        for (int cc = 0; cc < c; ++cc) { const float2 e = Eb[(size_t)cc * 32 * 64]; const float nr = pr_ * xr - pi_ * xi + e.x, ni = pr_ * xi + pi_ * xr + e.y; xr = nr; xi = ni; }
    }
    asm volatile("s_waitcnt lgkmcnt(0)" ::: "memory");
    bf16x8 cf[4];
    float dsk = 0.f;
    if (FINAL) {
        const bf16_t* ct = (const bf16_t*)(ws + WS_S5CT) + ((size_t)g * 16 + (lane & 15)) * 128 + 8 * (lane >> 4);
#pragma unroll
        for (int ks = 0; ks < 4; ++ks) cf[ks] = *(const bf16x8*)(ct + 32 * ks);
        dsk = p.in[22][g * 16 + (lane & 15)];
    }
    LAS bf16_t* X = (LAS bf16_t*)(wl + 4096);
#pragma unroll 1
    for (int sub = 0; sub < 2; ++sub) {
#pragma unroll 4
        for (int tt = 0; tt < 32; ++tt) {
            const LAS f32x4* ur = (const LAS f32x4*)(ub + (32 * sub + tt) * 16);
            float sr = 0.f, si = 0.f;
#pragma unroll
            for (int q = 0; q < 4; ++q) { const f32x4 uv = ur[q];
#pragma unroll
                for (int e = 0; e < 4; ++e) { sr += uv[e] * br[4 * q + e]; si += uv[e] * bi[4 * q + e]; } }
            const float nr = ar * xr - ai * xi + sr, ni = ar * xi + ai * xr + si; xr = nr; xi = ni;
            if (FINAL) { X[tt * 136 + lane] = (bf16_t)f2bf(xr); X[tt * 136 + 64 + lane] = (bf16_t)f2bf(xi); }
        }
        if (FINAL) {
            asm volatile("s_waitcnt lgkmcnt(0)" ::: "memory");
            bf16_t* Y = (bf16_t*)(ws + WS_Y);
#pragma unroll
            for (int mb = 0; mb < 2; ++mb) {
                f32x4 acc = {0.f, 0.f, 0.f, 0.f};
#pragma unroll
                for (int ks = 0; ks < 4; ++ks) { const bf16x8 af = *(const LAS bf16x8*)((const LAS unsigned char*)X + (16 * mb + (lane & 15)) * 272 + 64 * ks + 16 * (lane >> 4));
                    acc = __builtin_amdgcn_mfma_f32_16x16x32_bf16(af, cf[ks], acc, 0, 0, 0); }
#pragma unroll
                for (int i2 = 0; i2 < 4; ++i2) { const int t = 32 * sub + 16 * mb + 4 * (lane >> 4) + i2;
                    const float yv = acc[i2] + dsk * ub[t * 16 + (lane & 15)];
                    Y[((size_t)b * LP + 64 * c + t) * 512 + 16 * g + (lane & 15)] = (bf16_t)f2bf(gelu_tanh_f(yv)); }
            }
            asm volatile("s_waitcnt lgkmcnt(0)" ::: "memory");
        }
    }
    if (!FINAL) E[((size_t)(b * 132 + c) * 32 + g) * 64 + lane] = make_float2(xr, xi);
}

__device__ __forceinline__ f32x4 meta_mm(const bf16_t* X, int ldx, const bf16_t* Wt, int K, int n0, int lane) {
    const bf16_t* ap = X + (size_t)(PADR + (lane & 15)) * ldx + 8 * (lane >> 4);
    const bf16_t* bp = Wt + (size_t)(n0 + (lane & 15)) * K + 8 * (lane >> 4);
    f32x4 acc = {0.f, 0.f, 0.f, 0.f};
#pragma unroll 8
    for (int k = 0; k < K; k += 32) { const bf16x8 a = *(const bf16x8*)(ap + k), b = *(const bf16x8*)(bp + k); acc = __builtin_amdgcn_mfma_f32_16x16x32_bf16(a, b, acc, 0, 0, 0); }
    return acc;
}
template <int KIND>
__device__ __forceinline__ void meta_task(const bf16_t* X, int ldx, const bf16_t* Wt, int K, int n0, int lane, bf16_t* O, int ldc, const float* ssq_in, float* H, bf16_t* HB, float* ssq_out) {
    const f32x4 acc = meta_mm(X, ldx, Wt, K, n0, lane);
    const int c = n0 + (lane & 15);
#pragma unroll
    for (int i = 0; i < 4; ++i) {
        const int r = PADR + 4 * (lane >> 4) + i;
        if (KIND == 0) {
            const float rs = rsqrtf(ssq_in[r] * (1.0f / 1024.0f) + RMS_EPS);
            const bf16_t v = (bf16_t)f2bf(acc[i] * rs);
#pragma unroll
            for (int b = 0; b < NBATCH; ++b) O[(size_t)(b * LP + r) * ldc + c] = v;
        } else if (KIND == 1) {
            const float hv = H[(size_t)r * DM + c] + acc[i];
            float ss = hv * hv; ss += __shfl_xor(ss, 1); ss += __shfl_xor(ss, 2); ss += __shfl_xor(ss, 4); ss += __shfl_xor(ss, 8);
#pragma unroll
            for (int b = 0; b < NBATCH; ++b) { H[(size_t)(b * LP + r) * DM + c] = hv; HB[(size_t)(b * LP + r) * DM + c] = (bf16_t)f2bf(hv); if ((lane & 15) == 0 && ssq_out) atomicAdd(ssq_out + b * LP + r, ss); }
        } else {
            const float rs = rsqrtf(ssq_in[r] * (1.0f / 1024.0f) + RMS_EPS);
            const float v = acc[i] * rs, up = __shfl_xor(v, 4);
            if ((c & 4) == 0) O[(size_t)r * DFF + ((c >> 3) << 2) + (c & 3)] = (bf16_t)f2bf(v / (1.0f + __expf(-v)) * up);
        }
    }
}
__device__ __forceinline__ void zero_pad_rows(bf16_t* B, int pitch, int gw, int NGW, int lane) {
    for (int r = gw; r < NBATCH * PADR; r += NGW) { u32x4* rp = (u32x4*)(B + (size_t)((r / PADR) * LP + (r % PADR)) * pitch);
        for (int j = lane; j < pitch / 8; j += 64) rp[j] = (u32x4){0u, 0u, 0u, 0u}; }
}
#ifndef REP1
#define REP1 1
#endif
#ifndef REP2
#define REP2 1
#endif
#ifndef REP4
#define REP4 1
#endif
#ifndef REP6
#define REP6 1
#endif
#ifndef REP7
#define REP7 1
#endif
#ifndef REP8
#define REP8 1
#endif
#ifndef REP9
#define REP9 1
#endif
#ifndef REP11
#define REP11 1
#endif
__global__ void __launch_bounds__(NTHR, 2) mega_fwd(Params p) {
    extern __shared__ __attribute__((aligned(16))) unsigned char lds_raw[];
    LAS unsigned char* lds = (LAS unsigned char*)lds_raw;
    cg::grid_group grid = cg::this_grid();
    const int tid = threadIdx.x, lane = tid & 63, wave = __builtin_amdgcn_readfirstlane(tid >> 6);
    const int G = gridDim.x, gw = blockIdx.x * NW + wave, NGW = G * NW;
    unsigned char* ws = p.ws;
    unsigned* ctl = (unsigned*)(ws + WS_CTL);
    float* ssq = (float*)(ws + WS_SSQ);
    float* Fb = (float*)(ws + WS_F);
    float* H = (float*)(ws + WS_H);
    bf16_t* HB = (bf16_t*)(ws + WS_HB);
    bf16_t* QKV = (bf16_t*)(ws + WS_QKV);
    bf16_t* CAT = (bf16_t*)((unsigned char*)p.out + DO_CAT);
    float* STASH = (float*)((unsigned char*)p.out + DO_STASH);
    const int lo = p.ph_lo, hi_ph = p.ph_hi;
#ifndef PHMASK
#define PHMASK 0x3fff
#endif
#define IN(k) (((PHMASK >> (k)) & 1) && lo <= (k) && (k) < hi_ph)
#define SEAM(k) do { if (IN(k) && IN((k) + 1)) grid.sync(); } while (0)

    if (IN(0)) {
        if (blockIdx.x == 0 && tid < 256) ctl[tid] = 0u;
        for (int i = blockIdx.x * NTHR + tid; i < 3 * MROWS; i += G * NTHR) ssq[MROWS + i] = 0.f;
        for (int row = gw; row < MROWS; row += NGW) {
            const int b = row / LP, pos = row % LP;
            f32x4 v[4]; float s = 0.f;
            if (pos < PADR) {
#pragma unroll
                for (int j = 0; j < 4; ++j) v[j] = (f32x4){0.f, 0.f, 0.f, 0.f};
            } else {
                const float* src = (pos < 256) ? (p.in[1] + (size_t)(pos - PADR) * DM) : (p.in[0] + ((size_t)b * SEQ + (pos - 256)) * DM);
#pragma unroll
                for (int j = 0; j < 4; ++j) { v[j] = ((const f32x4*)src)[lane + 64 * j]; s += (v[j][0] * v[j][0] + v[j][1] * v[j][1]) + (v[j][2] * v[j][2] + v[j][3] * v[j][3]); }
            }
            s = wave_sum(s);
#pragma unroll
            for (int j = 0; j < 4; ++j) { ((f32x4*)(H + (size_t)row * DM))[lane + 64 * j] = v[j];
                u32x2 w; w.x = pk2(v[j][0], v[j][1]); w.y = pk2(v[j][2], v[j][3]); ((u32x2*)(HB + (size_t)row * DM))[lane + 64 * j] = w; }
            if (lane == 0) ssq[row] = s;
        }
        {
            LAS float* scr = (LAS float*)(lds + wave * 16384);
            const float* nmg = p.in[2]; const float* nfg = p.in[3];
            constexpr int I0 = 16 * 96, I1 = 16 * 32, I2 = 16 * 176, I3 = 44 * 32, I4 = 16 * 65, I5 = 8 * 16, I6 = 16 * 32, I7 = 16 * 176, I8 = 44 * 32;
            constexpr int NIT = I0 + I1 + I2 + I3 + I4 + I5 + I6 + I7 + I8;
            for (int it = gw; it < NIT; it += NGW) {
                int r = it;
                if (r < I0) { transpose_item(p.in[5], 1024, 3072, nmg, (bf16_t*)(ws + WS_W0IN), 1, scr, r, lane); continue; } r -= I0;
                if (r < I1) { transpose_item(p.in[6], 1024, 1024, nullptr, (bf16_t*)(ws + WS_W0OUT), 0, scr, r, lane); continue; } r -= I1;
                if (r < I2) { transpose_item(p.in[25], 1024, 5632, nfg, (bf16_t*)(ws + WS_WGU0), 3, scr, r, lane); continue; } r -= I2;
                if (r < I3) { transpose_item(p.in[26], 2816, 1024, nullptr, (bf16_t*)(ws + WS_WDN0), 0, scr, r, lane); continue; } r -= I3;
                if (r < I4) { transpose_item(p.in[12], 1024, 2056, nmg + 1024, (bf16_t*)(ws + WS_W1IN), 2, scr, r, lane); continue; } r -= I4;
                if (r < I5) { transpose_item(p.in[23], 512, 512, nullptr, (bf16_t*)(ws + WS_WGLU), 0, scr, r, lane); continue; } r -= I5;
                if (r < I6) { transpose_item(p.in[13], 1024, 1024, nullptr, (bf16_t*)(ws + WS_W1OUT), 0, scr, r, lane); continue; } r -= I6;
                if (r < I7) { transpose_item(p.in[25] + (size_t)1024 * 5632, 1024, 5632, nfg + 1024, (bf16_t*)(ws + WS_WGU1), 3, scr, r, lane); continue; } r -= I7;
                transpose_item(p.in[26] + (size_t)2816 * 1024, 2816, 1024, nullptr, (bf16_t*)(ws + WS_WDN1), 0, scr, r, lane);
            }
        }
        for (int i = blockIdx.x * NTHR + tid; i < 2048; i += G * NTHR) {
            const int g = i >> 6;
            const float lre = p.in[15][i], lim = p.in[16][i], dt = expf(p.in[17][g]);
            const float mag = expf(lre * dt), are = mag * cosf(lim * dt), aim = mag * sinf(lim * dt), den = lre * lre + lim * lim;
            const float gre = ((are - 1.0f) * lre + aim * lim) / den, gim = (aim * lre - (are - 1.0f) * lim) / den;
            float* ap = (float*)(ws + WS_S5A); ap[i] = are; ap[2048 + i] = aim;
            float* bbr = (float*)(ws + WS_S5BB); float* bbi = bbr + 2048 * 16;
            for (int h = 0; h < 16; ++h) { const float br = p.in[18][i * 16 + h], bi = p.in[19][i * 16 + h]; bbr[i * 16 + h] = gre * br - gim * bi; bbi[i * 16 + h] = gre * bi + gim * br; }
        }
        for (int i = blockIdx.x * NTHR + tid; i < 32 * 16 * 128; i += G * NTHR) {
            const int pp = i & 127, gh = i >> 7;
            const float v = (pp < 64) ? p.in[20][gh * 64 + pp] : -p.in[21][gh * 64 + (pp - 64)];
            ((bf16_t*)(ws + WS_S5CT))[i] = (bf16_t)f2bf(v);
        }
        for (int i = blockIdx.x * NTHR + tid; i < 8 * 1024; i += G * NTHR) {
            const int j = i >> 10, k = i & 1023;
            ((float*)(ws + WS_W1F))[i] = p.in[12][(size_t)k * 2056 + 1536 + j] * p.in[2][1024 + k];
        }
    }
    SEAM(0);

    for (int rep = 0; rep < (IN(1) ? REP1 : 0); ++rep) {
        pg8::Gemm g{HB, (const bf16_t*)(ws + WS_W0IN), MROWS, 3072, 1024}; pg8::StaticOrder S; S.init(NBATCH * SEQ, 3072, G, (int)blockIdx.x);
        pg8::EpiScaleBf16 E{QKV, 3072, ssq};
        pg8::gemm_phase<pg8::EpiScaleBf16, pg8::StaticOrder, true, true>(lds, g, S, E);
        if (rep == 0) { zero_pad_rows(QKV, 3072, gw, NGW, lane);
            for (int t = gw; t < 3072 / 16; t += NGW) meta_task<0>(HB, DM, (const bf16_t*)(ws + WS_W0IN), 1024, 16 * t, lane, QKV, 3072, ssq, nullptr, nullptr, nullptr); }
    }
    SEAM(1);

    for (int rep = 0; rep < (IN(2) ? REP2 : 0); ++rep) {
        float lam;
        { const float a1 = wave_sum(p.in[7][lane] * p.in[8][lane]), a2 = wave_sum(p.in[9][lane] * p.in[10][lane]); lam = expf(a1) - expf(a2) + 0.2f; }
        constexpr int NDIFF = 16 * 33, NSB = 32 * 33;
        LAS int* misc = (LAS int*)(lds + att::L_MISC);
        for (;;) {
            if (tid == 0) misc[0] = (int)atomicAdd(ctl + rep, 1u);
            __syncthreads();
            int idx = misc[0];
            __syncthreads();
#ifdef REP2_DIFF_ONLY
            if (rep > 0 && idx >= NDIFF) break;
#endif
#ifdef REP2_SB_ONLY
            if (rep > 0) idx += NDIFF;
#endif
            if (idx >= NDIFF + NSB) break;
            if (idx < NDIFF) {
#ifndef NO_DIFF
                const int u = 32 - idx / 16, bh = idx % 16, b = bh >> 2, hd = bh & 3;
                const int r32 = lane & 31, hi = lane >> 5;
                f32x4* st = (f32x4*)(STASH + ((size_t)blockIdx.x * NTHR + tid) * 64);
#pragma unroll 1
                for (int comp = 0; comp < 2; ++comp) {
                    att::Args a{QKV, 3072, b * LP, u, 1536 + hd * 128 + comp * 64, 2048 + hd * 128 + comp * 64, 2560 + hd * 128, nullptr, 0.f};
                    f32x16 o[4]; float l;
                    att::run<1, 4, false>(lds, a, o, l);
                    const float inv = 1.0f / l;
                    if (comp == 0) {
#pragma unroll
                        for (int c = 0; c < 4; ++c)
#pragma unroll
                            for (int g4 = 0; g4 < 4; ++g4) st[c * 4 + g4] = (f32x4){o[c][4 * g4] * inv, o[c][4 * g4 + 1] * inv, o[c][4 * g4 + 2] * inv, o[c][4 * g4 + 3] * inv};
                    } else {
                        float ss = 0.f;
#pragma unroll
                        for (int c = 0; c < 4; ++c)
#pragma unroll
                            for (int g4 = 0; g4 < 4; ++g4) { const f32x4 sv = st[c * 4 + g4];
#pragma unroll
                                for (int e = 0; e < 4; ++e) { const float v = sv[e] - lam * (o[c][4 * g4 + e] * inv); o[c][4 * g4 + e] = v; ss += v * v; } }
                        ss += __shfl_xor(ss, 32);
                        const float rs = 0.8f * rsqrtf(ss * (1.0f / 128.0f) + RMS_EPS);
                        const float* sg = p.in[11];
                        bf16_t* op = CAT + (size_t)(b * LP + 256 * u + 32 * wave + r32) * DM + 512 + hd * 128;
#pragma unroll
                        for (int c = 0; c < 4; ++c)
#pragma unroll
                            for (int g4 = 0; g4 < 4; ++g4) { const int dv = 32 * c + 8 * g4 + 4 * hi; const f32x4 gv = *(const f32x4*)(sg + dv);
                                u32x2 w; w.x = pk2(o[c][4 * g4] * rs * gv[0], o[c][4 * g4 + 1] * rs * gv[1]); w.y = pk2(o[c][4 * g4 + 2] * rs * gv[2], o[c][4 * g4 + 3] * rs * gv[3]);
                                *(u32x2*)(op + dv) = w; }
                    }
                }
#endif
            } else {
#ifndef NO_SB
                const int i2 = idx - NDIFF, u = 32 - i2 / 32, bh = i2 % 32, b = bh >> 3, h = bh & 7;
                const int r32 = lane & 31, hi = lane >> 5;
                att::Args a{QKV, 3072, b * LP, u, h * 64, 512 + h * 64, 1024 + h * 64, nullptr, 0.f};
                f32x16 o[2]; float l;
                att::run<0, 2, false>(lds, a, o, l);
                bf16_t* op = CAT + (size_t)(b * LP + 256 * u + 32 * wave + r32) * DM + h * 64;
#pragma unroll
                for (int c = 0; c < 2; ++c)
#pragma unroll
                    for (int g4 = 0; g4 < 4; ++g4) { const int dv = 32 * c + 8 * g4 + 4 * hi;
                        u32x2 w; w.x = pk2(o[c][4 * g4], o[c][4 * g4 + 1]); w.y = pk2(o[c][4 * g4 + 2], o[c][4 * g4 + 3]); *(u32x2*)(op + dv) = w; }
#endif
            }
        }
    }
    SEAM(2);

    if (IN(3)) {
        pg8::Gemm g{CAT, (const bf16_t*)(ws + WS_W0OUT), MROWS, 1024, 1024}; pg8::StaticOrder S; S.init(NBATCH * SEQ, 1024, G, (int)blockIdx.x);
        pg8::EpiResid E{H, HB, ssq + MROWS};
        pg8::gemm_phase<pg8::EpiResid, pg8::StaticOrder, true, true>(lds, g, S, E);
        for (int t = gw; t < 1024 / 16; t += NGW) meta_task<1>(CAT, DM, (const bf16_t*)(ws + WS_W0OUT), 1024, 16 * t, lane, nullptr, 0, nullptr, H, HB, ssq + MROWS);
    }
    SEAM(3);
    for (int rep = 0; rep < (IN(4) ? REP4 : 0); ++rep) {
        pg8::Gemm g{HB, (const bf16_t*)(ws + WS_WGU0), MROWS, 5632, 1024}; pg8::StaticOrder S; S.init(NBATCH * SEQ, 5632, G, (int)blockIdx.x);
        pg8::EpiSwiGLU E{QKV, ssq + MROWS};
        pg8::gemm_phase<pg8::EpiSwiGLU, pg8::StaticOrder, true, true>(lds, g, S, E);
        if (rep == 0) for (int t = gw; t < 5632 / 16; t += NGW) meta_task<2>(HB, DM, (const bf16_t*)(ws + WS_WGU0), 1024, 16 * t, lane, QKV, 0, ssq + MROWS, nullptr, nullptr, nullptr);
    }
    SEAM(4);
    if (IN(5)) {
        pg8::Gemm g{QKV, (const bf16_t*)(ws + WS_WDN0), MROWS, 1024, 2816}; pg8::StaticOrder S; S.init(NBATCH * SEQ, 1024, G, (int)blockIdx.x);
        pg8::EpiResid E{H, HB, ssq + 2 * MROWS};
        pg8::gemm_phase<pg8::EpiResid, pg8::StaticOrder, true, true>(lds, g, S, E);
        for (int t = gw; t < 1024 / 16; t += NGW) meta_task<1>(QKV, DFF, (const bf16_t*)(ws + WS_WDN0), DFF, 16 * t, lane, nullptr, 0, nullptr, H, HB, ssq + 2 * MROWS);
    }
    SEAM(5);
    for (int rep = 0; rep < (IN(6) ? REP6 : 0); ++rep) {
        {
            pg8::Gemm g{HB, (const bf16_t*)(ws + WS_W1IN), MROWS, 2048, 1024}; pg8::StaticOrder S; S.init(NBATCH * SEQ, 2048, G, (int)blockIdx.x);
            pg8::EpiScaleBf16 E{QKV, 2048, ssq + 2 * MROWS};
            pg8::gemm_phase<pg8::EpiScaleBf16, pg8::StaticOrder, true, true>(lds, g, S, E);
        }
        if (rep == 0) { zero_pad_rows(QKV, 2048, gw, NGW, lane);
            for (int t = gw; t < 2048 / 16; t += NGW) meta_task<0>(HB, DM, (const bf16_t*)(ws + WS_W1IN), 1024, 16 * t, lane, QKV, 2048, ssq + 2 * MROWS, nullptr, nullptr, nullptr); }
        const float* w1f = (const float*)(ws + WS_W1F);
        for (int row = gw; row < MROWS; row += NGW) {
            const int b = row / LP, pos = row % LP;
            f32x4 v[4];
#pragma unroll
            for (int j = 0; j < 4; ++j) v[j] = ((const f32x4*)(H + (size_t)row * DM))[lane + 64 * j];
            const float rs = rsqrtf(ssq[2 * MROWS + row] * (1.0f / 1024.0f) + RMS_EPS);
            float mine = 0.f;
#pragma unroll
            for (int hh = 0; hh < 8; ++hh) {
                float d = 0.f;
#pragma unroll
                for (int j = 0; j < 4; ++j) { const f32x4 wv = ((const f32x4*)(w1f + hh * 1024))[lane + 64 * j]; d += (v[j][0] * wv[0] + v[j][1] * wv[1]) + (v[j][2] * wv[2] + v[j][3] * wv[3]); }
                d = wave_sum(d);
                if (lane == hh) mine = d;
            }
            if (lane < 8) Fb[((size_t)b * 8 + lane) * LP + pos] = log_sigmoid_f(mine * rs + p.in[14][lane]);
        }
    }
    SEAM(6);
    for (int rep = 0; rep < (IN(7) ? REP7 : 0); ++rep) {
        LAS float* sc = (LAS float*)lds;
        for (int chain = blockIdx.x; chain < (rep == 0 ? 32 : 0); chain += G) {
            float* Fc = Fb + (size_t)chain * LP;
            { float km = 0.f; const int cb = chain >> 3, ch = chain & 7;
              for (int j = 0; j < 17; ++j) { const int idx = tid * 17 + j; if (idx < LP) { const u32x4* kp = (const u32x4*)(QKV + ((size_t)cb * LP + idx) * 2048 + 512 + ch * 64); float s2 = 0.f;
#pragma unroll
                  for (int q4 = 0; q4 < 8; ++q4) { const u32x4 kv = kp[q4]; const float e0 = bflo(kv.x), e1 = bfhi(kv.x), e2 = bflo(kv.y), e3 = bfhi(kv.y), e4 = bflo(kv.z), e5 = bfhi(kv.z), e6 = bflo(kv.w), e7 = bfhi(kv.w);
                      s2 += (e0 * e0 + e1 * e1) + (e2 * e2 + e3 * e3) + (e4 * e4 + e5 * e5) + (e6 * e6 + e7 * e7); }
                  km = fmaxf(km, s2); } }
#pragma unroll
              for (int o2 = 32; o2 >= 1; o2 >>= 1) km = fmaxf(km, __shfl_xor(km, o2));
              if (lane == 0) sc[512 + wave] = km;
              __syncthreads();
              if (tid == 0) { float m8 = sc[512]; for (int w8 = 1; w8 < 8; ++w8) m8 = fmaxf(m8, sc[512 + w8]); ((float*)(ws + WS_CTL + 4096))[chain] = m8; }
              __syncthreads(); }
            float loc[17]; float run = 0.f;
#pragma unroll
            for (int j = 0; j < 17; ++j) { const int idx = tid * 17 + j; const float v = (idx < LP) ? Fc[idx] : 0.f; run += v; loc[j] = run; }
            sc[tid] = run;
            __syncthreads();
            for (int off = 1; off < NTHR; off <<= 1) { const float v = sc[tid] + ((tid >= off) ? sc[tid - off] : 0.f); __syncthreads(); sc[tid] = v; __syncthreads(); }
            const float base = sc[tid] - run;
#pragma unroll
            for (int j = 0; j < 17; ++j) { const int idx = tid * 17 + j; if (idx < LP) Fc[idx] = base + loc[j]; }
            __syncthreads();
        }
        __syncthreads();
        for (int it = gw; it < 4 * 132 * 32; it += NGW) s5_item<false>(p, lds + 1024 * 16 + wave * 13312, it, lane);
    }
    SEAM(7);
    for (int rep = 0; rep < (IN(8) ? REP8 : 0); ++rep) {
        for (int it = gw; it < 4 * 132 * 32; it += NGW) s5_item<true>(p, lds + 1024 * 16 + wave * 13312, it, lane);
        __syncthreads();
        constexpr int NFOX = 32 * 33;
        LAS int* misc = (LAS int*)(lds + att::L_MISC);
        for (;;) {
            if (tid == 0) misc[0] = (int)atomicAdd(ctl + 64 + rep, 1u);
            __syncthreads();
            const int idx = misc[0];
            __syncthreads();
            if (idx >= NFOX) break;
            const int u = 32 - idx / 32, bh = idx % 32, b = bh >> 3, h = bh & 7;
            const int r32 = lane & 31, hi = lane >> 5;
            att::Args a{QKV, 2048, b * LP, u, h * 64, 512 + h * 64, 1024 + h * 64, Fb + (size_t)bh * LP, sqrtf(((const float*)(ws + WS_CTL + 4096))[bh])};
            f32x16 o[2]; float l;
            att::run<1, 2, true>(lds, a, o, l);
            const float inv = 1.0f / l;
            bf16_t* op = CAT + (size_t)(b * LP + 256 * u + 32 * wave + r32) * DM + h * 64;
#pragma unroll
            for (int c = 0; c < 2; ++c)
#pragma unroll
                for (int g4 = 0; g4 < 4; ++g4) { const int dv = 32 * c + 8 * g4 + 4 * hi;
                    u32x2 w; w.x = pk2(o[c][4 * g4] * inv, o[c][4 * g4 + 1] * inv); w.y = pk2(o[c][4 * g4 + 2] * inv, o[c][4 * g4 + 3] * inv); *(u32x2*)(op + dv) = w; }
        }
    }
    SEAM(8);
    for (int rep = 0; rep < (IN(9) ? REP9 : 0); ++rep) {
        pg8::Gemm g{(const bf16_t*)(ws + WS_Y), (const bf16_t*)(ws + WS_WGLU), MROWS, 512, 512}; pg8::StaticOrder S; S.init(NBATCH * SEQ, 512, G, (int)blockIdx.x);
        pg8::EpiGLU E{(const bf16_t*)(ws + WS_Y), p.in[24], CAT};
        pg8::gemm_phase<pg8::EpiGLU, pg8::StaticOrder, true, true>(lds, g, S, E);
    }
    SEAM(9);
    if (IN(10)) {
        pg8::Gemm g{CAT, (const bf16_t*)(ws + WS_W1OUT), MROWS, 1024, 1024}; pg8::StaticOrder S; S.init(NBATCH * SEQ, 1024, G, (int)blockIdx.x);
        pg8::EpiResid E{H, HB, ssq + 3 * MROWS};
        pg8::gemm_phase<pg8::EpiResid, pg8::StaticOrder, true, true>(lds, g, S, E);
    }
    SEAM(10);
    for (int rep = 0; rep < (IN(11) ? REP11 : 0); ++rep) {
        pg8::Gemm g{HB, (const bf16_t*)(ws + WS_WGU1), MROWS, 5632, 1024}; pg8::StaticOrder S; S.init(NBATCH * SEQ, 5632, G, (int)blockIdx.x);
        pg8::EpiSwiGLU E{QKV, ssq + 3 * MROWS};
        pg8::gemm_phase<pg8::EpiSwiGLU, pg8::StaticOrder, true, true>(lds, g, S, E);
    }
    SEAM(11);
    if (IN(12)) {
        pg8::Gemm g{QKV, (const bf16_t*)(ws + WS_WDN1), MROWS, 1024, 2816}; pg8::StaticOrder S; S.init(NBATCH * SEQ, 1024, G, (int)blockIdx.x);
        pg8::EpiResid E{H, HB, nullptr};
        pg8::gemm_phase<pg8::EpiResid, pg8::StaticOrder, true, true>(lds, g, S, E);
    }
    SEAM(12);
    if (IN(13)) {
        const float* fg = p.in[4];
        for (int r = gw; r < NBATCH * SEQ; r += NGW) {
            const int b = r / SEQ, t = r % SEQ; const size_t row = (size_t)b * LP + 256 + t;
            f32x4 v[4]; float s = 0.f;
#pragma unroll
            for (int j = 0; j < 4; ++j) { v[j] = ((const f32x4*)(H + row * DM))[lane + 64 * j]; s += (v[j][0] * v[j][0] + v[j][1] * v[j][1]) + (v[j][2] * v[j][2] + v[j][3] * v[j][3]); }
            const float rs = rsqrtf(wave_sum(s) * (1.0f / 1024.0f) + RMS_EPS);
#pragma unroll
            for (int j = 0; j < 4; ++j) { const f32x4 gv = ((const f32x4*)fg)[lane + 64 * j]; ((f32x4*)(p.out + (size_t)r * DM))[lane + 64 * j] = v[j] * rs * gv; }
        }
    }
#undef IN
#undef SEAM
}

#ifndef N_LAUNCH_MODE
#define N_LAUNCH_MODE 1
#endif
extern "C" void kernel_launch(void* const* d_in, const int* in_sizes, int n_in, void* d_out, int out_size, void* d_ws, size_t ws_size, hipStream_t stream) {
    static int grid = 0;
    if (grid == 0) {
        if (n_in != 27 || ws_size < WS_END || out_size != NBATCH * SEQ * DM) { fprintf(stderr, "kernel_launch: unexpected shapes (n_in %d, ws %zu, out %d)\n", n_in, ws_size, out_size); grid = -1; return; }
        int dev = 0, cus = 0, per_cu = 0;
        (void)hipGetDevice(&dev); (void)hipDeviceGetAttribute(&cus, hipDeviceAttributeMultiprocessorCount, dev);
        if (hipFuncSetAttribute((const void*)mega_fwd, hipFuncAttributeMaxDynamicSharedMemorySize, LDS_BYTES) != hipSuccess) { fprintf(stderr, "kernel_launch: hipFuncSetAttribute failed\n"); grid = -1; return; }
        if (hipOccupancyMaxActiveBlocksPerMultiprocessor(&per_cu, (const void*)mega_fwd, NTHR, LDS_BYTES) != hipSuccess || per_cu < 1) { fprintf(stderr, "kernel_launch: occupancy query says %d\n", per_cu); per_cu = 1; }
        (void)hipGetLastError();
        grid = cus * 1;
        if (grid <= 0) grid = 256;
    }
    if (grid < 0) return;
    Params p{};
    for (int i = 0; i < 27; ++i) p.in[i] = (const float*)d_in[i];
    p.out = (float*)d_out; p.ws = (unsigned char*)d_ws;
#if N_LAUNCH_MODE == 1
    p.ph_lo = 0; p.ph_hi = 14;
    void* args[] = {&p};
    hipError_t e = hipLaunchCooperativeKernel((const void*)mega_fwd, dim3(grid), dim3(NTHR), args, LDS_BYTES, stream);
    if (e != hipSuccess) fprintf(stderr, "cooperative launch failed: %s (grid %d)\n", hipGetErrorString(e), grid);
#else
    for (int ph = 0; ph < 14; ++ph) { p.ph_lo = ph; p.ph_hi = ph + 1; hipLaunchKernelGGL(mega_fwd, dim3(grid), dim3(NTHR), LDS_BYTES, stream, p); }
#endif
}
```

```cpp
#include <hip/hip_runtime.h>
#include <hip/hip_cooperative_groups.h>
#include <cstdio>
#include <cstdint>
namespace cg = cooperative_groups;

#define LAS __attribute__((address_space(3)))
constexpr int DM = 1024, NBATCH = 4, SEQ = 8192, LP = 8448, PADR = 240, NMETA = 16, MROWS = NBATCH * LP;
constexpr int DFF = 2816, NW = 8, NTHR = 512;
constexpr float C2 = 0.125f * 1.4426950408889634f;
constexpr float LOG2E = 1.4426950408889634f;
constexpr float RMS_EPS = 1e-6f;
constexpr int LDS_BYTES = 147456;

constexpr size_t MiB = 1u << 20;
constexpr size_t WS_CTL = 0;
constexpr size_t WS_SSQ = 452 * MiB;
constexpr size_t WS_F = 2 * MiB;
constexpr size_t WS_S5A = 4 * MiB;
constexpr size_t WS_S5BB = 4 * MiB + 65536;
constexpr size_t WS_S5CT = 4 * MiB + 65536 + 262144;
constexpr size_t WS_W1F = 4 * MiB + 65536 + 262144 + 131072;
constexpr size_t WS_S5BT = 4 * MiB + 524288;
constexpr size_t WS_W0IN = 6 * MiB, WS_W0OUT = 12 * MiB, WS_WGU0 = 14 * MiB, WS_WDN0 = 25 * MiB, WS_W1IN = 31 * MiB, WS_WGLU = 35 * MiB, WS_W1OUT = 36 * MiB, WS_WGU1 = 38 * MiB, WS_WDN1 = 49 * MiB;
constexpr size_t WS_H = 56 * MiB;
constexpr size_t WS_HB = 188 * MiB;
constexpr size_t WS_QKV = 254 * MiB;
constexpr size_t WS_Y = 386 * MiB;
constexpr size_t WS_E = 419 * MiB;
constexpr size_t WS_END = 454 * MiB;
constexpr size_t DO_CAT = 0, DO_STASH = 66 * MiB;

typedef unsigned short bf16_t;
typedef short bf16x8 __attribute__((ext_vector_type(8)));
typedef float f32x4 __attribute__((ext_vector_type(4)));
typedef float f32x16 __attribute__((ext_vector_type(16)));
typedef unsigned u32x4 __attribute__((ext_vector_type(4)));
typedef unsigned u32x2 __attribute__((ext_vector_type(2)));
typedef short v4i16_t __attribute__((ext_vector_type(4)));

__device__ __forceinline__ unsigned f2bf(float f) { unsigned u = __builtin_bit_cast(unsigned, f); return (u + 0x7fffu + ((u >> 16) & 1u)) >> 16; }
__device__ __forceinline__ unsigned pk2(float lo, float hi) { return f2bf(lo) | (f2bf(hi) << 16); }
__device__ __forceinline__ float bf2f(unsigned short b) { return __builtin_bit_cast(float, (unsigned)b << 16); }
__device__ __forceinline__ float bflo(unsigned w) { return __builtin_bit_cast(float, w << 16); }
__device__ __forceinline__ float bfhi(unsigned w) { return __builtin_bit_cast(float, w & 0xffff0000u); }
__device__ __forceinline__ float wave_sum(float v) {
#pragma unroll
    for (int o = 32; o >= 1; o >>= 1) v += __shfl_xor(v, o);
    return v;
}
typedef unsigned long long ssq_t;
__device__ __forceinline__ ssq_t ssq_fix(float ss) { return (ssq_t)(ss * 16777216.0f + 0.5f); }
__device__ __forceinline__ float ssq_rs(const ssq_t* p) { const ssq_t v = __hip_atomic_load(p, __ATOMIC_RELAXED, __HIP_MEMORY_SCOPE_AGENT); return rsqrtf((float)v * (1.0f / (16777216.0f * 1024.0f)) + RMS_EPS); }
__device__ __forceinline__ float fexp2(float x) { return __builtin_amdgcn_exp2f(x); }
__device__ __forceinline__ float flog2(float x) { return __builtin_amdgcn_logf(x); }
namespace pg8 {
#define PG8_LAS __attribute__((address_space(3)))
typedef unsigned short bf16_t;
typedef short bf16x8 __attribute__((ext_vector_type(8)));
typedef float f32x4 __attribute__((ext_vector_type(4)));
typedef unsigned u32x4 __attribute__((ext_vector_type(4)));
constexpr int BM = 256, BK = 64, HALF = 128, HTB = HALF * BK * 2  , STAGE_BYTES = 8 * HTB, NXCD = 8, WGM = 8;

__host__ __device__ __forceinline__ int lds_byte(int r, int c) { const int st = (r >> 4) * 2 + (c >> 5), rr = r & 15, cc = c & 31, ob = rr * 64 + cc * 2; return st * 1024 + (ob ^ (((ob >> 9) & 1) << 5)); }
__host__ __device__ __forceinline__ void stage_rc(int b, int& R, int& C) { const int st = b / 1024, sb = b % 1024, swz = sb ^ (((sb >> 9) & 1) << 5); R = (st >> 1) * 16 + swz / 64; C = (st & 1) * 32 + (swz % 64) / 2; }
__host__ __device__ __forceinline__ int perm32(int rho) { const int n = rho >> 4, i = rho & 15; return 8 * (i >> 2) + 4 * n + (i & 3); }

struct Unit { int pm, pn; };
struct Gemm { const bf16_t* A; const bf16_t* Bt; int M, N, K; };

struct StaticOrder {
    int nM, nN, nwg, G, c;
    __host__ __device__ void init(int M, int N, int G_, int c_) { nM = M / BM; nN = N / BM; nwg = nM * nN; G = G_; c = c_; }
    __host__ __device__ bool next(int i, Unit& u) const {
        const long L = (long)i * G + c; if (L >= nwg) return false;
        int wgid = (int)L; { const int q = nwg / NXCD, r = nwg % NXCD, xcd = wgid % NXCD, off = wgid / NXCD; wgid = (xcd < r ? xcd * (q + 1) : r * (q + 1) + (xcd - r) * q) + off; }
        const int nig = WGM * nN, gid = wgid / nig, fm = gid * WGM, gsz = (nM - fm) < WGM ? (nM - fm) : WGM;
        u.pm = fm + ((wgid % nig) % gsz); u.pn = (wgid % nig) / gsz;
        u.pm = u.pm + (u.pm >> 5) + 1;
        return true;
    }
    __device__ __forceinline__ void a_ready(const Unit&) const {}
    __device__ __forceinline__ void done(const Unit&) const {}
};
__device__ __forceinline__ unsigned cvt_pk_bf16(float lo, float hi) { unsigned r; asm volatile("v_cvt_pk_bf16_f32 %0, %1, %2" : "=v"(r) : "v"(lo), "v"(hi)); return r; }
typedef float f32x2 __attribute__((ext_vector_type(2)));
struct EpiScaleBf16 {
    static constexpr bool PERM = true, AFTER_DRAIN = false;
    bf16_t* O; int ldc; const ssq_t* ssq;
    __device__ __forceinline__ void pre(const Unit& u, int wr, int fr, unsigned long long (&rsv)[8]) const {
#pragma unroll
        for (int ai = 0; ai < 2; ++ai)
#pragma unroll
            for (int m = 0; m < 4; ++m) rsv[ai * 4 + m] = __hip_atomic_load(ssq + u.pm * BM + ai * HALF + wr * 64 + m * 16 + fr, __ATOMIC_RELAXED, __HIP_MEMORY_SCOPE_AGENT);
    }
    __device__ __forceinline__ void operator()(const f32x4 (&acc)[2][2][4][2], const Unit& u, int wr, int wc, int fr, int fq, const unsigned long long (&rsv)[8]) const {
        const int col0 = u.pn * BM + wc * 32 + 8 * fq;
#pragma unroll
        for (int ai = 0; ai < 2; ++ai)
#pragma unroll
            for (int m = 0; m < 4; ++m) {
                const int row = u.pm * BM + ai * HALF + wr * 64 + m * 16 + fr;
                const float rs = rsqrtf((float)rsv[ai * 4 + m] * (1.0f / (16777216.0f * 1024.0f)) + 1e-6f);
                bf16_t* rowp = O + (size_t)row * ldc + col0;
#pragma unroll
                for (int bj = 0; bj < 2; ++bj) { const f32x4 v0 = acc[ai][bj][m][0] * rs, v1 = acc[ai][bj][m][1] * rs;
                    u32x4 w; w.x = cvt_pk_bf16(v0[0], v0[1]); w.y = cvt_pk_bf16(v0[2], v0[3]); w.z = cvt_pk_bf16(v1[0], v1[1]); w.w = cvt_pk_bf16(v1[2], v1[3]);
                    *(u32x4*)(rowp + bj * HALF) = w; } }
    }
};
template <bool FINAL>
struct EpiResid {
    static constexpr bool PERM = true, AFTER_DRAIN = false;
    float* hf; bf16_t* hb; ssq_t* ssq;
    __device__ __forceinline__ void pre(const Unit&, int, int, unsigned long long (&)[8]) const {}
    __device__ __forceinline__ void operator()(const f32x4 (&acc)[2][2][4][2], const Unit& u, int wr, int wc, int fr, int fq, const unsigned long long (&rsv)[8]) const {
        const int col0 = u.pn * BM + wc * 32 + 8 * fq;
#pragma unroll
        for (int ai = 0; ai < 2; ++ai)
#pragma unroll
            for (int m = 0; m < 4; ++m) {
                const int row = u.pm * BM + ai * HALF + wr * 64 + m * 16 + fr;
                float ss = 0.f;
#pragma unroll
                for (int bj = 0; bj < 2; ++bj) {
                    bf16_t* bp = hb + (size_t)row * 1024 + col0 + bj * HALF;
                    const u32x4 hv = *(const u32x4*)bp;
                    f32x4 v0 = acc[ai][bj][m][0], v1 = acc[ai][bj][m][1];
                    v0[0] += __builtin_bit_cast(float, hv.x << 16); v0[1] += __builtin_bit_cast(float, hv.x & 0xffff0000u); v0[2] += __builtin_bit_cast(float, hv.y << 16); v0[3] += __builtin_bit_cast(float, hv.y & 0xffff0000u);
                    v1[0] += __builtin_bit_cast(float, hv.z << 16); v1[1] += __builtin_bit_cast(float, hv.z & 0xffff0000u); v1[2] += __builtin_bit_cast(float, hv.w << 16); v1[3] += __builtin_bit_cast(float, hv.w & 0xffff0000u);
                    if (FINAL) { float* hp = hf + (size_t)row * 1024 + col0 + bj * HALF; *(f32x4*)hp = v0; *(f32x4*)(hp + 4) = v1; }
                    else {
                        u32x4 w; w.x = cvt_pk_bf16(v0[0], v0[1]); w.y = cvt_pk_bf16(v0[2], v0[3]); w.z = cvt_pk_bf16(v1[0], v1[1]); w.w = cvt_pk_bf16(v1[2], v1[3]);
                        *(u32x4*)bp = w;
                        const float r0 = __builtin_bit_cast(float, w.x << 16), r1 = __builtin_bit_cast(float, w.x & 0xffff0000u), r2 = __builtin_bit_cast(float, w.y << 16), r3 = __builtin_bit_cast(float, w.y & 0xffff0000u);
                        const float r4 = __builtin_bit_cast(float, w.z << 16), r5 = __builtin_bit_cast(float, w.z & 0xffff0000u), r6 = __builtin_bit_cast(float, w.w << 16), r7 = __builtin_bit_cast(float, w.w & 0xffff0000u);
                        ss += (r0 * r0 + r1 * r1) + (r2 * r2 + r3 * r3) + (r4 * r4 + r5 * r5) + (r6 * r6 + r7 * r7);
                    }
                }
                if (!FINAL) { ss += __shfl_xor(ss, 16); ss += __shfl_xor(ss, 32); if (fq == 0) atomicAdd(ssq + row, ssq_fix(ss)); }
            }
    }
};
struct EpiSwiGLU {
    static constexpr bool PERM = true, AFTER_DRAIN = false;
    bf16_t* O; const ssq_t* ssq;
    __device__ __forceinline__ void pre(const Unit& u, int wr, int fr, unsigned long long (&rsv)[8]) const {
#pragma unroll
        for (int ai = 0; ai < 2; ++ai)
#pragma unroll
            for (int m = 0; m < 4; ++m) rsv[ai * 4 + m] = __hip_atomic_load(ssq + u.pm * BM + ai * HALF + wr * 64 + m * 16 + fr, __ATOMIC_RELAXED, __HIP_MEMORY_SCOPE_AGENT);
    }
    __device__ __forceinline__ void operator()(const f32x4 (&acc)[2][2][4][2], const Unit& u, int wr, int wc, int fr, int fq, const unsigned long long (&rsv)[8]) const {
        const int col0 = u.pn * BM + wc * 32 + 8 * fq;
#pragma unroll
        for (int ai = 0; ai < 2; ++ai)
#pragma unroll
            for (int m = 0; m < 4; ++m) {
                const int row = u.pm * BM + ai * HALF + wr * 64 + m * 16 + fr;
                const float rs = rsqrtf((float)rsv[ai * 4 + m] * (1.0f / (16777216.0f * 1024.0f)) + 1e-6f);
#pragma unroll
                for (int bj = 0; bj < 2; ++bj) { const f32x4 g = acc[ai][bj][m][0] * rs, up = acc[ai][bj][m][1] * rs; float a[4];
#pragma unroll
                    for (int e = 0; e < 4; ++e) a[e] = g[e] * __builtin_amdgcn_rcpf(1.0f + __builtin_amdgcn_exp2f(-1.4426950408889634f * g[e])) * up[e];
                    u32x2 w; w.x = cvt_pk_bf16(a[0], a[1]); w.y = cvt_pk_bf16(a[2], a[3]);
                    *(u32x2*)(O + (size_t)row * 2816 + ((col0 + bj * HALF) >> 1)) = w; } }
    }
};
struct EpiGLU {
    static constexpr bool PERM = true, AFTER_DRAIN = false;
    const bf16_t* Y; const float* bias; bf16_t* O;
    __device__ __forceinline__ void pre(const Unit&, int, int, unsigned long long (&)[8]) const {}
    __device__ __forceinline__ void operator()(const f32x4 (&acc)[2][2][4][2], const Unit& u, int wr, int wc, int fr, int fq, const unsigned long long (&rsv)[8]) const {
        const int col0 = u.pn * BM + wc * 32 + 8 * fq;
#pragma unroll
        for (int ai = 0; ai < 2; ++ai)
#pragma unroll
            for (int m = 0; m < 4; ++m) {
                const int row = u.pm * BM + ai * HALF + wr * 64 + m * 16 + fr;
#pragma unroll
                for (int bj = 0; bj < 2; ++bj) { const int col = col0 + bj * HALF;
                    const u32x4 yv = *(const u32x4*)(Y + (size_t)row * 512 + col);
                    const f32x4 b0 = *(const f32x4*)(bias + col), b1 = *(const f32x4*)(bias + col + 4);
                    const f32x4 z0 = acc[ai][bj][m][0] + b0, z1 = acc[ai][bj][m][1] + b1; float o[8];
                    const float yy[8] = {__builtin_bit_cast(float, yv.x << 16), __builtin_bit_cast(float, yv.x & 0xffff0000u), __builtin_bit_cast(float, yv.y << 16), __builtin_bit_cast(float, yv.y & 0xffff0000u),
                                         __builtin_bit_cast(float, yv.z << 16), __builtin_bit_cast(float, yv.z & 0xffff0000u), __builtin_bit_cast(float, yv.w << 16), __builtin_bit_cast(float, yv.w & 0xffff0000u)};
#pragma unroll
                    for (int e = 0; e < 4; ++e) { o[e] = yy[e] * __builtin_amdgcn_rcpf(1.0f + __builtin_amdgcn_exp2f(-1.4426950408889634f * z0[e])); o[4 + e] = yy[4 + e] * __builtin_amdgcn_rcpf(1.0f + __builtin_amdgcn_exp2f(-1.4426950408889634f * z1[e])); }
                    u32x4 w; w.x = cvt_pk_bf16(o[0], o[1]); w.y = cvt_pk_bf16(o[2], o[3]); w.z = cvt_pk_bf16(o[4], o[5]); w.w = cvt_pk_bf16(o[6], o[7]);
                    *(u32x4*)(O + (size_t)row * 1024 + 512 + col) = w; } }
    }
};
template <class Epi, class Sched, bool ALIGN_EPI = false, bool SP2 = false>
__device__ __forceinline__ void gemm_phase(PG8_LAS unsigned char* lds, const Gemm g, const Sched& S, const Epi& E) {
    int tid_l = threadIdx.x; asm volatile("" : "+v"(tid_l));
    const int tid = tid_l, wid = __builtin_amdgcn_readfirstlane(tid >> 6), lane = tid & 63, wr = wid >> 2, wc = wid & 3, fr = lane & 15, fq = lane >> 4;
    const int K = g.K, nt = K / BK;
    unsigned voffA[2], voffB[2];
#pragma unroll
    for (int i = 0; i < 2; ++i) { int R, C; stage_rc(tid * 16 + i * 8192, R, C); const int Rb = Epi::PERM ? ((R & ~31) + perm32(R & 31)) : R;
        voffA[i] = (unsigned)(R * K + C) * 2u; voffB[i] = (unsigned)(Rb * K + C) * 2u; }
    const size_t kstep = (size_t)(BK * 2);
    const size_t hstep = (size_t)HALF * K * 2;
    const size_t tstep = 2 * hstep;
    const unsigned ldsw = (unsigned)wid * 1024u;
    const int aoff = lds_byte(wr * 64 + fr, fq * 8), boff = lds_byte(wc * 32 + fr, fq * 8);
#define PG8_SA(b, h) (((b) * 2 + (h)) * HTB)
#define PG8_SB(b, h) ((4 + (b) * 2 + (h)) * HTB)
#define PG8_STAGE(bufoff, gbase, voff) do { _Pragma("unroll") for (int _i = 0; _i < 2; ++_i) \
        __builtin_amdgcn_global_load_lds((const unsigned*)((const char*)(gbase) + (voff)[_i]), (PG8_LAS unsigned*)(lds + (bufoff) + ldsw + _i * 8192), 16, 0, 0); } while (0)
#define PG8_LDA(dst, b, h) do { _Pragma("unroll") for (int m = 0; m < 4; ++m) _Pragma("unroll") for (int k = 0; k < 2; ++k) dst[m][k] = *(const PG8_LAS bf16x8*)(lds + PG8_SA(b, h) + aoff + m * 2048 + k * 1024); } while (0)
#define PG8_LDB(dst, b, h) do { _Pragma("unroll") for (int n = 0; n < 2; ++n) _Pragma("unroll") for (int k = 0; k < 2; ++k) dst[n][k] = *(const PG8_LAS bf16x8*)(lds + PG8_SB(b, h) + boff + n * 2048 + k * 1024); } while (0)
#define PG8_MMA(ai, bj, At, Bt) do { __builtin_amdgcn_s_setprio(1); _Pragma("unroll") for (int m = 0; m < 4; ++m) _Pragma("unroll") for (int n = 0; n < 2; ++n) _Pragma("unroll") for (int k = 0; k < 2; ++k) \
        acc[ai][bj][m][n] = __builtin_amdgcn_mfma_f32_16x16x32_bf16(Bt[n][k], At[m][k], acc[ai][bj][m][n], 0, 0, 0); __builtin_amdgcn_s_setprio(0); } while (0)
#define PG8_WAIT_V(n) asm volatile("s_waitcnt vmcnt(" #n ")" ::: "memory")
#define PG8_WAIT_L(n) asm volatile("s_waitcnt lgkmcnt(" #n ")" ::: "memory")
#define PG8_BAR __builtin_amdgcn_s_barrier()
#define PG8_SCHED __builtin_amdgcn_sched_barrier(0)
    Unit cur, nxt; int ui = 0;
    if (!S.next(0, cur)) return;
    f32x4 acc[2][2][4][2];
    unsigned long long rsv[8];
#pragma unroll
    for (int i_ = 0; i_ < 8; ++i_) rsv[i_] = 0ull;
#pragma unroll
    for (int a = 0; a < 2; ++a)
#pragma unroll
        for (int b = 0; b < 2; ++b)
#pragma unroll
            for (int m = 0; m < 4; ++m)
#pragma unroll
                for (int n = 0; n < 2; ++n) acc[a][b][m][n] = (f32x4){0.f, 0.f, 0.f, 0.f};
    bf16x8 At[4][2], B0[2][2], B1[2][2];
    const char* cA = (const char*)g.A + (size_t)cur.pm * tstep; const char* cB = (const char*)g.Bt + (size_t)cur.pn * tstep;
    S.a_ready(cur);
    if constexpr (SP2) {
        PG8_STAGE(PG8_SB(0, 0), cB, voffB); PG8_STAGE(PG8_SB(0, 1), cB + hstep, voffB); PG8_STAGE(PG8_SA(0, 0), cA, voffA); PG8_STAGE(PG8_SA(0, 1), cA + hstep, voffA);
        if (wr == 1) PG8_BAR;
        PG8_WAIT_V(2); PG8_BAR;
        PG8_STAGE(PG8_SB(1, 0), cB + kstep, voffB); PG8_STAGE(PG8_SA(1, 0), cA + kstep, voffA); PG8_STAGE(PG8_SB(1, 1), cB + hstep + kstep, voffB);
        PG8_WAIT_V(6); PG8_BAR;
    } else {
        PG8_STAGE(PG8_SB(0, 0), cB, voffB); PG8_STAGE(PG8_SA(0, 0), cA, voffA); PG8_STAGE(PG8_SB(0, 1), cB + hstep, voffB); PG8_STAGE(PG8_SA(0, 1), cA + hstep, voffA);
        if (wr == 1) PG8_BAR;
        PG8_WAIT_V(4); PG8_BAR;
        PG8_STAGE(PG8_SB(1, 0), cB + kstep, voffB); PG8_STAGE(PG8_SA(1, 0), cA + kstep, voffA); PG8_STAGE(PG8_SB(1, 1), cB + hstep + kstep, voffB);
        PG8_WAIT_V(6); PG8_BAR;
    }
    for (;;) {
        const bool has_next = S.next(ui + 1, nxt);
        const char* nA = has_next ? (const char*)g.A + (size_t)nxt.pm * tstep : cA; const char* nB = has_next ? (const char*)g.Bt + (size_t)nxt.pn * tstep : cB;
        for (int t = 0; t < nt; t += 2) {
            const bool last = (t == nt - 2);
            if (last) E.pre(cur, wr, fr, rsv);
            const char* a1 = cA + (size_t)(t + 1) * kstep;
            const char* a2 = last ? nA : cA + (size_t)(t + 2) * kstep; const char* b2 = last ? nB : cB + (size_t)(t + 2) * kstep;
            const char* a3 = a2 + kstep; const char* b3 = b2 + kstep;
            if (last && has_next) S.a_ready(nxt);
            if constexpr (SP2) {
            PG8_LDB(B0, 0, 0); PG8_LDB(B1, 0, 1); PG8_SCHED; PG8_LDA(At, 0, 0); PG8_STAGE(PG8_SA(1, 1), a1 + hstep, voffA);
            PG8_WAIT_V(8); PG8_WAIT_L(0); PG8_BAR; PG8_MMA(0, 0, At, B0); PG8_MMA(0, 1, At, B1); PG8_BAR; PG8_SCHED;
            PG8_LDA(At, 0, 1); PG8_STAGE(PG8_SB(0, 0), b2, voffB); PG8_STAGE(PG8_SB(0, 1), b2 + hstep, voffB); PG8_STAGE(PG8_SA(0, 0), a2, voffA);
            PG8_WAIT_V(8); PG8_WAIT_L(0); PG8_BAR; PG8_MMA(1, 0, At, B0); PG8_MMA(1, 1, At, B1); PG8_BAR; PG8_SCHED;
            PG8_LDB(B0, 1, 0); PG8_LDB(B1, 1, 1); PG8_SCHED; PG8_LDA(At, 1, 0); PG8_STAGE(PG8_SA(0, 1), a2 + hstep, voffA);
            PG8_WAIT_V(8); PG8_WAIT_L(0); PG8_BAR; PG8_MMA(0, 0, At, B0); PG8_MMA(0, 1, At, B1); PG8_BAR; PG8_SCHED;
            PG8_LDA(At, 1, 1); PG8_STAGE(PG8_SB(1, 0), b3, voffB); PG8_STAGE(PG8_SB(1, 1), b3 + hstep, voffB); PG8_STAGE(PG8_SA(1, 0), a3, voffA);
            PG8_WAIT_V(8); PG8_WAIT_L(0); PG8_BAR; PG8_MMA(1, 0, At, B0); PG8_MMA(1, 1, At, B1); PG8_BAR; PG8_SCHED;
            } else {
            PG8_LDB(B0, 0, 0); PG8_SCHED; PG8_LDA(At, 0, 0); PG8_STAGE(PG8_SA(1, 1), a1 + hstep, voffA);
            PG8_WAIT_L(8); PG8_BAR; PG8_WAIT_L(0); PG8_MMA(0, 0, At, B0); PG8_BAR; PG8_SCHED;
            PG8_LDB(B1, 0, 1); PG8_STAGE(PG8_SB(0, 0), b2, voffB);
            PG8_BAR; PG8_WAIT_L(0); PG8_MMA(0, 1, At, B1); PG8_BAR;
            PG8_LDA(At, 0, 1); PG8_STAGE(PG8_SA(0, 0), a2, voffA);
            PG8_BAR; PG8_WAIT_L(0); PG8_MMA(1, 0, At, B0); PG8_BAR; PG8_SCHED;
            PG8_STAGE(PG8_SB(0, 1), b2 + hstep, voffB);
            PG8_WAIT_V(6); PG8_BAR; PG8_MMA(1, 1, At, B1); PG8_BAR;
            PG8_LDB(B0, 1, 0); PG8_SCHED; PG8_LDA(At, 1, 0); PG8_STAGE(PG8_SA(0, 1), a2 + hstep, voffA);
            PG8_WAIT_L(8); PG8_BAR; PG8_WAIT_L(0); PG8_MMA(0, 0, At, B0); PG8_BAR; PG8_SCHED;
            PG8_LDB(B1, 1, 1); PG8_STAGE(PG8_SB(1, 0), b3, voffB);
            PG8_BAR; PG8_WAIT_L(0); PG8_MMA(0, 1, At, B1); PG8_BAR;
            PG8_LDA(At, 1, 1); PG8_STAGE(PG8_SA(1, 0), a3, voffA);
            PG8_BAR; PG8_WAIT_L(0); PG8_MMA(1, 0, At, B0); PG8_BAR; PG8_SCHED;
            PG8_STAGE(PG8_SB(1, 1), b3 + hstep, voffB);
            PG8_WAIT_V(6); PG8_BAR; PG8_MMA(1, 1, At, B1); PG8_BAR;
            }
        }
        if constexpr (ALIGN_EPI) { if (wr == 0) PG8_BAR; }
        if constexpr (!Epi::AFTER_DRAIN) { E(acc, cur, wr, wc, fr, fq, rsv); S.done(cur); }
        if (!has_next) break;
#pragma unroll
        for (int a = 0; a < 2; ++a)
#pragma unroll
            for (int b = 0; b < 2; ++b)
#pragma unroll
                for (int m = 0; m < 4; ++m)
#pragma unroll
                    for (int n = 0; n < 2; ++n) acc[a][b][m][n] = (f32x4){0.f, 0.f, 0.f, 0.f};
        cur = nxt; cA = nA; cB = nB; ++ui;
        if constexpr (ALIGN_EPI) { if (wr == 1) PG8_BAR; }
    }
    PG8_WAIT_V(0);
    if constexpr (!ALIGN_EPI) { if (wr == 0) PG8_BAR; }
    PG8_BAR;
    if constexpr (Epi::AFTER_DRAIN) { E.fused(acc, cur, wr, wc, fr, fq, lds, wid, lane); S.done(cur); }
#undef PG8_SA
#undef PG8_SB
#undef PG8_STAGE
#undef PG8_LDA
#undef PG8_LDB
#undef PG8_MMA
#undef PG8_WAIT_V
#undef PG8_WAIT_L
#undef PG8_BAR
#undef PG8_SCHED
}
}
namespace att {
constexpr int KROW = 144, KBUF = 64 * KROW;
constexpr int VBUF = 16384;
constexpr int L_K = 0, L_V = 2 * KBUF, L_BIAS = L_V + 3 * VBUF, L_FLAG = L_BIAS + 2 * 64 * 4, L_MISC = L_FLAG + 64, L_END = L_MISC + 64;
__device__ __forceinline__ int crow(int r, int hi) { return (r & 3) + 8 * (r >> 2) + 4 * hi; }
__device__ __forceinline__ unsigned cvtpk(float lo, float hi) { unsigned r; asm volatile("v_cvt_pk_bf16_f32 %0, %1, %2" : "=v"(r) : "v"(lo), "v"(hi)); return r; }

struct Args { const bf16_t* qkv; int pitch; int rowb; int u; int qcol, kcol, vcol; const float* F; float kmax; };


template <bool MASKED>
__device__ __forceinline__ void sb_tile(f32x16 (&x)[2], float& carry, int tlo, int hi, int qpos) {
#pragma unroll
                for (int xt = 1; xt >= 0; --xt) {
                    float lm[16], G[4], Gp[4];
#pragma unroll
                    for (int r = 0; r < 16; ++r) {
                        const float z = x[xt][r], sp = fmaxf(z, 0.f) + flog2(1.0f + fexp2(-fabsf(z)));
                        bool valid = true;
                        if (MASKED) { const int kvp = tlo + 32 * xt + crow(r, hi); valid = (kvp < qpos) && (kvp >= PADR); }
                        lm[r] = valid ? -sp : 0.f;
                        x[xt][r] = valid ? (z - sp) : -1e30f;
                    }
#pragma unroll
                    for (int g = 0; g < 4; ++g) { G[g] = (lm[4 * g] + lm[4 * g + 1]) + (lm[4 * g + 2] + lm[4 * g + 3]); Gp[g] = __shfl_xor(G[g], 32); }
                    float runv = carry;
#pragma unroll
                    for (int g = 3; g >= 0; --g) {
                        const float g1 = hi ? G[g] : Gp[g], g0 = hi ? Gp[g] : G[g];
                        const float sg = hi ? runv : (runv + g1);
                        const float c3 = sg, c2 = c3 + lm[4 * g + 3], c1 = c2 + lm[4 * g + 2], c0 = c1 + lm[4 * g + 1];
                        x[xt][4 * g + 3] = fexp2(x[xt][4 * g + 3] + c3); x[xt][4 * g + 2] = fexp2(x[xt][4 * g + 2] + c2);
                        x[xt][4 * g + 1] = fexp2(x[xt][4 * g + 1] + c1); x[xt][4 * g] = fexp2(x[xt][4 * g] + c0);
                        runv = runv + (g1 + g0);
                    }
                    carry = runv;
                }
}
template <int MODE, int NDV, bool BIAS>
__device__ __forceinline__ void tile_compute(LAS unsigned char* lds, int kt, int buf, int vs, const bf16x8 (&qf)[4], f32x16 (&o)[NDV],
                                             float& mrun, float& lrun, float& carry, f32x16& negm, f32x16& osum, bool wdone, bool& pend, int& vsp, int w, int lane, int r32, int hi, int qmin, int qpos, unsigned vlane) {
#define ATT_PV(VS_) do { const unsigned vba = (unsigned)(uintptr_t)(lds + L_V + (VS_) * VBUF + vlane);     \
        _Pragma("unroll") for (int ks = 0; ks < 4; ++ks) { \
            v4i16_t lo_[NDV], hh_[NDV]; \
            _Pragma("unroll") for (int c = 0; c < NDV; ++c) { \
                asm volatile("ds_read_b64_tr_b16 %0, %1 offset:%c2" : "=&v"(lo_[c]) : "v"(vba), "i"((2 * ks) * (NDV * 512) + 512 * c) : "memory"); \
                asm volatile("ds_read_b64_tr_b16 %0, %1 offset:%c2" : "=&v"(hh_[c]) : "v"(vba), "i"((2 * ks + 1) * (NDV * 512) + 512 * c) : "memory"); } \
            if (NDV == 4) asm volatile("s_waitcnt lgkmcnt(0)" : "+v"(lo_[0]), "+v"(hh_[0]), "+v"(lo_[1]), "+v"(hh_[1]), "+v"(lo_[2 % NDV]), "+v"(hh_[2 % NDV]), "+v"(lo_[3 % NDV]), "+v"(hh_[3 % NDV]) :: "memory");     \
            else asm volatile("s_waitcnt lgkmcnt(0)" : "+v"(lo_[0]), "+v"(hh_[0]), "+v"(lo_[1]), "+v"(hh_[1]) :: "memory"); \
            bf16x8 pb; { u32x4 t4 = {pk[ks][0], pk[ks][1], pk[ks][2], pk[ks][3]}; pb = __builtin_bit_cast(bf16x8, t4); } \
            _Pragma("unroll") for (int c = 0; c < NDV; ++c) { \
                const bf16x8 va = {lo_[c][0], lo_[c][1], lo_[c][2], lo_[c][3], hh_[c][0], hh_[c][1], hh_[c][2], hh_[c][3]}; \
                o[c] = __builtin_amdgcn_mfma_f32_32x32x16_bf16(va, pb, o[c], 0, 0, 0); } } } while (0)
        const int tlo = 64 * kt;
        const bool skip = wdone || ((MODE == 0) ? (tlo >= qmin + 31) : (tlo > qmin + 31));
        if (!skip) {
            unsigned pk[4][4];
            const bool needmask = (kt == 3) || ((MODE == 0) ? (tlo + 63 >= qmin) : (tlo + 63 > qmin));
            const LAS unsigned char* kb = lds + L_K + buf * KBUF + r32 * KROW + 16 * hi;
            f32x16 x[2];
#pragma unroll
            for (int xt = 0; xt < 2; ++xt) {
                if (BIAS) {
                    const LAS float* bp = (const LAS float*)(lds + L_BIAS + buf * 256) + 32 * xt + 4 * hi;
#pragma unroll
                    for (int g = 0; g < 4; ++g) { const f32x4 bv = *(const LAS f32x4*)(bp + 8 * g); x[xt][4 * g] = bv[0]; x[xt][4 * g + 1] = bv[1]; x[xt][4 * g + 2] = bv[2]; x[xt][4 * g + 3] = bv[3]; }
                } else if (MODE == 0) {
#pragma unroll
                    for (int r = 0; r < 16; ++r) x[xt][r] = 0.f;
                }
#pragma unroll
                for (int d0 = 0; d0 < 4; ++d0) { const bf16x8 kf = *(const LAS bf16x8*)(kb + xt * 32 * KROW + 32 * d0);
                    if (MODE == 1 && !BIAS && d0 == 0) x[xt] = __builtin_amdgcn_mfma_f32_32x32x16_bf16(kf, qf[d0], negm, 0, 0, 0);
                    else x[xt] = __builtin_amdgcn_mfma_f32_32x32x16_bf16(kf, qf[d0], x[xt], 0, 0, 0); }
            }
            if (MODE == 1) {
                if (needmask) {
#pragma unroll
                    for (int xt = 0; xt < 2; ++xt)
#pragma unroll
                        for (int r = 0; r < 16; ++r) { const int kvp = tlo + 32 * xt + crow(r, hi); if (kvp > qpos || kvp < PADR) x[xt][r] = -1e30f; }
                }
                float mx = x[0][0];
#pragma unroll
                for (int r = 1; r < 16; ++r) mx = fmaxf(mx, x[0][r]);
#pragma unroll
                for (int r = 0; r < 16; ++r) mx = fmaxf(mx, x[1][r]);
                if (BIAS) {
                    mx = fmaxf(mx, __shfl_xor(mx, 32));
                    const float mnew = fmaxf(mrun, mx), alpha = fexp2(mrun - mnew); mrun = mnew;
#pragma unroll
                    for (int xt = 0; xt < 2; ++xt)
#pragma unroll
                        for (int r = 0; r < 16; ++r) x[xt][r] = fexp2(x[xt][r] - mnew);
                    if (__any(alpha != 1.0f)) {
#pragma unroll
                        for (int c = 0; c < NDV; ++c)
#pragma unroll
                            for (int r = 0; r < 16; ++r) o[c][r] *= alpha;
#pragma unroll
                        for (int r = 0; r < 16; ++r) osum[r] *= alpha;
                    }
                } else {
                    const bool first = (carry == 0.f);
                    if (first || __any(mx > 8.0f)) {
                        carry = 1.f;
                        mx = fmaxf(mx, __shfl_xor(mx, 32));
                        const float dl = first ? ((mx > -1e29f) ? mx : 0.f) : fmaxf(mx, 0.f);
                        const float alpha = first ? 1.0f : fexp2(-dl);
                        mrun += dl; lrun *= alpha;
#pragma unroll
                        for (int xt = 0; xt < 2; ++xt)
#pragma unroll
                            for (int r = 0; r < 16; ++r) x[xt][r] -= dl;
#pragma unroll
                        for (int r = 0; r < 16; ++r) negm[r] = -mrun;
#pragma unroll
                        for (int c = 0; c < NDV; ++c)
#pragma unroll
                            for (int r = 0; r < 16; ++r) o[c][r] *= alpha;
                    }
                    float ps = 0.f;
#pragma unroll
                    for (int xt = 0; xt < 2; ++xt)
#pragma unroll
                        for (int r = 0; r < 16; ++r) { const float pv = fexp2(x[xt][r]); x[xt][r] = pv; ps += pv; }
                    lrun += ps;
                }
            } else {
                if (needmask) sb_tile<true>(x, carry, tlo, hi, qpos); else sb_tile<false>(x, carry, tlo, hi, qpos);
            }
#pragma unroll
            for (int ks = 0; ks < 4; ++ks)
#pragma unroll
                for (int j = 0; j < 4; ++j) pk[ks][j] = cvtpk(x[ks >> 1][8 * (ks & 1) + 2 * j], x[ks >> 1][8 * (ks & 1) + 2 * j + 1]);
            if (BIAS) {
                const bf16x8 ones = {(short)0x3F80, (short)0x3F80, (short)0x3F80, (short)0x3F80, (short)0x3F80, (short)0x3F80, (short)0x3F80, (short)0x3F80};
#pragma unroll
                for (int ks = 0; ks < 4; ++ks) { const u32x4 t4 = {pk[ks][0], pk[ks][1], pk[ks][2], pk[ks][3]}; osum = __builtin_amdgcn_mfma_f32_32x32x16_bf16(ones, __builtin_bit_cast(bf16x8, t4), osum, 0, 0, 0); }
            }
            ATT_PV(vs);
        }
}
#undef ATT_PV

template <int MODE, int NDV, bool BIAS>
__device__ __forceinline__ void run(LAS unsigned char* lds, const Args& a, f32x16 (&o)[NDV], float& l_out) {
    int tid_l = threadIdx.x; asm volatile("" : "+v"(tid_l));
    const int tid = tid_l, lane = tid & 63, w = __builtin_amdgcn_readfirstlane(tid >> 6), r32 = lane & 31, hi = lane >> 5;
    const int qmin = 256 * a.u + 32 * w, qpos = qmin + r32;
    constexpr int NV = NDV / 2;
    bf16x8 qf[4];
    { const bf16_t* qp = a.qkv + (size_t)(a.rowb + qpos) * a.pitch + a.qcol + 8 * hi;
#pragma unroll
      for (int d0 = 0; d0 < 4; ++d0) qf[d0] = *(const bf16x8*)(qp + 16 * d0); }
    float qkb = 0.f;
    if (BIAS) { float s2 = 0.f;
#pragma unroll
        for (int d0 = 0; d0 < 4; ++d0)
#pragma unroll
            for (int j = 0; j < 8; ++j) { const float qv = bf2f((unsigned short)qf[d0][j]); s2 += qv * qv; }
        s2 += __shfl_xor(s2, 32); qkb = sqrtf(s2) * a.kmax * 1.001f + 1e-3f; }
    const int kr = tid >> 3, kc = tid & 7;
    const bf16_t* kg = a.qkv + (size_t)(a.rowb + kr) * a.pitch + a.kcol + 8 * kc;
    const unsigned klds = kr * KROW + kc * 16;
    const bf16_t* vg[NV]; unsigned vlds[NV];
#pragma unroll
    for (int j = 0; j < NV; ++j) {
        int vr, ch; if (NDV == 2) { vr = tid >> 3; ch = tid & 7; } else { vr = (tid >> 4) + 32 * j; ch = tid & 15; }
        vg[j] = a.qkv + (size_t)(a.rowb + vr) * a.pitch + a.vcol + 8 * ch;
        vlds[j] = (vr >> 3) * (NDV * 512) + (ch >> 2) * 512 + (vr & 7) * 64 + (ch & 3) * 16;
    }
    const size_t tstride = (size_t)64 * a.pitch;
    float fq0 = 0.f; if (BIAS) fq0 = a.F[256 * a.u];
    const int ntile = 4 * a.u + 1;
#define ATT_TILE(i) ((MODE == 0 || BIAS) ? (4 * a.u + 3 - (i)) : (3 + (i)))
    u32x4 kregA, vregA[NV]; float bregA = 0.f, ubnA = 0.f, ubn_next = 0.f;
#define ATT_LOADX(KR, VR, BR, UB, kt) do { KR = *(const u32x4*)(kg + (size_t)(kt) * tstride); _Pragma("unroll") for (int j_ = 0; j_ < NV; ++j_) VR[j_] = *(const u32x4*)(vg[j_] + (size_t)(kt) * tstride); \
        if (BIAS) { if (tid < 64) BR = (fq0 - a.F[64 * (kt) + tid]) * LOG2E; UB = (fq0 - a.F[64 * (kt) + 63]) * LOG2E; } } while (0)
#define ATT_WRITEX(KR, VR, BR, UB, b, vs_) do { *(LAS u32x4*)(lds + L_K + (b) * KBUF + klds) = KR; _Pragma("unroll") for (int j_ = 0; j_ < NV; ++j_) *(LAS u32x4*)(lds + L_V + (vs_) * VBUF + vlds[j_]) = VR[j_]; \
        if (BIAS) { if (tid < 64) *(LAS float*)(lds + L_BIAS + (b) * 256 + tid * 4) = BR; ubn_next = UB; } } while (0)
#define ATT_LOADA(kt) ATT_LOADX(kregA, vregA, bregA, ubnA, kt)
#define ATT_WRITEA(b, vs_) ATT_WRITEX(kregA, vregA, bregA, ubnA, b, vs_)
#pragma unroll
    for (int c = 0; c < NDV; ++c)
#pragma unroll
        for (int r = 0; r < 16; ++r) o[c][r] = 0.f;
    float mrun = (MODE == 1 && !BIAS) ? 0.f : -1e30f, lrun = 0.f, carry = 0.f;
    f32x16 negm, osum;
#pragma unroll
    for (int r = 0; r < 16; ++r) { negm[r] = 0.f; osum[r] = 0.f; }
    const unsigned vlane = 64 * (4 * hi + ((lane & 15) >> 2)) + 32 * ((lane >> 4) & 1) + 8 * (lane & 3);
    ATT_LOADA(ATT_TILE(0)); ATT_WRITEA(0, 0);
    asm volatile("" :: "v"(qf[0]), "v"(qf[1]), "v"(qf[2]), "v"(qf[3]));
    __syncthreads();
    bool pend = false; int vsp = 0, vs = 0;
#define ATT_ITER(i_) do { \
        const int kt_ = ATT_TILE(i_), buf_ = (i_) & 1; vs = (i_) % 3; \
        if ((i_) + 1 < ntile) ATT_LOADA(ATT_TILE((i_) + 1)); \
        bool wdone_ = false; if (MODE == 0) wdone_ = __all(carry < -160.0f) != 0; if (BIAS) wdone_ = __all(qkb + ub_cur - mrun < -160.0f) != 0; \
        tile_compute<MODE, NDV, BIAS>(lds, kt_, buf_, vs, qf, o, mrun, lrun, carry, negm, osum, wdone_, pend, vsp, w, lane, r32, hi, qmin, qpos, vlane); \
        if (MODE == 0) { const int ok = __all(carry < -160.0f) ? 1 : 0; if (lane == 0) *(LAS int*)(lds + L_FLAG + (buf_ * 8 + w) * 4) = ok; } \
        if ((i_) + 1 < ntile) ATT_WRITEA(buf_ ^ 1, ((i_) + 1) % 3); \
        ub_cur = ubn_next; \
        if (BIAS) { const int ok = __all(qkb + ubn_next - mrun < -160.0f) ? 1 : 0; if (lane == 0) *(LAS int*)(lds + L_FLAG + (buf_ * 8 + w) * 4) = ok; } \
        __syncthreads(); \
        if (MODE == 0 || BIAS) { const LAS int* fl = (const LAS int*)(lds + L_FLAG + buf_ * 32); \
            if (fl[0] & fl[1] & fl[2] & fl[3] & fl[4] & fl[5] & fl[6] & fl[7]) stop = true; } } while (0)
    bool stop = false;
    float ub_cur = ubn_next;
    for (int i = 0; i < ntile && !stop; ++i) ATT_ITER(i);
    __syncthreads();
    l_out = BIAS ? osum[0] : (lrun + __shfl_xor(lrun, 32));
#undef ATT_TILE
#undef ATT_LOADX
#undef ATT_WRITEX
#undef ATT_LOADA
#undef ATT_WRITEA
#undef ATT_ITER
}
}
struct Params { const float* in[27]; float* out; unsigned char* ws; int ph_lo, ph_hi; };

__device__ __forceinline__ float log_sigmoid_f(float x) { return -(fmaxf(-x, 0.f) + log1pf(expf(-fabsf(x)))); }
__device__ __forceinline__ float gelu_tanh_f(float x) { const float z = 0.7978845608028654f * (x + 0.044715f * x * x * x); const float t = 1.0f - 2.0f / (__expf(2.0f * z) + 1.0f); return 0.5f * x * (1.0f + t); }

__device__ __forceinline__ void map_col(int kind, int n, int& dr, float& sc) {
    sc = 1.0f; dr = n;
    if (kind == 1) { if (n < 512 || (n >= 1536 && n < 2048)) sc = C2; }
    else if (kind == 2) { if (n < 512) sc = C2; else if (n >= 1536 && n < 1544) dr = -1; else if (n >= 1544) dr = n - 8; }
    else if (kind == 3) { if (n < 2816) dr = 8 * (n >> 2) + (n & 3); else { const int j = n - 2816; dr = 8 * (j >> 2) + 4 + (j & 3); } }
}
__device__ __forceinline__ void transpose_item(const float* W, int K, int N, const float* gk, bf16_t* WT, int kind, LAS float* scr, int item, int lane) {
    const int nblk = (N + 31) / 32, kb = item / nblk, nb = item % nblk, k0 = 64 * kb, n0 = 32 * nb;
    float wv[32];
    { const int n = n0 + (lane & 31); const bool inb = n < N; const float* wp = W + (size_t)(k0 + (lane >> 5)) * N + (inb ? n : 0);
#pragma unroll
      for (int i = 0; i < 32; ++i) wv[i] = inb ? wp[(size_t)(2 * i) * N] : 0.f;
      if (gk) {
#pragma unroll
          for (int i = 0; i < 32; ++i) wv[i] *= gk[k0 + 2 * i + (lane >> 5)];
      }
#pragma unroll
      for (int i = 0; i < 32; ++i) scr[(2 * i + (lane >> 5)) * 33 + (lane & 31)] = wv[i]; }
    asm volatile("s_waitcnt lgkmcnt(0)" ::: "memory");
    const int c = lane & 7;
#pragma unroll
    for (int j = 0; j < 4; ++j) { const int nl = (lane >> 3) + 8 * j, n = n0 + nl;
        if (n < N) { int dr; float sc; map_col(kind, n, dr, sc);
            if (dr >= 0) { const LAS float* s = scr + (8 * c) * 33 + nl;
                u32x4 o; o.x = pk2(s[0 * 33] * sc, s[1 * 33] * sc); o.y = pk2(s[2 * 33] * sc, s[3 * 33] * sc); o.z = pk2(s[4 * 33] * sc, s[5 * 33] * sc); o.w = pk2(s[6 * 33] * sc, s[7 * 33] * sc);
                *(u32x4*)(WT + (size_t)dr * K + k0 + 8 * c) = o; } } }
    asm volatile("s_waitcnt lgkmcnt(0)" ::: "memory");
}

struct S5Ops { float ar, ai, dsk; bf16x8 bfr[4], af[2], cf[4]; unsigned short uq[16]; };
template <bool FINAL>
__device__ __forceinline__ void s5_load(const Params& p, int item, int lane, S5Ops& q) {
    const int g = item & 31, bc = item >> 5, c = bc % 132, b = bc / 132;
    const unsigned char* ws = p.ws;
    const bf16_t* qkv = (const bf16_t*)(ws + WS_QKV);
    const float* a_re_p = (const float*)(ws + WS_S5A); const float* a_im_p = a_re_p + 2048;
    const int gp = g * 64 + lane, r32 = lane & 31, hi = lane >> 5;
    q.ar = a_re_p[gp]; q.ai = a_im_p[gp];
    { const bf16_t* bt = (const bf16_t*)(ws + WS_S5BT) + ((size_t)g * 128 + r32) * 16 + 8 * hi;
#pragma unroll
      for (int pb = 0; pb < 4; ++pb) q.bfr[pb] = *(const bf16x8*)(bt + pb * 32 * 16); }
    const bf16_t* urow = qkv + ((size_t)b * LP + 64 * c) * 2048 + 1536 + 16 * g;
#pragma unroll
    for (int sub = 0; sub < 2; ++sub) q.af[sub] = *(const bf16x8*)(urow + (size_t)(32 * sub + r32) * 2048 + 8 * hi);
    q.dsk = 0.f;
    if (FINAL) {
        const bf16_t* ct = (const bf16_t*)(ws + WS_S5CT) + ((size_t)g * 16 + (lane & 15)) * 128 + 8 * (lane >> 4);
#pragma unroll
        for (int ks = 0; ks < 4; ++ks) q.cf[ks] = *(const bf16x8*)(ct + 32 * ks);
        q.dsk = p.in[22][g * 16 + (lane & 15)];
#pragma unroll
        for (int k = 0; k < 16; ++k) { const int t = 32 * (k >> 3) + 16 * ((k >> 2) & 1) + 4 * (lane >> 4) + (k & 3); q.uq[k] = urow[(size_t)t * 2048 + (lane & 15)]; }
    }
}
template <bool FINAL>
__device__ __forceinline__ void s5_compute(const Params& p, LAS unsigned char* wl  , int item, int lane, const S5Ops& q) {
    const int g = item & 31, bc = item >> 5, c = bc % 132, b = bc / 132;
    const unsigned char* ws = p.ws;
    float2* E = (float2*)(ws + WS_E);
    const int r32 = lane & 31, hi = lane >> 5;
    const float ar = q.ar, ai = q.ai;
    float xr = 0.f, xi = 0.f;
    if (FINAL) {
        float pr_ = ar, pi_ = ai;
#pragma unroll
        for (int s = 0; s < 6; ++s) { const float nr = pr_ * pr_ - pi_ * pi_, ni = 2.0f * pr_ * pi_; pr_ = nr; pi_ = ni; }
        const float2* Eb = E + ((size_t)b * 132 * 32 + g) * 64 + lane;
        int cc = 0;
        for (; cc + 8 <= c; cc += 8) {
            float2 e[8];
#pragma unroll
            for (int k = 0; k < 8; ++k) e[k] = Eb[(size_t)(cc + k) * 32 * 64];
#pragma unroll
            for (int k = 0; k < 8; ++k) { const float nr = pr_ * xr - pi_ * xi + e[k].x, ni = pr_ * xi + pi_ * xr + e[k].y; xr = nr; xi = ni; }
        }
        for (; cc < c; ++cc) { const float2 e = Eb[(size_t)cc * 32 * 64]; const float nr = pr_ * xr - pi_ * xi + e.x, ni = pr_ * xi + pi_ * xr + e.y; xr = nr; xi = ni; }
    }
    LAS float* BU = (LAS float*)wl;
#pragma unroll 1
    for (int sub = 0; sub < 2; ++sub) {
#pragma unroll
        for (int pb = 0; pb < 4; ++pb) {
            f32x16 z;
#pragma unroll
            for (int r = 0; r < 16; ++r) z[r] = 0.f;
            const f32x16 d = __builtin_amdgcn_mfma_f32_32x32x16_bf16(sub == 0 ? q.af[0] : q.af[1], q.bfr[pb], z, 0, 0, 0);
#pragma unroll
            for (int r = 0; r < 16; ++r) BU[((r & 3) + 8 * (r >> 2) + 4 * hi) * 128 + 32 * pb + r32] = d[r];
        }
        asm volatile("s_waitcnt lgkmcnt(0)" ::: "memory");
#pragma unroll 8
        for (int tt = 0; tt < 32; ++tt) {
            const float sr = BU[tt * 128 + lane], si = BU[tt * 128 + 64 + lane];
            const float nr = ar * xr - ai * xi + sr, ni = ar * xi + ai * xr + si; xr = nr; xi = ni;
            if (FINAL) {
                LAS unsigned char* xrow = wl + tt * 512;
                *(LAS bf16_t*)(xrow + (((lane >> 3) ^ (tt & 15)) << 4) + ((lane & 7) << 1)) = (bf16_t)f2bf(xr);
                *(LAS bf16_t*)(xrow + ((((64 + lane) >> 3) ^ (tt & 15)) << 4) + ((lane & 7) << 1)) = (bf16_t)f2bf(xi);
            }
        }
        if (FINAL) {
            asm volatile("s_waitcnt lgkmcnt(0)" ::: "memory");
            bf16_t* Y = (bf16_t*)(ws + WS_Y);
#pragma unroll
            for (int mb = 0; mb < 2; ++mb) {
                f32x4 acc = {0.f, 0.f, 0.f, 0.f};
                const int tr = 16 * mb + (lane & 15);
#pragma unroll
                for (int ks = 0; ks < 4; ++ks) { const bf16x8 xf = *(const LAS bf16x8*)(wl + tr * 512 + (((4 * ks + (lane >> 4)) ^ (tr & 15)) << 4));
                    acc = __builtin_amdgcn_mfma_f32_16x16x32_bf16(xf, q.cf[ks], acc, 0, 0, 0); }
#pragma unroll
                for (int i2 = 0; i2 < 4; ++i2) { const int t = 32 * sub + 16 * mb + 4 * (lane >> 4) + i2;
                    const float uv = bf2f(sub == 0 ? q.uq[4 * mb + i2] : q.uq[8 + 4 * mb + i2]);
                    const float yv = acc[i2] + q.dsk * uv;
                    Y[((size_t)b * LP + 64 * c + t) * 512 + 16 * g + (lane & 15)] = (bf16_t)f2bf(gelu_tanh_f(yv)); }
            }
            asm volatile("s_waitcnt lgkmcnt(0)" ::: "memory");
        }
    }
    if (!FINAL) E[((size_t)(b * 132 + c) * 32 + g) * 64 + lane] = make_float2(xr, xi);
}
template <bool FINAL>
__device__ __forceinline__ void s5_run(const Params& p, LAS unsigned char* wl, int first, int stride, int nitems, int lane) {
    S5Ops cur, nxt;
    if (first < nitems) s5_load<FINAL>(p, first, lane, cur);
    for (int it = first; it < nitems; it += stride) {
        if (it + stride < nitems) s5_load<FINAL>(p, it + stride, lane, nxt);
        s5_compute<FINAL>(p, wl, it, lane, cur);
        cur = nxt;
    }
}
__device__ __forceinline__ unsigned long long rt() { return __builtin_amdgcn_s_memrealtime(); }
#define XB_TMO      128
#define XB_XCNT(j)  (256  + 64 * (j))
#define XB_XSUB(j)  (1280 + 64 * (j))
#define XB_XGEN(j)  (2304 + 64 * (j))
#define XB_TOP      3328
#define XB_TOPGEN   3392
#define XCD_BAR_WORDS 3456
#define XB_SPIN_CAP (1u << 18)

__device__ __forceinline__ unsigned xb_ld(unsigned* p)              { return __hip_atomic_load(p, __ATOMIC_RELAXED, __HIP_MEMORY_SCOPE_AGENT); }
__device__ __forceinline__ unsigned xb_add(unsigned* p, unsigned v) { return __hip_atomic_fetch_add(p, v, __ATOMIC_RELAXED, __HIP_MEMORY_SCOPE_AGENT); }
__device__ __forceinline__ unsigned xb_xcc_id() { return (unsigned)__builtin_amdgcn_s_getreg((3 << 11) | 20) & 0xFu; }
#define XB_SPIN(cond, bar) do { unsigned _sp = 0; while (cond) { __builtin_amdgcn_s_sleep(1); \
    if ((++_sp & 255u) == 0u) { if (xb_ld(&(bar)[XB_TMO])) break; if (_sp > XB_SPIN_CAP) { atomicAdd(&(bar)[XB_TMO], 1u); break; } } } } while (0)

struct XcdBarrier {
    unsigned* bar; unsigned x;
    volatile LAS unsigned* st;
};

__device__ __forceinline__ XcdBarrier xcd_barrier_post(unsigned* bar, volatile LAS unsigned* st) {
    XcdBarrier b; b.bar = bar; b.x = xb_xcc_id(); b.st = st;
    if (threadIdx.x == 0) (void)xb_add(&bar[XB_XCNT(b.x)], 1u);
    return b;
}
__device__ __forceinline__ void xcd_barrier_complete(unsigned* bar, unsigned x, unsigned& nloc, unsigned& nx) {
    const unsigned G = gridDim.x * gridDim.y * gridDim.z;
    unsigned sum, cnt, mine, sp = 0u;
    for (;;) {
        sum = 0u; cnt = 0u; mine = 0u;
#pragma unroll
        for (unsigned j = 0; j < 16; ++j) { const unsigned c = xb_ld(&bar[XB_XCNT(j)]); sum += c; cnt += (c > 0u) ? 1u : 0u; mine = (j == x) ? c : mine; }
        if (sum == G) break;
        __builtin_amdgcn_s_sleep(1);
        if ((++sp & 255u) == 0u) { if (xb_ld(&bar[XB_TMO])) break; if (sp > XB_SPIN_CAP) { atomicAdd(&bar[XB_TMO], 1u); break; } }
    }
    nloc = mine > 0u ? mine : 1u; nx = cnt > 0u ? cnt : 1u;
}

__device__ __forceinline__ void xcd_barrier(const XcdBarrier& b) {
    asm volatile("s_waitcnt vmcnt(0)" ::: "memory");
    __syncthreads();
    if (threadIdx.x == 0) {
        unsigned* bar = b.bar;
        __builtin_amdgcn_s_waitcnt(0);
        unsigned nloc = b.st[0], nx = b.st[1];
        if (nloc == 0u) { xcd_barrier_complete(bar, b.x, nloc, nx); b.st[0] = nloc; b.st[1] = nx; }
        const unsigned old = xb_add(&bar[XB_XSUB(b.x)], 1u);
        const unsigned gen = old / nloc;
        if (old + 1u == (gen + 1u) * nloc) {
            __builtin_amdgcn_fence(__ATOMIC_RELEASE, "agent");
            asm volatile("s_waitcnt vmcnt(0)" ::: "memory");
            const unsigned og = xb_add(&bar[XB_TOP], 1u);
            const unsigned tg = og / nx;
            if (og + 1u == (tg + 1u) * nx) xb_add(&bar[XB_TOPGEN], 1u);
            else XB_SPIN(xb_ld(&bar[XB_TOPGEN]) == tg, bar);
            __builtin_amdgcn_fence(__ATOMIC_ACQUIRE, "agent");
            asm volatile("s_waitcnt vmcnt(0)" ::: "memory");
        } else {
            XB_SPIN(xb_ld(&bar[XB_TOPGEN]) == gen, bar);
            __builtin_amdgcn_fence(__ATOMIC_ACQUIRE, "agent");
            asm volatile("s_waitcnt vmcnt(0)" ::: "memory");
        }
    }
    __syncthreads();
}

__device__ __forceinline__ f32x4 meta_mm(const bf16_t* X, int ldx, const bf16_t* Wt, int K, int n0, int lane, int kb, int ke) {
    const bf16_t* ap = X + (size_t)(PADR + (lane & 15)) * ldx + 8 * (lane >> 4);
    const bf16_t* bp = Wt + (size_t)(n0 + (lane & 15)) * K + 8 * (lane >> 4);
    f32x4 acc = {0.f, 0.f, 0.f, 0.f};
#pragma unroll 4
    for (int k = kb; k < ke; k += 32) { const bf16x8 a = *(const bf16x8*)(ap + k), b = *(const bf16x8*)(bp + k); acc = __builtin_amdgcn_mfma_f32_16x16x32_bf16(a, b, acc, 0, 0, 0); }
    return acc;
}
template <int KIND>
__device__ __forceinline__ void meta_task(LAS unsigned char* lds, int wave, const bf16_t* X, int ldx, const bf16_t* Wt, int K, int n0, int lane, bf16_t* O, int ldc, const ssq_t* ssq_in, float* H, bf16_t* HB, ssq_t* ssq_out) {
    const int ks = K >> 3;
    f32x4 acc = meta_mm(X, ldx, Wt, K, n0, lane, wave * ks, (wave + 1) * ks);
    LAS f32x4* red = (LAS f32x4*)lds;
    red[wave * 64 + lane] = acc;
    __syncthreads();
    if (wave != 0) { __syncthreads(); return; }
#pragma unroll
    for (int w2 = 1; w2 < 8; ++w2) acc += red[w2 * 64 + lane];
    const int c = n0 + (lane & 15);
#pragma unroll
    for (int i = 0; i < 4; ++i) {
        const int r = PADR + 4 * (lane >> 4) + i;
        if (KIND == 0) {
            const float rs = ssq_rs(ssq_in + r);
            const bf16_t v = (bf16_t)f2bf(acc[i] * rs);
#pragma unroll
            for (int b = 0; b < NBATCH; ++b) O[(size_t)(b * LP + r) * ldc + c] = v;
        } else if (KIND == 1) {
            const float hv = bf2f((unsigned short)f2bf(bf2f(HB[(size_t)r * DM + c]) + acc[i]));
            float ss = hv * hv; ss += __shfl_xor(ss, 1); ss += __shfl_xor(ss, 2); ss += __shfl_xor(ss, 4); ss += __shfl_xor(ss, 8);
#pragma unroll
            for (int b = 0; b < NBATCH; ++b) { HB[(size_t)(b * LP + r) * DM + c] = (bf16_t)f2bf(hv); if ((lane & 15) == 0 && ssq_out) atomicAdd(ssq_out + b * LP + r, ssq_fix(ss)); }
        } else {
            const float rs = ssq_rs(ssq_in + r);
            const float v = acc[i] * rs, up = __shfl_xor(v, 4);
            if ((c & 4) == 0) O[(size_t)r * DFF + ((c >> 3) << 2) + (c & 3)] = (bf16_t)f2bf(v / (1.0f + __expf(-v)) * up);
        }
    }
    __syncthreads();
}
__device__ __forceinline__ void zero_pad_rows(bf16_t* B, int pitch, int gw, int NGW, int lane) {
    for (int r = gw; r < NBATCH * PADR; r += NGW) { u32x4* rp = (u32x4*)(B + (size_t)((r / PADR) * LP + (r % PADR)) * pitch);
        for (int j = lane; j < pitch / 8; j += 64) rp[j] = (u32x4){0u, 0u, 0u, 0u}; }
}
#ifndef REP3
#define REP3 1
#endif
#ifndef REP5
#define REP5 1
#endif
#ifndef REP10
#define REP10 1
#endif
#ifndef REP12
#define REP12 1
#endif
#ifndef REP0
#define REP0 1
#endif
#ifndef REP1
#define REP1 1
#endif
#ifndef REP2
#define REP2 1
#endif
#ifndef REP4
#define REP4 1
#endif
#ifndef REP6
#define REP6 1
#endif
#ifndef REP7
#define REP7 1
#endif
#ifndef REP8
#define REP8 1
#endif
#ifndef REP9
#define REP9 1
#endif
#ifndef REP11
#define REP11 1
#endif
__global__ void __launch_bounds__(NTHR, 2) mega_fwd(Params p) {
    extern __shared__ __attribute__((aligned(16))) unsigned char lds_raw[];
    LAS unsigned char* lds = (LAS unsigned char*)lds_raw;
    cg::grid_group grid = cg::this_grid();
    const int tid = threadIdx.x, lane = tid & 63, wave = __builtin_amdgcn_readfirstlane(tid >> 6);
    const int G = gridDim.x, gw = blockIdx.x * NW + wave, NGW = G * NW;
    unsigned char* ws = p.ws;
    unsigned* ctl = (unsigned*)(ws + WS_CTL);
    ssq_t* ssq = (ssq_t*)(ws + WS_SSQ);
    float* Fb = (float*)(ws + WS_F);
    float* H = (float*)(ws + WS_H);
    bf16_t* HB = (bf16_t*)(ws + WS_HB);
    bf16_t* QKV = (bf16_t*)(ws + WS_QKV);
    bf16_t* CAT = (bf16_t*)((unsigned char*)p.out + DO_CAT);
    float* STASH = (float*)((unsigned char*)p.out + DO_STASH);
    const int lo = p.ph_lo, hi_ph = p.ph_hi;
    volatile LAS unsigned* xst = (volatile LAS unsigned*)(lds + 131072 + 64);
    if (tid < 2) xst[tid] = 0u;
    __syncthreads();
    XcdBarrier xbar = xcd_barrier_post((unsigned*)(ws + WS_CTL + 16384), xst);
#ifndef PHMASK
#define PHMASK 0x3fff
#endif
#define IN(k) (((PHMASK >> (k)) & 1) && lo <= (k) && (k) < hi_ph)
#define SEAM(k) do { if (IN(k) && IN((k) + 1)) xcd_barrier(xbar); } while (0)
    if (p.ph_lo < 0) grid.sync();

    for (int rep = 0; rep < (IN(0) ? REP0 : 0); ++rep) {
        for (int i = blockIdx.x * NTHR + tid; i < 3 * MROWS; i += G * NTHR) ssq[MROWS + i] = 0ull;
        for (int row = gw; row < MROWS; row += NGW) {
            const int b = row / LP, pos = row % LP;
            f32x4 v[4]; float s = 0.f;
            if (pos < PADR) {
#pragma unroll
                for (int j = 0; j < 4; ++j) v[j] = (f32x4){0.f, 0.f, 0.f, 0.f};
            } else {
                const float* src = (pos < 256) ? (p.in[1] + (size_t)(pos - PADR) * DM) : (p.in[0] + ((size_t)b * SEQ + (pos - 256)) * DM);
#pragma unroll
                for (int j = 0; j < 4; ++j) { v[j] = ((const f32x4*)src)[lane + 64 * j]; s += (v[j][0] * v[j][0] + v[j][1] * v[j][1]) + (v[j][2] * v[j][2] + v[j][3] * v[j][3]); }
            }
            s = wave_sum(s);
#pragma unroll
            for (int j = 0; j < 4; ++j) {
                u32x2 w; w.x = pk2(v[j][0], v[j][1]); w.y = pk2(v[j][2], v[j][3]); ((u32x2*)(HB + (size_t)row * DM))[lane + 64 * j] = w; }
            if (lane == 0) ssq[row] = ssq_fix(s);
        }
        {
            LAS float* scr = (LAS float*)(lds + wave * 16384);
            const float* nmg = p.in[2]; const float* nfg = p.in[3];
            constexpr int I0 = 16 * 96, I1 = 16 * 32, I2 = 16 * 176, I3 = 44 * 32, I4 = 16 * 65, I5 = 8 * 16, I6 = 16 * 32, I7 = 16 * 176, I8 = 44 * 32;
            constexpr int NIT = I0 + I1 + I2 + I3 + I4 + I5 + I6 + I7 + I8;
            for (int it = gw; it < NIT; it += NGW) {
                int r = it;
                if (r < I0) { transpose_item(p.in[5], 1024, 3072, nmg, (bf16_t*)(ws + WS_W0IN), 1, scr, r, lane); continue; } r -= I0;
                if (r < I1) { transpose_item(p.in[6], 1024, 1024, nullptr, (bf16_t*)(ws + WS_W0OUT), 0, scr, r, lane); continue; } r -= I1;
                if (r < I2) { transpose_item(p.in[25], 1024, 5632, nfg, (bf16_t*)(ws + WS_WGU0), 3, scr, r, lane); continue; } r -= I2;
                if (r < I3) { transpose_item(p.in[26], 2816, 1024, nullptr, (bf16_t*)(ws + WS_WDN0), 0, scr, r, lane); continue; } r -= I3;
                if (r < I4) { transpose_item(p.in[12], 1024, 2056, nmg + 1024, (bf16_t*)(ws + WS_W1IN), 2, scr, r, lane); continue; } r -= I4;
                if (r < I5) { transpose_item(p.in[23], 512, 512, nullptr, (bf16_t*)(ws + WS_WGLU), 0, scr, r, lane); continue; } r -= I5;
                if (r < I6) { transpose_item(p.in[13], 1024, 1024, nullptr, (bf16_t*)(ws + WS_W1OUT), 0, scr, r, lane); continue; } r -= I6;
                if (r < I7) { transpose_item(p.in[25] + (size_t)1024 * 5632, 1024, 5632, nfg + 1024, (bf16_t*)(ws + WS_WGU1), 3, scr, r, lane); continue; } r -= I7;
                transpose_item(p.in[26] + (size_t)2816 * 1024, 2816, 1024, nullptr, (bf16_t*)(ws + WS_WDN1), 0, scr, r, lane);
            }
        }
        for (int idx = blockIdx.x * NTHR + tid; idx < 2048 * 16; idx += G * NTHR) {
            const int i = idx >> 4, h = idx & 15, g = i >> 6;
            const float lre = p.in[15][i], lim = p.in[16][i], dt = expf(p.in[17][g]);
            const float mag = expf(lre * dt), are = mag * cosf(lim * dt), aim = mag * sinf(lim * dt), den = lre * lre + lim * lim;
            const float gre = ((are - 1.0f) * lre + aim * lim) / den, gim = (aim * lre - (are - 1.0f) * lim) / den;
            if (h == 0) { float* ap = (float*)(ws + WS_S5A); ap[i] = are; ap[2048 + i] = aim; }
            float* bbr = (float*)(ws + WS_S5BB); float* bbi = bbr + 2048 * 16;
            bf16_t* bt = (bf16_t*)(ws + WS_S5BT) + ((size_t)g * 128 + (i & 63)) * 16;
            const float br = p.in[18][i * 16 + h], bi = p.in[19][i * 16 + h]; const float vr = gre * br - gim * bi, vi = gre * bi + gim * br;
            bbr[i * 16 + h] = vr; bbi[i * 16 + h] = vi; bt[h] = (bf16_t)f2bf(vr); bt[64 * 16 + h] = (bf16_t)f2bf(vi);
        }
        for (int i = blockIdx.x * NTHR + tid; i < 32 * 16 * 128; i += G * NTHR) {
            const int pp = i & 127, gh = i >> 7;
            const float v = (pp < 64) ? p.in[20][gh * 64 + pp] : -p.in[21][gh * 64 + (pp - 64)];
            ((bf16_t*)(ws + WS_S5CT))[i] = (bf16_t)f2bf(v);
        }
        for (int i = blockIdx.x * NTHR + tid; i < 8 * 1024; i += G * NTHR) {
            const int j = i >> 10, k = i & 1023;
            ((float*)(ws + WS_W1F))[i] = p.in[12][(size_t)k * 2056 + 1536 + j] * p.in[2][1024 + k];
        }
    }
    SEAM(0);

    for (int rep = 0; rep < (IN(1) ? REP1 : 0); ++rep) {
        pg8::Gemm g{HB, (const bf16_t*)(ws + WS_W0IN), MROWS, 3072, 1024}; pg8::StaticOrder S; S.init(NBATCH * SEQ, 3072, G, (int)blockIdx.x);
        pg8::EpiScaleBf16 E{QKV, 3072, ssq};
        pg8::gemm_phase<pg8::EpiScaleBf16, pg8::StaticOrder, true, true>(lds, g, S, E);
        if (rep == 0) { zero_pad_rows(QKV, 3072, gw, NGW, lane);
            for (int t = blockIdx.x; t < 3072 / 16; t += G) meta_task<0>(lds, wave, HB, DM, (const bf16_t*)(ws + WS_W0IN), 1024, 16 * t, lane, QKV, 3072, ssq, nullptr, nullptr, nullptr); }
    }
    SEAM(1);

    for (int rep = 0; rep < (IN(2) ? REP2 : 0); ++rep) {
        float lam;
        { const float a1 = wave_sum(p.in[7][lane] * p.in[8][lane]), a2 = wave_sum(p.in[9][lane] * p.in[10][lane]); lam = expf(a1) - expf(a2) + 0.2f; }
        constexpr int NDIFF = 16 * 33, NSB = 32 * 33;
        LAS int* misc = (LAS int*)(lds + att::L_MISC);
        for (;;) {
            if (tid == 0) misc[0] = (int)atomicAdd(ctl + rep, 1u);
            __syncthreads();
            int idx = misc[0];
            __syncthreads();
#ifdef REP2_DIFF_ONLY
            if (rep > 0 && idx >= NDIFF) break;
#endif
#ifdef REP2_SB_ONLY
            if (rep > 0) idx += NDIFF;
#endif
            if (idx >= NDIFF + NSB) break;
            if (idx < NDIFF) {
#ifndef NO_DIFF
                const int u = 32 - idx / 16, bh = idx % 16, b = bh >> 2, hd = bh & 3;
                const int r32 = lane & 31, hi = lane >> 5;
                f32x4* st = (f32x4*)(STASH + ((size_t)blockIdx.x * NTHR + tid) * 64);
#pragma unroll 1
                for (int comp = 0; comp < 2; ++comp) {
                    att::Args a{QKV, 3072, b * LP, u, 1536 + hd * 128 + comp * 64, 2048 + hd * 128 + comp * 64, 2560 + hd * 128, nullptr, 0.f};
                    f32x16 o[4]; float l;
                    att::run<1, 4, false>(lds, a, o, l);
                    const float inv = (l > 0.f) ? 1.0f / l : 0.f;
                    if (comp == 0) {
#pragma unroll
                        for (int c = 0; c < 4; ++c)
#pragma unroll
                            for (int g4 = 0; g4 < 4; ++g4) st[c * 4 + g4] = (f32x4){o[c][4 * g4] * inv, o[c][4 * g4 + 1] * inv, o[c][4 * g4 + 2] * inv, o[c][4 * g4 + 3] * inv};
                    } else {
                        float ss = 0.f;
#pragma unroll
                        for (int c = 0; c < 4; ++c)
#pragma unroll
                            for (int g4 = 0; g4 < 4; ++g4) { const f32x4 sv = st[c * 4 + g4];
#pragma unroll
                                for (int e = 0; e < 4; ++e) { const float v = sv[e] - lam * (o[c][4 * g4 + e] * inv); o[c][4 * g4 + e] = v; ss += v * v; } }
                        ss += __shfl_xor(ss, 32);
                        const float rs = 0.8f * rsqrtf(ss * (1.0f / 128.0f) + RMS_EPS);
                        const float* sg = p.in[11];
                        bf16_t* op = CAT + (size_t)(b * LP + 256 * u + 32 * wave + r32) * DM + 512 + hd * 128;
#pragma unroll
                        for (int c = 0; c < 4; ++c)
#pragma unroll
                            for (int g4 = 0; g4 < 4; ++g4) { const int dv = 32 * c + 8 * g4 + 4 * hi; const f32x4 gv = *(const f32x4*)(sg + dv);
                                u32x2 w; w.x = pk2(o[c][4 * g4] * rs * gv[0], o[c][4 * g4 + 1] * rs * gv[1]); w.y = pk2(o[c][4 * g4 + 2] * rs * gv[2], o[c][4 * g4 + 3] * rs * gv[3]);
                                *(u32x2*)(op + dv) = w; }
                    }
                }
#endif
            } else {
#ifndef NO_SB
                const int i2 = idx - NDIFF, u = 32 - i2 / 32, bh = i2 % 32, b = bh >> 3, h = bh & 7;
                const int r32 = lane & 31, hi = lane >> 5;
                att::Args a{QKV, 3072, b * LP, u, h * 64, 512 + h * 64, 1024 + h * 64, nullptr, 0.f};
                f32x16 o[2]; float l;
                att::run<0, 2, false>(lds, a, o, l);
                bf16_t* op = CAT + (size_t)(b * LP + 256 * u + 32 * wave + r32) * DM + h * 64;
#pragma unroll
                for (int c = 0; c < 2; ++c)
#pragma unroll
                    for (int g4 = 0; g4 < 4; ++g4) { const int dv = 32 * c + 8 * g4 + 4 * hi;
                        u32x2 w; w.x = pk2(o[c][4 * g4], o[c][4 * g4 + 1]); w.y = pk2(o[c][4 * g4 + 2], o[c][4 * g4 + 3]); *(u32x2*)(op + dv) = w; }
#endif
            }
        }
    }
    SEAM(2);

    if (IN(3)) {
        pg8::Gemm g{CAT, (const bf16_t*)(ws + WS_W0OUT), MROWS, 1024, 1024}; pg8::StaticOrder S; S.init(NBATCH * SEQ, 1024, G, (int)blockIdx.x);
        pg8::EpiResid<false> E{nullptr, HB, ssq + MROWS};
        pg8::gemm_phase<pg8::EpiResid<false>, pg8::StaticOrder, true, true>(lds, g, S, E);
        for (int t = blockIdx.x; t < 1024 / 16; t += G) meta_task<1>(lds, wave, CAT, DM, (const bf16_t*)(ws + WS_W0OUT), 1024, 16 * t, lane, nullptr, 0, nullptr, H, HB, ssq + MROWS);
    }
    SEAM(3);
    for (int rep = 0; rep < (IN(4) ? REP4 : 0); ++rep) {
        pg8::Gemm g{HB, (const bf16_t*)(ws + WS_WGU0), MROWS, 5632, 1024}; pg8::StaticOrder S; S.init(NBATCH * SEQ, 5632, G, (int)blockIdx.x);
        pg8::EpiSwiGLU E{QKV, ssq + MROWS};
        pg8::gemm_phase<pg8::EpiSwiGLU, pg8::StaticOrder, true, true>(lds, g, S, E);
        if (rep == 0) for (int t = blockIdx.x; t < 5632 / 16; t += G) meta_task<2>(lds, wave, HB, DM, (const bf16_t*)(ws + WS_WGU0), 1024, 16 * t, lane, QKV, 0, ssq + MROWS, nullptr, nullptr, nullptr);
    }
    SEAM(4);
    if (IN(5)) {
        pg8::Gemm g{QKV, (const bf16_t*)(ws + WS_WDN0), MROWS, 1024, 2816}; pg8::StaticOrder S; S.init(NBATCH * SEQ, 1024, G, (int)blockIdx.x);
        pg8::EpiResid<false> E{nullptr, HB, ssq + 2 * MROWS};
        pg8::gemm_phase<pg8::EpiResid<false>, pg8::StaticOrder, true, true>(lds, g, S, E);
        for (int t = blockIdx.x; t < 1024 / 16; t += G) meta_task<1>(lds, wave, QKV, DFF, (const bf16_t*)(ws + WS_WDN0), DFF, 16 * t, lane, nullptr, 0, nullptr, H, HB, ssq + 2 * MROWS);
    }
    SEAM(5);
    for (int rep = 0; rep < (IN(6) ? REP6 : 0); ++rep) {
        {
            pg8::Gemm g{HB, (const bf16_t*)(ws + WS_W1IN), MROWS, 2048, 1024}; pg8::StaticOrder S; S.init(NBATCH * SEQ, 2048, G, (int)blockIdx.x);
            pg8::EpiScaleBf16 E{QKV, 2048, ssq + 2 * MROWS};
            pg8::gemm_phase<pg8::EpiScaleBf16, pg8::StaticOrder, true, true>(lds, g, S, E);
        }
        if (rep == 0) { zero_pad_rows(QKV, 2048, gw, NGW, lane);
            for (int t = blockIdx.x; t < 2048 / 16; t += G) meta_task<0>(lds, wave, HB, DM, (const bf16_t*)(ws + WS_W1IN), 1024, 16 * t, lane, QKV, 2048, ssq + 2 * MROWS, nullptr, nullptr, nullptr); }
        const float* w1f = (const float*)(ws + WS_W1F);
        {
            u32x2 hw[4], hn[4];
            if (gw < MROWS) {
#pragma unroll
                for (int j = 0; j < 4; ++j) hw[j] = ((const u32x2*)(HB + (size_t)gw * DM))[lane + 64 * j];
            }
            for (int row = gw; row < MROWS; row += NGW) {
                const int b = row / LP, pos = row % LP;
                if (row + NGW < MROWS) {
#pragma unroll
                    for (int j = 0; j < 4; ++j) hn[j] = ((const u32x2*)(HB + (size_t)(row + NGW) * DM))[lane + 64 * j];
                }
                f32x4 v[4];
#pragma unroll
                for (int j = 0; j < 4; ++j) v[j] = (f32x4){bflo(hw[j].x), bfhi(hw[j].x), bflo(hw[j].y), bfhi(hw[j].y)};
                const float rs = ssq_rs(ssq + 2 * MROWS + row);
                float mine = 0.f;
#pragma unroll
                for (int hh = 0; hh < 8; ++hh) {
                    float d = 0.f;
#pragma unroll
                    for (int j = 0; j < 4; ++j) { const f32x4 wv = ((const f32x4*)(w1f + hh * 1024))[lane + 64 * j]; d += (v[j][0] * wv[0] + v[j][1] * wv[1]) + (v[j][2] * wv[2] + v[j][3] * wv[3]); }
                    d = wave_sum(d);
                    if (lane == hh) mine = d;
                }
                if (lane < 8) Fb[((size_t)b * 8 + lane) * LP + pos] = log_sigmoid_f(mine * rs + p.in[14][lane]);
#pragma unroll
                for (int j = 0; j < 4; ++j) hw[j] = hn[j];
            }
        }
    }
    SEAM(6);
    for (int rep = 0; rep < (IN(7) ? REP7 : 0); ++rep) {
        LAS float* sc = (LAS float*)lds;
        for (int chain = blockIdx.x; chain < (rep == 0 ? 32 : 0); chain += G) {
            float* Fc = Fb + (size_t)chain * LP;
            { float km = 0.f; const int cb = chain >> 3, ch = chain & 7;
              for (int j = 0; j < 17; ++j) { const int idx = tid * 17 + j; if (idx < LP) { const u32x4* kp = (const u32x4*)(QKV + ((size_t)cb * LP + idx) * 2048 + 512 + ch * 64); float s2 = 0.f;
#pragma unroll
                  for (int q4 = 0; q4 < 8; ++q4) { const u32x4 kv = kp[q4]; const float e0 = bflo(kv.x), e1 = bfhi(kv.x), e2 = bflo(kv.y), e3 = bfhi(kv.y), e4 = bflo(kv.z), e5 = bfhi(kv.z), e6 = bflo(kv.w), e7 = bfhi(kv.w);
                      s2 += (e0 * e0 + e1 * e1) + (e2 * e2 + e3 * e3) + (e4 * e4 + e5 * e5) + (e6 * e6 + e7 * e7); }
                  km = fmaxf(km, s2); } }
#pragma unroll
              for (int o2 = 32; o2 >= 1; o2 >>= 1) km = fmaxf(km, __shfl_xor(km, o2));
              if (lane == 0) sc[512 + wave] = km;
              __syncthreads();
              if (tid == 0) { float m8 = sc[512]; for (int w8 = 1; w8 < 8; ++w8) m8 = fmaxf(m8, sc[512 + w8]); ((float*)(ws + WS_CTL + 4096))[chain] = m8; }
              __syncthreads(); }
            float loc[17]; float run = 0.f;
#pragma unroll
            for (int j = 0; j < 17; ++j) { const int idx = tid * 17 + j; const float v = (idx < LP) ? Fc[idx] : 0.f; run += v; loc[j] = run; }
            sc[tid] = run;
            __syncthreads();
            for (int off = 1; off < NTHR; off <<= 1) { const float v = sc[tid] + ((tid >= off) ? sc[tid - off] : 0.f); __syncthreads(); sc[tid] = v; __syncthreads(); }
            const float base = sc[tid] - run;
#pragma unroll
            for (int j = 0; j < 17; ++j) { const int idx = tid * 17 + j; if (idx < LP) Fc[idx] = base + loc[j]; }
            __syncthreads();
        }
        __syncthreads();
        if (G > 64) { if (blockIdx.x >= 32) s5_run<false>(p, lds + wave * 16384, (blockIdx.x - 32) * NW + wave, (G - 32) * NW, 4 * 132 * 32, lane); }
        else s5_run<false>(p, lds + wave * 16384, gw, NGW, 4 * 132 * 32, lane);
    }
    SEAM(7);
    for (int rep = 0; rep < (IN(8) ? REP8 : 0); ++rep) {
        s5_run<true>(p, lds + wave * 16384, gw, NGW, 4 * 132 * 32, lane);
        __syncthreads();
        constexpr int NFOX = 32 * 33;
        LAS int* misc = (LAS int*)(lds + att::L_MISC);
        for (;;) {
            if (tid == 0) misc[0] = (int)atomicAdd(ctl + 64 + rep, 1u);
            __syncthreads();
            const int idx = misc[0];
            __syncthreads();
            if (idx >= NFOX) break;
            const int u = 32 - idx / 32, bh = idx % 32, b = bh >> 3, h = bh & 7;
            const int r32 = lane & 31, hi = lane >> 5;
            att::Args a{QKV, 2048, b * LP, u, h * 64, 512 + h * 64, 1024 + h * 64, Fb + (size_t)bh * LP, sqrtf(((const float*)(ws + WS_CTL + 4096))[bh])};
            f32x16 o[2]; float l;
            att::run<1, 2, true>(lds, a, o, l);
            const float inv = 1.0f / l;
            bf16_t* op = CAT + (size_t)(b * LP + 256 * u + 32 * wave + r32) * DM + h * 64;
#pragma unroll
            for (int c = 0; c < 2; ++c)
#pragma unroll
                for (int g4 = 0; g4 < 4; ++g4) { const int dv = 32 * c + 8 * g4 + 4 * hi;
                    u32x2 w; w.x = pk2(o[c][4 * g4] * inv, o[c][4 * g4 + 1] * inv); w.y = pk2(o[c][4 * g4 + 2] * inv, o[c][4 * g4 + 3] * inv); *(u32x2*)(op + dv) = w; }
        }
    }
    SEAM(8);
    for (int rep = 0; rep < (IN(9) ? REP9 : 0); ++rep) {
        pg8::Gemm g{(const bf16_t*)(ws + WS_Y), (const bf16_t*)(ws + WS_WGLU), MROWS, 512, 512}; pg8::StaticOrder S; S.init(NBATCH * SEQ, 512, G, (int)blockIdx.x);
        pg8::EpiGLU E{(const bf16_t*)(ws + WS_Y), p.in[24], CAT};
        pg8::gemm_phase<pg8::EpiGLU, pg8::StaticOrder, true, true>(lds, g, S, E);
    }
    SEAM(9);
    if (IN(10)) {
        pg8::Gemm g{CAT, (const bf16_t*)(ws + WS_W1OUT), MROWS, 1024, 1024}; pg8::StaticOrder S; S.init(NBATCH * SEQ, 1024, G, (int)blockIdx.x);
        pg8::EpiResid<false> E{nullptr, HB, ssq + 3 * MROWS};
        pg8::gemm_phase<pg8::EpiResid<false>, pg8::StaticOrder, true, true>(lds, g, S, E);
    }
    SEAM(10);
    for (int rep = 0; rep < (IN(11) ? REP11 : 0); ++rep) {
        pg8::Gemm g{HB, (const bf16_t*)(ws + WS_WGU1), MROWS, 5632, 1024}; pg8::StaticOrder S; S.init(NBATCH * SEQ, 5632, G, (int)blockIdx.x);
        pg8::EpiSwiGLU E{QKV, ssq + 3 * MROWS};
        pg8::gemm_phase<pg8::EpiSwiGLU, pg8::StaticOrder, true, true>(lds, g, S, E);
    }
    SEAM(11);
    if (IN(12)) {
        pg8::Gemm g{QKV, (const bf16_t*)(ws + WS_WDN1), MROWS, 1024, 2816}; pg8::StaticOrder S; S.init(NBATCH * SEQ, 1024, G, (int)blockIdx.x);
        pg8::EpiResid<true> E{H, HB, nullptr};
        pg8::gemm_phase<pg8::EpiResid<true>, pg8::StaticOrder, true, true>(lds, g, S, E);
    }
    SEAM(12);
#ifdef EXTRA_SYNCS
    for (int k = 0; k < EXTRA_SYNCS; ++k) xcd_barrier(xbar);
#endif
    if (IN(13)) {
        const float* fg = p.in[4];
        {
            f32x4 v[4], vn[4];
            if (gw < NBATCH * SEQ) { const size_t row0 = (size_t)(gw / SEQ) * LP + 256 + (gw % SEQ);
#pragma unroll
                for (int j = 0; j < 4; ++j) v[j] = ((const f32x4*)(H + row0 * DM))[lane + 64 * j]; }
            for (int r = gw; r < NBATCH * SEQ; r += NGW) {
                const int rn = r + NGW;
                if (rn < NBATCH * SEQ) { const size_t rown = (size_t)(rn / SEQ) * LP + 256 + (rn % SEQ);
#pragma unroll
                    for (int j = 0; j < 4; ++j) vn[j] = ((const f32x4*)(H + rown * DM))[lane + 64 * j]; }
                float s = 0.f;
#pragma unroll
                for (int j = 0; j < 4; ++j) s += (v[j][0] * v[j][0] + v[j][1] * v[j][1]) + (v[j][2] * v[j][2] + v[j][3] * v[j][3]);
                const float rs = rsqrtf(wave_sum(s) * (1.0f / 1024.0f) + RMS_EPS);
#pragma unroll
                for (int j = 0; j < 4; ++j) { const f32x4 gv = ((const f32x4*)fg)[lane + 64 * j]; ((f32x4*)(p.out + (size_t)r * DM))[lane + 64 * j] = v[j] * rs * gv; }
#pragma unroll
                for (int j = 0; j < 4; ++j) v[j] = vn[j];
            }
        }
    }
#undef IN
#undef SEAM
}

#ifndef N_LAUNCH_MODE
#define N_LAUNCH_MODE 1
#endif
extern "C" void kernel_launch(void* const* d_in, const int* in_sizes, int n_in, void* d_out, int out_size, void* d_ws, size_t ws_size, hipStream_t stream) {
    static int grid = 0;
    if (grid == 0) {
        if (n_in != 27 || ws_size < WS_END || out_size != NBATCH * SEQ * DM) { fprintf(stderr, "kernel_launch: unexpected shapes (n_in %d, ws %zu, out %d)\n", n_in, ws_size, out_size); grid = -1; return; }
        int dev = 0, cus = 0, per_cu = 0;
        (void)hipGetDevice(&dev); (void)hipDeviceGetAttribute(&cus, hipDeviceAttributeMultiprocessorCount, dev);
        if (hipFuncSetAttribute((const void*)mega_fwd, hipFuncAttributeMaxDynamicSharedMemorySize, LDS_BYTES) != hipSuccess) { fprintf(stderr, "kernel_launch: hipFuncSetAttribute failed\n"); grid = -1; return; }
        if (hipOccupancyMaxActiveBlocksPerMultiprocessor(&per_cu, (const void*)mega_fwd, NTHR, LDS_BYTES) != hipSuccess || per_cu < 1) { fprintf(stderr, "kernel_launch: occupancy query says %d\n", per_cu); per_cu = 1; }
        (void)hipGetLastError();
        grid = cus * 1;
        if (grid <= 0) grid = 256;
    }
    if (grid < 0) return;
    if (hipMemsetAsync((char*)d_ws + WS_CTL, 0, 65536, stream) != hipSuccess) { fprintf(stderr, "kernel_launch: memset of the control words failed\n"); return; }
    Params p{};
    for (int i = 0; i < 27; ++i) p.in[i] = (const float*)d_in[i];
    p.out = (float*)d_out; p.ws = (unsigned char*)d_ws;
#if N_LAUNCH_MODE == 1
    p.ph_lo = 0; p.ph_hi = 14;
    void* args[] = {&p};
    hipError_t e = hipLaunchCooperativeKernel((const void*)mega_fwd, dim3(grid), dim3(NTHR), args, LDS_BYTES, stream);
    if (e != hipSuccess) fprintf(stderr, "cooperative launch failed: %s (grid %d)\n", hipGetErrorString(e), grid);
#else
    for (int ph = 0; ph < 14; ++ph) { p.ph_lo = ph; p.ph_hi = ph + 1; hipLaunchKernelGGL(mega_fwd, dim3(grid), dim3(NTHR), LDS_BYTES, stream, p); }
#endif
}
```

```cpp
#include <hip/hip_runtime.h>
#include <hip/hip_cooperative_groups.h>
#include <cstdio>
#include <cstdint>
namespace cg = cooperative_groups;

#define LAS __attribute__((address_space(3)))
constexpr int DM = 1024, NBATCH = 4, SEQ = 8192, LP = 8448, PADR = 240, NMETA = 16, MROWS = NBATCH * LP;
constexpr int DFF = 2816, NW = 8, NTHR = 512;
constexpr float C2 = 0.125f * 1.4426950408889634f;
constexpr float LOG2E = 1.4426950408889634f;
constexpr float RMS_EPS = 1e-6f;
constexpr int LDS_BYTES = 147456;

constexpr size_t MiB = 1u << 20;
constexpr size_t WS_CTL = 0;
constexpr size_t WS_SSQ = 452 * MiB;
constexpr size_t WS_F = 2 * MiB;
constexpr size_t WS_S5A = 4 * MiB;
constexpr size_t WS_S5BB = 4 * MiB + 65536;
constexpr size_t WS_S5CT = 4 * MiB + 65536 + 262144;
constexpr size_t WS_W1F = 4 * MiB + 65536 + 262144 + 131072;
constexpr size_t WS_S5BT = 4 * MiB + 524288;
constexpr size_t WS_W0IN = 6 * MiB, WS_W0OUT = 12 * MiB, WS_WGU0 = 14 * MiB, WS_WDN0 = 25 * MiB, WS_W1IN = 31 * MiB, WS_WGLU = 35 * MiB, WS_W1OUT = 36 * MiB, WS_WGU1 = 38 * MiB, WS_WDN1 = 49 * MiB;
constexpr size_t WS_H = 56 * MiB;
constexpr size_t WS_HB = 188 * MiB;
constexpr size_t WS_QKV = 254 * MiB;
constexpr size_t WS_Y = 386 * MiB;
constexpr size_t WS_E = 419 * MiB;
constexpr size_t WS_END = 454 * MiB;
constexpr size_t DO_CAT = 0, DO_STASH = 66 * MiB;

typedef unsigned short bf16_t;
typedef short bf16x8 __attribute__((ext_vector_type(8)));
typedef float f32x4 __attribute__((ext_vector_type(4)));
typedef float f32x16 __attribute__((ext_vector_type(16)));
typedef unsigned u32x4 __attribute__((ext_vector_type(4)));
typedef unsigned u32x2 __attribute__((ext_vector_type(2)));
typedef short v4i16_t __attribute__((ext_vector_type(4)));

__device__ __forceinline__ unsigned f2bf(float f) { unsigned u = __builtin_bit_cast(unsigned, f); return (u + 0x7fffu + ((u >> 16) & 1u)) >> 16; }
__device__ __forceinline__ unsigned pk2(float lo, float hi) { return f2bf(lo) | (f2bf(hi) << 16); }
__device__ __forceinline__ float bf2f(unsigned short b) { return __builtin_bit_cast(float, (unsigned)b << 16); }
__device__ __forceinline__ float bflo(unsigned w) { return __builtin_bit_cast(float, w << 16); }
__device__ __forceinline__ float bfhi(unsigned w) { return __builtin_bit_cast(float, w & 0xffff0000u); }
__device__ __forceinline__ float wave_sum(float v) {
#pragma unroll
    for (int o = 32; o >= 1; o >>= 1) v += __shfl_xor(v, o);
    return v;
}
typedef unsigned long long ssq_t;
__device__ __forceinline__ ssq_t ssq_fix(float ss) { return (ssq_t)(ss * 16777216.0f + 0.5f); }
__device__ __forceinline__ float ssq_rs(const ssq_t* p) { const ssq_t v = __hip_atomic_load(p, __ATOMIC_RELAXED, __HIP_MEMORY_SCOPE_AGENT); return rsqrtf((float)v * (1.0f / (16777216.0f * 1024.0f)) + RMS_EPS); }
__device__ __forceinline__ float fexp2(float x) { return __builtin_amdgcn_exp2f(x); }
__device__ __forceinline__ float flog2(float x) { return __builtin_amdgcn_logf(x); }
namespace pg8 {
#define PG8_LAS __attribute__((address_space(3)))
typedef unsigned short bf16_t;
typedef short bf16x8 __attribute__((ext_vector_type(8)));
typedef float f32x4 __attribute__((ext_vector_type(4)));
typedef unsigned u32x4 __attribute__((ext_vector_type(4)));
constexpr int BM = 256, BK = 64, HALF = 128, HTB = HALF * BK * 2  , STAGE_BYTES = 8 * HTB, NXCD = 8, WGM = 8;

__host__ __device__ __forceinline__ int lds_byte(int r, int c) { const int st = (r >> 4) * 2 + (c >> 5), rr = r & 15, cc = c & 31, ob = rr * 64 + cc * 2; return st * 1024 + (ob ^ (((ob >> 9) & 1) << 5)); }
__host__ __device__ __forceinline__ void stage_rc(int b, int& R, int& C) { const int st = b / 1024, sb = b % 1024, swz = sb ^ (((sb >> 9) & 1) << 5); R = (st >> 1) * 16 + swz / 64; C = (st & 1) * 32 + (swz % 64) / 2; }
__host__ __device__ __forceinline__ int perm32(int rho) { const int n = rho >> 4, i = rho & 15; return 8 * (i >> 2) + 4 * n + (i & 3); }

struct Unit { int pm, pn; };
struct Gemm { const bf16_t* A; const bf16_t* Bt; int M, N, K; };

struct StaticOrder {
    int nM, nN, nwg, G, c;
    __host__ __device__ void init(int M, int N, int G_, int c_) { nM = M / BM; nN = N / BM; nwg = nM * nN; G = G_; c = c_; }
    __host__ __device__ bool next(int i, Unit& u) const {
        const long L = (long)i * G + c; if (L >= nwg) return false;
        int wgid = (int)L; { const int q = nwg / NXCD, r = nwg % NXCD, xcd = wgid % NXCD, off = wgid / NXCD; wgid = (xcd < r ? xcd * (q + 1) : r * (q + 1) + (xcd - r) * q) + off; }
        const int nig = WGM * nN, gid = wgid / nig, fm = gid * WGM, gsz = (nM - fm) < WGM ? (nM - fm) : WGM;
        u.pm = fm + ((wgid % nig) % gsz); u.pn = (wgid % nig) / gsz;
        u.pm = u.pm + (u.pm >> 5) + 1;
        return true;
    }
    __device__ __forceinline__ void a_ready(const Unit&) const {}
    __device__ __forceinline__ void done(const Unit&) const {}
};
__device__ __forceinline__ unsigned cvt_pk_bf16(float lo, float hi) { unsigned r; asm volatile("v_cvt_pk_bf16_f32 %0, %1, %2" : "=v"(r) : "v"(lo), "v"(hi)); return r; }
typedef float f32x2 __attribute__((ext_vector_type(2)));
struct EpiScaleBf16 {
    static constexpr bool PERM = true, AFTER_DRAIN = false;
    bf16_t* O; int ldc; const ssq_t* ssq;
    __device__ __forceinline__ void pre(const Unit& u, int wr, int fr, unsigned long long (&rsv)[8]) const {
#pragma unroll
        for (int ai = 0; ai < 2; ++ai)
#pragma unroll
            for (int m = 0; m < 4; ++m) rsv[ai * 4 + m] = __hip_atomic_load(ssq + u.pm * BM + ai * HALF + wr * 64 + m * 16 + fr, __ATOMIC_RELAXED, __HIP_MEMORY_SCOPE_AGENT);
    }
    __device__ __forceinline__ void operator()(const f32x4 (&acc)[2][2][4][2], const Unit& u, int wr, int wc, int fr, int fq, const unsigned long long (&rsv)[8]) const {
        const int col0 = u.pn * BM + wc * 32 + 8 * fq;
#pragma unroll
        for (int ai = 0; ai < 2; ++ai)
#pragma unroll
            for (int m = 0; m < 4; ++m) {
                const int row = u.pm * BM + ai * HALF + wr * 64 + m * 16 + fr;
                const float rs = rsqrtf((float)rsv[ai * 4 + m] * (1.0f / (16777216.0f * 1024.0f)) + 1e-6f);
                bf16_t* rowp = O + (size_t)row * ldc + col0;
#pragma unroll
                for (int bj = 0; bj < 2; ++bj) { const f32x4 v0 = acc[ai][bj][m][0] * rs, v1 = acc[ai][bj][m][1] * rs;
                    u32x4 w; w.x = cvt_pk_bf16(v0[0], v0[1]); w.y = cvt_pk_bf16(v0[2], v0[3]); w.z = cvt_pk_bf16(v1[0], v1[1]); w.w = cvt_pk_bf16(v1[2], v1[3]);
                    *(u32x4*)(rowp + bj * HALF) = w; } }
    }
};
template <bool FINAL>
struct EpiResid {
    static constexpr bool PERM = true, AFTER_DRAIN = false;
    float* hf; bf16_t* hb; ssq_t* ssq;
    __device__ __forceinline__ void pre(const Unit&, int, int, unsigned long long (&)[8]) const {}
    __device__ __forceinline__ void operator()(const f32x4 (&acc)[2][2][4][2], const Unit& u, int wr, int wc, int fr, int fq, const unsigned long long (&rsv)[8]) const {
        const int col0 = u.pn * BM + wc * 32 + 8 * fq;
#pragma unroll
        for (int ai = 0; ai < 2; ++ai)
#pragma unroll
            for (int m = 0; m < 4; ++m) {
                const int row = u.pm * BM + ai * HALF + wr * 64 + m * 16 + fr;
                float ss = 0.f;
#pragma unroll
                for (int bj = 0; bj < 2; ++bj) {
                    bf16_t* bp = hb + (size_t)row * 1024 + col0 + bj * HALF;
                    const u32x4 hv = *(const u32x4*)bp;
                    f32x4 v0 = acc[ai][bj][m][0], v1 = acc[ai][bj][m][1];
                    v0[0] += __builtin_bit_cast(float, hv.x << 16); v0[1] += __builtin_bit_cast(float, hv.x & 0xffff0000u); v0[2] += __builtin_bit_cast(float, hv.y << 16); v0[3] += __builtin_bit_cast(float, hv.y & 0xffff0000u);
                    v1[0] += __builtin_bit_cast(float, hv.z << 16); v1[1] += __builtin_bit_cast(float, hv.z & 0xffff0000u); v1[2] += __builtin_bit_cast(float, hv.w << 16); v1[3] += __builtin_bit_cast(float, hv.w & 0xffff0000u);
                    if (FINAL) { float* hp = hf + (size_t)row * 1024 + col0 + bj * HALF; *(f32x4*)hp = v0; *(f32x4*)(hp + 4) = v1; }
                    else {
                        u32x4 w; w.x = cvt_pk_bf16(v0[0], v0[1]); w.y = cvt_pk_bf16(v0[2], v0[3]); w.z = cvt_pk_bf16(v1[0], v1[1]); w.w = cvt_pk_bf16(v1[2], v1[3]);
                        *(u32x4*)bp = w;
                        const float r0 = __builtin_bit_cast(float, w.x << 16), r1 = __builtin_bit_cast(float, w.x & 0xffff0000u), r2 = __builtin_bit_cast(float, w.y << 16), r3 = __builtin_bit_cast(float, w.y & 0xffff0000u);
                        const float r4 = __builtin_bit_cast(float, w.z << 16), r5 = __builtin_bit_cast(float, w.z & 0xffff0000u), r6 = __builtin_bit_cast(float, w.w << 16), r7 = __builtin_bit_cast(float, w.w & 0xffff0000u);
                        ss += (r0 * r0 + r1 * r1) + (r2 * r2 + r3 * r3) + (r4 * r4 + r5 * r5) + (r6 * r6 + r7 * r7);
                    }
                }
                if (!FINAL) { ss += __shfl_xor(ss, 16); ss += __shfl_xor(ss, 32); if (fq == 0) atomicAdd(ssq + row, ssq_fix(ss)); }
            }
    }
};
struct EpiSwiGLU {
    static constexpr bool PERM = true, AFTER_DRAIN = false;
    bf16_t* O; const ssq_t* ssq;
    __device__ __forceinline__ void pre(const Unit& u, int wr, int fr, unsigned long long (&rsv)[8]) const {
#pragma unroll
        for (int ai = 0; ai < 2; ++ai)
#pragma unroll
            for (int m = 0; m < 4; ++m) rsv[ai * 4 + m] = __hip_atomic_load(ssq + u.pm * BM + ai * HALF + wr * 64 + m * 16 + fr, __ATOMIC_RELAXED, __HIP_MEMORY_SCOPE_AGENT);
    }
    __device__ __forceinline__ void operator()(const f32x4 (&acc)[2][2][4][2], const Unit& u, int wr, int wc, int fr, int fq, const unsigned long long (&rsv)[8]) const {
        const int col0 = u.pn * BM + wc * 32 + 8 * fq;
#pragma unroll
        for (int ai = 0; ai < 2; ++ai)
#pragma unroll
            for (int m = 0; m < 4; ++m) {
                const int row = u.pm * BM + ai * HALF + wr * 64 + m * 16 + fr;
                const float rs = rsqrtf((float)rsv[ai * 4 + m] * (1.0f / (16777216.0f * 1024.0f)) + 1e-6f);
#pragma unroll
                for (int bj = 0; bj < 2; ++bj) { const f32x4 g = acc[ai][bj][m][0] * rs, up = acc[ai][bj][m][1] * rs; float a[4];
#pragma unroll
                    for (int e = 0; e < 4; ++e) a[e] = g[e] * __builtin_amdgcn_rcpf(1.0f + __builtin_amdgcn_exp2f(-1.4426950408889634f * g[e])) * up[e];
                    u32x2 w; w.x = cvt_pk_bf16(a[0], a[1]); w.y = cvt_pk_bf16(a[2], a[3]);
                    *(u32x2*)(O + (size_t)row * 2816 + ((col0 + bj * HALF) >> 1)) = w; } }
    }
};
struct EpiGLU {
    static constexpr bool PERM = true, AFTER_DRAIN = false;
    const bf16_t* Y; const float* bias; bf16_t* O;
    __device__ __forceinline__ void pre(const Unit&, int, int, unsigned long long (&)[8]) const {}
    __device__ __forceinline__ void operator()(const f32x4 (&acc)[2][2][4][2], const Unit& u, int wr, int wc, int fr, int fq, const unsigned long long (&rsv)[8]) const {
        const int col0 = u.pn * BM + wc * 32 + 8 * fq;
#pragma unroll
        for (int ai = 0; ai < 2; ++ai)
#pragma unroll
            for (int m = 0; m < 4; ++m) {
                const int row = u.pm * BM + ai * HALF + wr * 64 + m * 16 + fr;
#pragma unroll
                for (int bj = 0; bj < 2; ++bj) { const int col = col0 + bj * HALF;
                    const u32x4 yv = *(const u32x4*)(Y + (size_t)row * 512 + col);
                    const f32x4 b0 = *(const f32x4*)(bias + col), b1 = *(const f32x4*)(bias + col + 4);
                    const f32x4 z0 = acc[ai][bj][m][0] + b0, z1 = acc[ai][bj][m][1] + b1; float o[8];
                    const float yy[8] = {__builtin_bit_cast(float, yv.x << 16), __builtin_bit_cast(float, yv.x & 0xffff0000u), __builtin_bit_cast(float, yv.y << 16), __builtin_bit_cast(float, yv.y & 0xffff0000u),
                                         __builtin_bit_cast(float, yv.z << 16), __builtin_bit_cast(float, yv.z & 0xffff0000u), __builtin_bit_cast(float, yv.w << 16), __builtin_bit_cast(float, yv.w & 0xffff0000u)};
#pragma unroll
                    for (int e = 0; e < 4; ++e) { o[e] = yy[e] * __builtin_amdgcn_rcpf(1.0f + __builtin_amdgcn_exp2f(-1.4426950408889634f * z0[e])); o[4 + e] = yy[4 + e] * __builtin_amdgcn_rcpf(1.0f + __builtin_amdgcn_exp2f(-1.4426950408889634f * z1[e])); }
                    u32x4 w; w.x = cvt_pk_bf16(o[0], o[1]); w.y = cvt_pk_bf16(o[2], o[3]); w.z = cvt_pk_bf16(o[4], o[5]); w.w = cvt_pk_bf16(o[6], o[7]);
                    *(u32x4*)(O + (size_t)row * 1024 + 512 + col) = w; } }
    }
};
template <class Epi, class Sched, bool ALIGN_EPI = false, bool SP2 = false>
__device__ __forceinline__ void gemm_phase(PG8_LAS unsigned char* lds, const Gemm g, const Sched& S, const Epi& E) {
    int tid_l = threadIdx.x; asm volatile("" : "+v"(tid_l));
    const int tid = tid_l, wid = __builtin_amdgcn_readfirstlane(tid >> 6), lane = tid & 63, wr = wid >> 2, wc = wid & 3, fr = lane & 15, fq = lane >> 4;
    const int K = g.K, nt = K / BK;
    unsigned voffA[2], voffB[2];
#pragma unroll
    for (int i = 0; i < 2; ++i) { int R, C; stage_rc(tid * 16 + i * 8192, R, C); const int Rb = Epi::PERM ? ((R & ~31) + perm32(R & 31)) : R;
        voffA[i] = (unsigned)(R * K + C) * 2u; voffB[i] = (unsigned)(Rb * K + C) * 2u; }
    const size_t kstep = (size_t)(BK * 2);
    const size_t hstep = (size_t)HALF * K * 2;
    const size_t tstep = 2 * hstep;
    const unsigned ldsw = (unsigned)wid * 1024u;
    const int aoff = lds_byte(wr * 64 + fr, fq * 8), boff = lds_byte(wc * 32 + fr, fq * 8);
#define PG8_SA(b, h) (((b) * 2 + (h)) * HTB)
#define PG8_SB(b, h) ((4 + (b) * 2 + (h)) * HTB)
#define PG8_STAGE(bufoff, gbase, voff) do { _Pragma("unroll") for (int _i = 0; _i < 2; ++_i) \
        __builtin_amdgcn_global_load_lds((const unsigned*)((const char*)(gbase) + (voff)[_i]), (PG8_LAS unsigned*)(lds + (bufoff) + ldsw + _i * 8192), 16, 0, 0); } while (0)
#define PG8_LDA(dst, b, h) do { _Pragma("unroll") for (int m = 0; m < 4; ++m) _Pragma("unroll") for (int k = 0; k < 2; ++k) dst[m][k] = *(const PG8_LAS bf16x8*)(lds + PG8_SA(b, h) + aoff + m * 2048 + k * 1024); } while (0)
#define PG8_LDB(dst, b, h) do { _Pragma("unroll") for (int n = 0; n < 2; ++n) _Pragma("unroll") for (int k = 0; k < 2; ++k) dst[n][k] = *(const PG8_LAS bf16x8*)(lds + PG8_SB(b, h) + boff + n * 2048 + k * 1024); } while (0)
#define PG8_MMA(ai, bj, At, Bt) do { __builtin_amdgcn_s_setprio(1); _Pragma("unroll") for (int m = 0; m < 4; ++m) _Pragma("unroll") for (int n = 0; n < 2; ++n) _Pragma("unroll") for (int k = 0; k < 2; ++k) \
        acc[ai][bj][m][n] = __builtin_amdgcn_mfma_f32_16x16x32_bf16(Bt[n][k], At[m][k], acc[ai][bj][m][n], 0, 0, 0); __builtin_amdgcn_s_setprio(0); } while (0)
#define PG8_WAIT_V(n) asm volatile("s_waitcnt vmcnt(" #n ")" ::: "memory")
#define PG8_WAIT_L(n) asm volatile("s_waitcnt lgkmcnt(" #n ")" ::: "memory")
#define PG8_BAR __builtin_amdgcn_s_barrier()
#define PG8_SCHED __builtin_amdgcn_sched_barrier(0)
    Unit cur, nxt; int ui = 0;
    if (!S.next(0, cur)) return;
    f32x4 acc[2][2][4][2];
    unsigned long long rsv[8];
#pragma unroll
    for (int i_ = 0; i_ < 8; ++i_) rsv[i_] = 0ull;
#pragma unroll
    for (int a = 0; a < 2; ++a)
#pragma unroll
        for (int b = 0; b < 2; ++b)
#pragma unroll
            for (int m = 0; m < 4; ++m)
#pragma unroll
                for (int n = 0; n < 2; ++n) acc[a][b][m][n] = (f32x4){0.f, 0.f, 0.f, 0.f};
    bf16x8 At[4][2], B0[2][2], B1[2][2];
    const char* cA = (const char*)g.A + (size_t)cur.pm * tstep; const char* cB = (const char*)g.Bt + (size_t)cur.pn * tstep;
    S.a_ready(cur);
    if constexpr (SP2) {
        PG8_STAGE(PG8_SB(0, 0), cB, voffB); PG8_STAGE(PG8_SB(0, 1), cB + hstep, voffB); PG8_STAGE(PG8_SA(0, 0), cA, voffA); PG8_STAGE(PG8_SA(0, 1), cA + hstep, voffA);
        if (wr == 1) PG8_BAR;
        PG8_WAIT_V(2); PG8_BAR;
        PG8_STAGE(PG8_SB(1, 0), cB + kstep, voffB); PG8_STAGE(PG8_SA(1, 0), cA + kstep, voffA); PG8_STAGE(PG8_SB(1, 1), cB + hstep + kstep, voffB);
        PG8_WAIT_V(6); PG8_BAR;
    } else {
        PG8_STAGE(PG8_SB(0, 0), cB, voffB); PG8_STAGE(PG8_SA(0, 0), cA, voffA); PG8_STAGE(PG8_SB(0, 1), cB + hstep, voffB); PG8_STAGE(PG8_SA(0, 1), cA + hstep, voffA);
        if (wr == 1) PG8_BAR;
        PG8_WAIT_V(4); PG8_BAR;
        PG8_STAGE(PG8_SB(1, 0), cB + kstep, voffB); PG8_STAGE(PG8_SA(1, 0), cA + kstep, voffA); PG8_STAGE(PG8_SB(1, 1), cB + hstep + kstep, voffB);
        PG8_WAIT_V(6); PG8_BAR;
    }
    for (;;) {
        const bool has_next = S.next(ui + 1, nxt);
        const char* nA = has_next ? (const char*)g.A + (size_t)nxt.pm * tstep : cA; const char* nB = has_next ? (const char*)g.Bt + (size_t)nxt.pn * tstep : cB;
        for (int t = 0; t < nt; t += 2) {
            const bool last = (t == nt - 2);
            if (last) E.pre(cur, wr, fr, rsv);
            const char* a1 = cA + (size_t)(t + 1) * kstep;
            const char* a2 = last ? nA : cA + (size_t)(t + 2) * kstep; const char* b2 = last ? nB : cB + (size_t)(t + 2) * kstep;
            const char* a3 = a2 + kstep; const char* b3 = b2 + kstep;
            if (last && has_next) S.a_ready(nxt);
            if constexpr (SP2) {
            PG8_LDB(B0, 0, 0); PG8_LDB(B1, 0, 1); PG8_SCHED; PG8_LDA(At, 0, 0); PG8_STAGE(PG8_SA(1, 1), a1 + hstep, voffA);
            PG8_WAIT_V(8); PG8_WAIT_L(0); PG8_BAR; PG8_MMA(0, 0, At, B0); PG8_MMA(0, 1, At, B1); PG8_BAR; PG8_SCHED;
            PG8_LDA(At, 0, 1); PG8_STAGE(PG8_SB(0, 0), b2, voffB); PG8_STAGE(PG8_SB(0, 1), b2 + hstep, voffB); PG8_STAGE(PG8_SA(0, 0), a2, voffA);
            PG8_WAIT_V(8); PG8_WAIT_L(0); PG8_BAR; PG8_MMA(1, 0, At, B0); PG8_MMA(1, 1, At, B1); PG8_BAR; PG8_SCHED;
            PG8_LDB(B0, 1, 0); PG8_LDB(B1, 1, 1); PG8_SCHED; PG8_LDA(At, 1, 0); PG8_STAGE(PG8_SA(0, 1), a2 + hstep, voffA);
            PG8_WAIT_V(8); PG8_WAIT_L(0); PG8_BAR; PG8_MMA(0, 0, At, B0); PG8_MMA(0, 1, At, B1); PG8_BAR; PG8_SCHED;
            PG8_LDA(At, 1, 1); PG8_STAGE(PG8_SB(1, 0), b3, voffB); PG8_STAGE(PG8_SB(1, 1), b3 + hstep, voffB); PG8_STAGE(PG8_SA(1, 0), a3, voffA);
            PG8_WAIT_V(8); PG8_WAIT_L(0); PG8_BAR; PG8_MMA(1, 0, At, B0); PG8_MMA(1, 1, At, B1); PG8_BAR; PG8_SCHED;
            } else {
            PG8_LDB(B0, 0, 0); PG8_SCHED; PG8_LDA(At, 0, 0); PG8_STAGE(PG8_SA(1, 1), a1 + hstep, voffA);
            PG8_WAIT_L(8); PG8_BAR; PG8_WAIT_L(0); PG8_MMA(0, 0, At, B0); PG8_BAR; PG8_SCHED;
            PG8_LDB(B1, 0, 1); PG8_STAGE(PG8_SB(0, 0), b2, voffB);
            PG8_BAR; PG8_WAIT_L(0); PG8_MMA(0, 1, At, B1); PG8_BAR;
            PG8_LDA(At, 0, 1); PG8_STAGE(PG8_SA(0, 0), a2, voffA);
            PG8_BAR; PG8_WAIT_L(0); PG8_MMA(1, 0, At, B0); PG8_BAR; PG8_SCHED;
            PG8_STAGE(PG8_SB(0, 1), b2 + hstep, voffB);
            PG8_WAIT_V(6); PG8_BAR; PG8_MMA(1, 1, At, B1); PG8_BAR;
            PG8_LDB(B0, 1, 0); PG8_SCHED; PG8_LDA(At, 1, 0); PG8_STAGE(PG8_SA(0, 1), a2 + hstep, voffA);
            PG8_WAIT_L(8); PG8_BAR; PG8_WAIT_L(0); PG8_MMA(0, 0, At, B0); PG8_BAR; PG8_SCHED;
            PG8_LDB(B1, 1, 1); PG8_STAGE(PG8_SB(1, 0), b3, voffB);
            PG8_BAR; PG8_WAIT_L(0); PG8_MMA(0, 1, At, B1); PG8_BAR;
            PG8_LDA(At, 1, 1); PG8_STAGE(PG8_SA(1, 0), a3, voffA);
            PG8_BAR; PG8_WAIT_L(0); PG8_MMA(1, 0, At, B0); PG8_BAR; PG8_SCHED;
            PG8_STAGE(PG8_SB(1, 1), b3 + hstep, voffB);
            PG8_WAIT_V(6); PG8_BAR; PG8_MMA(1, 1, At, B1); PG8_BAR;
            }
        }
        if constexpr (ALIGN_EPI) { if (wr == 0) PG8_BAR; }
        if constexpr (!Epi::AFTER_DRAIN) { E(acc, cur, wr, wc, fr, fq, rsv); S.done(cur); }
        if (!has_next) break;
#pragma unroll
        for (int a = 0; a < 2; ++a)
#pragma unroll
            for (int b = 0; b < 2; ++b)
#pragma unroll
                for (int m = 0; m < 4; ++m)
#pragma unroll
                    for (int n = 0; n < 2; ++n) acc[a][b][m][n] = (f32x4){0.f, 0.f, 0.f, 0.f};
        cur = nxt; cA = nA; cB = nB; ++ui;
        if constexpr (ALIGN_EPI) { if (wr == 1) PG8_BAR; }
    }
    PG8_WAIT_V(0);
    if constexpr (!ALIGN_EPI) { if (wr == 0) PG8_BAR; }
    PG8_BAR;
    if constexpr (Epi::AFTER_DRAIN) { E.fused(acc, cur, wr, wc, fr, fq, lds, wid, lane); S.done(cur); }
#undef PG8_SA
#undef PG8_SB
#undef PG8_STAGE
#undef PG8_LDA
#undef PG8_LDB
#undef PG8_MMA
#undef PG8_WAIT_V
#undef PG8_WAIT_L
#undef PG8_BAR
#undef PG8_SCHED
}
}
namespace att {
constexpr int KROW = 144, KBUF = 64 * KROW;
constexpr int VBUF = 16384;
constexpr int L_K = 0, L_V = 2 * KBUF, L_BIAS = L_V + 3 * VBUF, L_FLAG = L_BIAS + 2 * 64 * 4, L_MISC = L_FLAG + 64, L_END = L_MISC + 64;
__device__ __forceinline__ int crow(int r, int hi) { return (r & 3) + 8 * (r >> 2) + 4 * hi; }
__device__ __forceinline__ unsigned cvtpk(float lo, float hi) { unsigned r; asm volatile("v_cvt_pk_bf16_f32 %0, %1, %2" : "=v"(r) : "v"(lo), "v"(hi)); return r; }

struct Args { const bf16_t* qkv; int pitch; int rowb; int u; int qcol, kcol, vcol; const float* F; float kmax; };


template <bool MASKED>
__device__ __forceinline__ void sb_tile(f32x16 (&x)[2], float& carry, int tlo, int hi, int qpos) {
#pragma unroll
                for (int xt = 1; xt >= 0; --xt) {
                    float lm[16], G[4], Gp[4];
#pragma unroll
                    for (int r = 0; r < 16; ++r) {
                        const float z = x[xt][r], sp = fmaxf(z, 0.f) + flog2(1.0f + fexp2(-fabsf(z)));
                        bool valid = true;
                        if (MASKED) { const int kvp = tlo + 32 * xt + crow(r, hi); valid = (kvp < qpos) && (kvp >= PADR); }
                        lm[r] = valid ? -sp : 0.f;
                        x[xt][r] = valid ? (z - sp) : -1e30f;
                    }
#pragma unroll
                    for (int g = 0; g < 4; ++g) { G[g] = (lm[4 * g] + lm[4 * g + 1]) + (lm[4 * g + 2] + lm[4 * g + 3]); Gp[g] = __shfl_xor(G[g], 32); }
                    float runv = carry;
#pragma unroll
                    for (int g = 3; g >= 0; --g) {
                        const float g1 = hi ? G[g] : Gp[g], g0 = hi ? Gp[g] : G[g];
                        const float sg = hi ? runv : (runv + g1);
                        const float c3 = sg, c2 = c3 + lm[4 * g + 3], c1 = c2 + lm[4 * g + 2], c0 = c1 + lm[4 * g + 1];
                        x[xt][4 * g + 3] = fexp2(x[xt][4 * g + 3] + c3); x[xt][4 * g + 2] = fexp2(x[xt][4 * g + 2] + c2);
                        x[xt][4 * g + 1] = fexp2(x[xt][4 * g + 1] + c1); x[xt][4 * g] = fexp2(x[xt][4 * g] + c0);
                        runv = runv + (g1 + g0);
                    }
                    carry = runv;
                }
}
template <int MODE, int NDV, bool BIAS>
__device__ __forceinline__ void tile_compute(LAS unsigned char* lds, int kt, int buf, int vs, const bf16x8 (&qf)[4], f32x16 (&o)[NDV],
                                             float& mrun, float& lrun, float& carry, f32x16& negm, f32x16& osum, bool wdone, bool& pend, int& vsp, int w, int lane, int r32, int hi, int qmin, int qpos, unsigned vlane) {
#define ATT_PV(VS_) do { const unsigned vba = (unsigned)(uintptr_t)(lds + L_V + (VS_) * VBUF + vlane);     \
        _Pragma("unroll") for (int ks = 0; ks < 4; ++ks) { \
            v4i16_t lo_[NDV], hh_[NDV]; \
            _Pragma("unroll") for (int c = 0; c < NDV; ++c) { \
                asm volatile("ds_read_b64_tr_b16 %0, %1 offset:%c2" : "=&v"(lo_[c]) : "v"(vba), "i"((2 * ks) * (NDV * 512) + 512 * c) : "memory"); \
                asm volatile("ds_read_b64_tr_b16 %0, %1 offset:%c2" : "=&v"(hh_[c]) : "v"(vba), "i"((2 * ks + 1) * (NDV * 512) + 512 * c) : "memory"); } \
            if (NDV == 4) asm volatile("s_waitcnt lgkmcnt(0)" : "+v"(lo_[0]), "+v"(hh_[0]), "+v"(lo_[1]), "+v"(hh_[1]), "+v"(lo_[2 % NDV]), "+v"(hh_[2 % NDV]), "+v"(lo_[3 % NDV]), "+v"(hh_[3 % NDV]) :: "memory");     \
            else asm volatile("s_waitcnt lgkmcnt(0)" : "+v"(lo_[0]), "+v"(hh_[0]), "+v"(lo_[1]), "+v"(hh_[1]) :: "memory"); \
            bf16x8 pb; { u32x4 t4 = {pk[ks][0], pk[ks][1], pk[ks][2], pk[ks][3]}; pb = __builtin_bit_cast(bf16x8, t4); } \
            _Pragma("unroll") for (int c = 0; c < NDV; ++c) { \
                const bf16x8 va = {lo_[c][0], lo_[c][1], lo_[c][2], lo_[c][3], hh_[c][0], hh_[c][1], hh_[c][2], hh_[c][3]}; \
                o[c] = __builtin_amdgcn_mfma_f32_32x32x16_bf16(va, pb, o[c], 0, 0, 0); } } } while (0)
        const int tlo = 64 * kt;
        const bool skip = wdone || ((MODE == 0) ? (tlo >= qmin + 31) : (tlo > qmin + 31));
        if (!skip) {
            unsigned pk[4][4];
            const bool needmask = (kt == 3) || ((MODE == 0) ? (tlo + 63 >= qmin) : (tlo + 63 > qmin));
            const LAS unsigned char* kb = lds + L_K + buf * KBUF + r32 * KROW + 16 * hi;
            f32x16 x[2];
#pragma unroll
            for (int xt = 0; xt < 2; ++xt) {
                if (BIAS) {
                    const LAS float* bp = (const LAS float*)(lds + L_BIAS + buf * 256) + 32 * xt + 4 * hi;
#pragma unroll
                    for (int g = 0; g < 4; ++g) { const f32x4 bv = *(const LAS f32x4*)(bp + 8 * g); x[xt][4 * g] = bv[0]; x[xt][4 * g + 1] = bv[1]; x[xt][4 * g + 2] = bv[2]; x[xt][4 * g + 3] = bv[3]; }
                } else if (MODE == 0) {
#pragma unroll
                    for (int r = 0; r < 16; ++r) x[xt][r] = 0.f;
                }
#pragma unroll
                for (int d0 = 0; d0 < 4; ++d0) { const bf16x8 kf = *(const LAS bf16x8*)(kb + xt * 32 * KROW + 32 * d0);
                    if (MODE == 1 && !BIAS && d0 == 0) x[xt] = __builtin_amdgcn_mfma_f32_32x32x16_bf16(kf, qf[d0], negm, 0, 0, 0);
                    else x[xt] = __builtin_amdgcn_mfma_f32_32x32x16_bf16(kf, qf[d0], x[xt], 0, 0, 0); }
            }
            if (MODE == 1) {
                if (needmask) {
#pragma unroll
                    for (int xt = 0; xt < 2; ++xt)
#pragma unroll
                        for (int r = 0; r < 16; ++r) { const int kvp = tlo + 32 * xt + crow(r, hi); if (kvp > qpos || kvp < PADR) x[xt][r] = -1e30f; }
                }
                float mx = x[0][0];
#pragma unroll
                for (int r = 1; r < 16; ++r) mx = fmaxf(mx, x[0][r]);
#pragma unroll
                for (int r = 0; r < 16; ++r) mx = fmaxf(mx, x[1][r]);
                if (BIAS) {
                    mx = fmaxf(mx, __shfl_xor(mx, 32));
                    const float mnew = fmaxf(mrun, mx), alpha = fexp2(mrun - mnew); mrun = mnew;
#pragma unroll
                    for (int xt = 0; xt < 2; ++xt)
#pragma unroll
                        for (int r = 0; r < 16; ++r) x[xt][r] = fexp2(x[xt][r] - mnew);
                    if (__any(alpha != 1.0f)) {
#pragma unroll
                        for (int c = 0; c < NDV; ++c)
#pragma unroll
                            for (int r = 0; r < 16; ++r) o[c][r] *= alpha;
#pragma unroll
                        for (int r = 0; r < 16; ++r) osum[r] *= alpha;
                    }
                } else {
                    const bool first = (carry == 0.f);
                    if (first || __any(mx > 8.0f)) {
                        carry = 1.f;
                        mx = fmaxf(mx, __shfl_xor(mx, 32));
                        const float dl = first ? ((mx > -1e29f) ? mx : 0.f) : fmaxf(mx, 0.f);
                        const float alpha = first ? 1.0f : fexp2(-dl);
                        mrun += dl; lrun *= alpha;
#pragma unroll
                        for (int xt = 0; xt < 2; ++xt)
#pragma unroll
                            for (int r = 0; r < 16; ++r) x[xt][r] -= dl;
#pragma unroll
                        for (int r = 0; r < 16; ++r) negm[r] = -mrun;
#pragma unroll
                        for (int c = 0; c < NDV; ++c)
#pragma unroll
                            for (int r = 0; r < 16; ++r) o[c][r] *= alpha;
                    }
                    float ps = 0.f;
#pragma unroll
                    for (int xt = 0; xt < 2; ++xt)
#pragma unroll
                        for (int r = 0; r < 16; ++r) { const float pv = fexp2(x[xt][r]); x[xt][r] = pv; ps += pv; }
                    lrun += ps;
                }
            } else {
                if (needmask) sb_tile<true>(x, carry, tlo, hi, qpos); else sb_tile<false>(x, carry, tlo, hi, qpos);
            }
#pragma unroll
            for (int ks = 0; ks < 4; ++ks)
#pragma unroll
                for (int j = 0; j < 4; ++j) pk[ks][j] = cvtpk(x[ks >> 1][8 * (ks & 1) + 2 * j], x[ks >> 1][8 * (ks & 1) + 2 * j + 1]);
            if (BIAS) {
                const bf16x8 ones = {(short)0x3F80, (short)0x3F80, (short)0x3F80, (short)0x3F80, (short)0x3F80, (short)0x3F80, (short)0x3F80, (short)0x3F80};
#pragma unroll
                for (int ks = 0; ks < 4; ++ks) { const u32x4 t4 = {pk[ks][0], pk[ks][1], pk[ks][2], pk[ks][3]}; osum = __builtin_amdgcn_mfma_f32_32x32x16_bf16(ones, __builtin_bit_cast(bf16x8, t4), osum, 0, 0, 0); }
            }
            ATT_PV(vs);
        }
}
#undef ATT_PV

template <int MODE, int NDV, bool BIAS>
__device__ __forceinline__ void run(LAS unsigned char* lds, const Args& a, f32x16 (&o)[NDV], float& l_out) {
    int tid_l = threadIdx.x; asm volatile("" : "+v"(tid_l));
    const int tid = tid_l, lane = tid & 63, w = __builtin_amdgcn_readfirstlane(tid >> 6), r32 = lane & 31, hi = lane >> 5;
    const int qmin = 256 * a.u + 32 * w, qpos = qmin + r32;
    constexpr int NV = NDV / 2;
    bf16x8 qf[4];
    { const bf16_t* qp = a.qkv + (size_t)(a.rowb + qpos) * a.pitch + a.qcol + 8 * hi;
#pragma unroll
      for (int d0 = 0; d0 < 4; ++d0) qf[d0] = *(const bf16x8*)(qp + 16 * d0); }
    float qkb = 0.f;
    if (BIAS) { float s2 = 0.f;
#pragma unroll
        for (int d0 = 0; d0 < 4; ++d0)
#pragma unroll
            for (int j = 0; j < 8; ++j) { const float qv = bf2f((unsigned short)qf[d0][j]); s2 += qv * qv; }
        s2 += __shfl_xor(s2, 32); qkb = sqrtf(s2) * a.kmax * 1.001f + 1e-3f; }
    const int kr = tid >> 3, kc = tid & 7;
    const bf16_t* kg = a.qkv + (size_t)(a.rowb + kr) * a.pitch + a.kcol + 8 * kc;
    const unsigned klds = kr * KROW + kc * 16;
    const bf16_t* vg[NV]; unsigned vlds[NV];
#pragma unroll
    for (int j = 0; j < NV; ++j) {
        int vr, ch; if (NDV == 2) { vr = tid >> 3; ch = tid & 7; } else { vr = (tid >> 4) + 32 * j; ch = tid & 15; }
        vg[j] = a.qkv + (size_t)(a.rowb + vr) * a.pitch + a.vcol + 8 * ch;
        vlds[j] = (vr >> 3) * (NDV * 512) + (ch >> 2) * 512 + (vr & 7) * 64 + (ch & 3) * 16;
    }
    const size_t tstride = (size_t)64 * a.pitch;
    float fq0 = 0.f; if (BIAS) fq0 = a.F[256 * a.u];
    const int ntile = 4 * a.u + 1;
#define ATT_TILE(i) ((MODE == 0 || BIAS) ? (4 * a.u + 3 - (i)) : (3 + (i)))
    u32x4 kregA, vregA[NV]; float bregA = 0.f, ubnA = 0.f, ubn_next = 0.f;
#define ATT_LOADX(KR, VR, BR, UB, kt) do { KR = *(const u32x4*)(kg + (size_t)(kt) * tstride); _Pragma("unroll") for (int j_ = 0; j_ < NV; ++j_) VR[j_] = *(const u32x4*)(vg[j_] + (size_t)(kt) * tstride); \
        if (BIAS) { if (tid < 64) BR = (fq0 - a.F[64 * (kt) + tid]) * LOG2E; UB = (fq0 - a.F[64 * (kt) + 63]) * LOG2E; } } while (0)
#define ATT_WRITEX(KR, VR, BR, UB, b, vs_) do { *(LAS u32x4*)(lds + L_K + (b) * KBUF + klds) = KR; _Pragma("unroll") for (int j_ = 0; j_ < NV; ++j_) *(LAS u32x4*)(lds + L_V + (vs_) * VBUF + vlds[j_]) = VR[j_]; \
        if (BIAS) { if (tid < 64) *(LAS float*)(lds + L_BIAS + (b) * 256 + tid * 4) = BR; ubn_next = UB; } } while (0)
#define ATT_LOADA(kt) ATT_LOADX(kregA, vregA, bregA, ubnA, kt)
#define ATT_WRITEA(b, vs_) ATT_WRITEX(kregA, vregA, bregA, ubnA, b, vs_)
#pragma unroll
    for (int c = 0; c < NDV; ++c)
#pragma unroll
        for (int r = 0; r < 16; ++r) o[c][r] = 0.f;
    float mrun = (MODE == 1 && !BIAS) ? 0.f : -1e30f, lrun = 0.f, carry = 0.f;
    f32x16 negm, osum;
#pragma unroll
    for (int r = 0; r < 16; ++r) { negm[r] = 0.f; osum[r] = 0.f; }
    const unsigned vlane = 64 * (4 * hi + ((lane & 15) >> 2)) + 32 * ((lane >> 4) & 1) + 8 * (lane & 3);
    ATT_LOADA(ATT_TILE(0)); ATT_WRITEA(0, 0);
    asm volatile("" :: "v"(qf[0]), "v"(qf[1]), "v"(qf[2]), "v"(qf[3]));
    __syncthreads();
    bool pend = false; int vsp = 0, vs = 0;
#define ATT_ITER(i_) do { \
        const int kt_ = ATT_TILE(i_), buf_ = (i_) & 1; vs = (i_) % 3; \
        if ((i_) + 1 < ntile) ATT_LOADA(ATT_TILE((i_) + 1)); \
        bool wdone_ = false; if (MODE == 0) wdone_ = __all(carry < -160.0f) != 0; if (BIAS) wdone_ = __all(qkb + ub_cur - mrun < -160.0f) != 0; \
        tile_compute<MODE, NDV, BIAS>(lds, kt_, buf_, vs, qf, o, mrun, lrun, carry, negm, osum, wdone_, pend, vsp, w, lane, r32, hi, qmin, qpos, vlane); \
        if (MODE == 0) { const int ok = __all(carry < -160.0f) ? 1 : 0; if (lane == 0) *(LAS int*)(lds + L_FLAG + (buf_ * 8 + w) * 4) = ok; } \
        if ((i_) + 1 < ntile) ATT_WRITEA(buf_ ^ 1, ((i_) + 1) % 3); \
        ub_cur = ubn_next; \
        if (BIAS) { const int ok = __all(qkb + ubn_next - mrun < -160.0f) ? 1 : 0; if (lane == 0) *(LAS int*)(lds + L_FLAG + (buf_ * 8 + w) * 4) = ok; } \
        __syncthreads(); \
        if (MODE == 0 || BIAS) { const LAS int* fl = (const LAS int*)(lds + L_FLAG + buf_ * 32); \
            if (fl[0] & fl[1] & fl[2] & fl[3] & fl[4] & fl[5] & fl[6] & fl[7]) stop = true; } } while (0)
    bool stop = false;
    float ub_cur = ubn_next;
    for (int i = 0; i < ntile && !stop; ++i) ATT_ITER(i);
    __syncthreads();
    l_out = BIAS ? osum[0] : (lrun + __shfl_xor(lrun, 32));
#undef ATT_TILE
#undef ATT_LOADX
#undef ATT_WRITEX
#undef ATT_LOADA
#undef ATT_WRITEA
#undef ATT_ITER
}
}
struct Params { const float* in[27]; float* out; unsigned char* ws; int ph_lo, ph_hi; };

__device__ __forceinline__ float log_sigmoid_f(float x) { return -(fmaxf(-x, 0.f) + log1pf(expf(-fabsf(x)))); }
__device__ __forceinline__ float gelu_tanh_f(float x) { const float z = 0.7978845608028654f * (x + 0.044715f * x * x * x); const float t = 1.0f - 2.0f / (__expf(2.0f * z) + 1.0f); return 0.5f * x * (1.0f + t); }

__device__ __forceinline__ void map_col(int kind, int n, int& dr, float& sc) {
    sc = 1.0f; dr = n;
    if (kind == 1) { if (n < 512 || (n >= 1536 && n < 2048)) sc = C2; }
    else if (kind == 2) { if (n < 512) sc = C2; else if (n >= 1536 && n < 1544) dr = -1; else if (n >= 1544) dr = n - 8; }
    else if (kind == 3) { if (n < 2816) dr = 8 * (n >> 2) + (n & 3); else { const int j = n - 2816; dr = 8 * (j >> 2) + 4 + (j & 3); } }
}
__device__ __forceinline__ void transpose_item(const float* W, int K, int N, const float* gk, bf16_t* WT, int kind, LAS float* scr, int item, int lane) {
    const int nblk = (N + 31) / 32, kb = item / nblk, nb = item % nblk, k0 = 64 * kb, n0 = 32 * nb;
    float wv[32];
    { const int n = n0 + (lane & 31); const bool inb = n < N; const float* wp = W + (size_t)(k0 + (lane >> 5)) * N + (inb ? n : 0);
#pragma unroll
      for (int i = 0; i < 32; ++i) wv[i] = inb ? wp[(size_t)(2 * i) * N] : 0.f;
      if (gk) {
#pragma unroll
          for (int i = 0; i < 32; ++i) wv[i] *= gk[k0 + 2 * i + (lane >> 5)];
      }
#pragma unroll
      for (int i = 0; i < 32; ++i) scr[(2 * i + (lane >> 5)) * 33 + (lane & 31)] = wv[i]; }
    asm volatile("s_waitcnt lgkmcnt(0)" ::: "memory");
    const int c = lane & 7;
#pragma unroll
    for (int j = 0; j < 4; ++j) { const int nl = (lane >> 3) + 8 * j, n = n0 + nl;
        if (n < N) { int dr; float sc; map_col(kind, n, dr, sc);
            if (dr >= 0) { const LAS float* s = scr + (8 * c) * 33 + nl;
                u32x4 o; o.x = pk2(s[0 * 33] * sc, s[1 * 33] * sc); o.y = pk2(s[2 * 33] * sc, s[3 * 33] * sc); o.z = pk2(s[4 * 33] * sc, s[5 * 33] * sc); o.w = pk2(s[6 * 33] * sc, s[7 * 33] * sc);
                *(u32x4*)(WT + (size_t)dr * K + k0 + 8 * c) = o; } } }
    asm volatile("s_waitcnt lgkmcnt(0)" ::: "memory");
}

struct S5Ops { float ar, ai, dsk; bf16x8 bfr[4], af[2], cf[4]; unsigned short uq[16]; };
template <bool FINAL>
__device__ __forceinline__ void s5_load(const Params& p, int item, int lane, S5Ops& q) {
    const int g = item & 31, bc = item >> 5, c = bc % 132, b = bc / 132;
    const unsigned char* ws = p.ws;
    const bf16_t* qkv = (const bf16_t*)(ws + WS_QKV);
    const float* a_re_p = (const float*)(ws + WS_S5A); const float* a_im_p = a_re_p + 2048;
    const int gp = g * 64 + lane, r32 = lane & 31, hi = lane >> 5;
    q.ar = a_re_p[gp]; q.ai = a_im_p[gp];
    { const bf16_t* bt = (const bf16_t*)(ws + WS_S5BT) + ((size_t)g * 128 + r32) * 16 + 8 * hi;
#pragma unroll
      for (int pb = 0; pb < 4; ++pb) q.bfr[pb] = *(const bf16x8*)(bt + pb * 32 * 16); }
    const bf16_t* urow = qkv + ((size_t)b * LP + 64 * c) * 2048 + 1536 + 16 * g;
#pragma unroll
    for (int sub = 0; sub < 2; ++sub) q.af[sub] = *(const bf16x8*)(urow + (size_t)(32 * sub + r32) * 2048 + 8 * hi);
    q.dsk = 0.f;
    if (FINAL) {
        const bf16_t* ct = (const bf16_t*)(ws + WS_S5CT) + ((size_t)g * 16 + (lane & 15)) * 128 + 8 * (lane >> 4);
#pragma unroll
        for (int ks = 0; ks < 4; ++ks) q.cf[ks] = *(const bf16x8*)(ct + 32 * ks);
        q.dsk = p.in[22][g * 16 + (lane & 15)];
#pragma unroll
        for (int k = 0; k < 16; ++k) { const int t = 32 * (k >> 3) + 16 * ((k >> 2) & 1) + 4 * (lane >> 4) + (k & 3); q.uq[k] = urow[(size_t)t * 2048 + (lane & 15)]; }
    }
}
template <bool FINAL>
__device__ __forceinline__ void s5_compute(const Params& p, LAS unsigned char* wl  , int item, int lane, const S5Ops& q) {
    const int g = item & 31, bc = item >> 5, c = bc % 132, b = bc / 132;
    const unsigned char* ws = p.ws;
    float2* E = (float2*)(ws + WS_E);
    const int r32 = lane & 31, hi = lane >> 5;
    const float ar = q.ar, ai = q.ai;
    float xr = 0.f, xi = 0.f;
    if (FINAL) {
        float pr_ = ar, pi_ = ai;
#pragma unroll
        for (int s = 0; s < 6; ++s) { const float nr = pr_ * pr_ - pi_ * pi_, ni = 2.0f * pr_ * pi_; pr_ = nr; pi_ = ni; }
        const float2* Eb = E + ((size_t)b * 132 * 32 + g) * 64 + lane;
        int cc = 0;
        for (; cc + 8 <= c; cc += 8) {
            float2 e[8];
#pragma unroll
            for (int k = 0; k < 8; ++k) e[k] = Eb[(size_t)(cc + k) * 32 * 64];
#pragma unroll
            for (int k = 0; k < 8; ++k) { const float nr = pr_ * xr - pi_ * xi + e[k].x, ni = pr_ * xi + pi_ * xr + e[k].y; xr = nr; xi = ni; }
        }
        for (; cc < c; ++cc) { const float2 e = Eb[(size_t)cc * 32 * 64]; const float nr = pr_ * xr - pi_ * xi + e.x, ni = pr_ * xi + pi_ * xr + e.y; xr = nr; xi = ni; }
    }
    LAS float* BU = (LAS float*)wl;
#pragma unroll 1
    for (int sub = 0; sub < 2; ++sub) {
#pragma unroll
        for (int pb = 0; pb < 4; ++pb) {
            f32x16 z;
#pragma unroll
            for (int r = 0; r < 16; ++r) z[r] = 0.f;
            const f32x16 d = __builtin_amdgcn_mfma_f32_32x32x16_bf16(sub == 0 ? q.af[0] : q.af[1], q.bfr[pb], z, 0, 0, 0);
#pragma unroll
            for (int r = 0; r < 16; ++r) BU[((r & 3) + 8 * (r >> 2) + 4 * hi) * 128 + 32 * pb + r32] = d[r];
        }
        asm volatile("s_waitcnt lgkmcnt(0)" ::: "memory");
#pragma unroll 8
        for (int tt = 0; tt < 32; ++tt) {
            const float sr = BU[tt * 128 + lane], si = BU[tt * 128 + 64 + lane];
            const float nr = ar * xr - ai * xi + sr, ni = ar * xi + ai * xr + si; xr = nr; xi = ni;
            if (FINAL) {
                LAS unsigned char* xrow = wl + tt * 512;
                const unsigned xp = pg8::cvt_pk_bf16(xr, xi);
                *(LAS bf16_t*)(xrow + (((lane >> 3) ^ (tt & 15)) << 4) + ((lane & 7) << 1)) = (bf16_t)(xp & 0xffffu);
                *(LAS bf16_t*)(xrow + ((((64 + lane) >> 3) ^ (tt & 15)) << 4) + ((lane & 7) << 1)) = (bf16_t)(xp >> 16);
            }
        }
        if (FINAL) {
            asm volatile("s_waitcnt lgkmcnt(0)" ::: "memory");
            bf16_t* Y = (bf16_t*)(ws + WS_Y);
#pragma unroll
            for (int mb = 0; mb < 2; ++mb) {
                f32x4 acc = {0.f, 0.f, 0.f, 0.f};
                const int tr = 16 * mb + (lane & 15);
#pragma unroll
                for (int ks = 0; ks < 4; ++ks) { const bf16x8 xf = *(const LAS bf16x8*)(wl + tr * 512 + (((4 * ks + (lane >> 4)) ^ (tr & 15)) << 4));
                    acc = __builtin_amdgcn_mfma_f32_16x16x32_bf16(xf, q.cf[ks], acc, 0, 0, 0); }
#pragma unroll
                for (int i2 = 0; i2 < 4; ++i2) { const int t = 32 * sub + 16 * mb + 4 * (lane >> 4) + i2;
                    const float uv = bf2f(sub == 0 ? q.uq[4 * mb + i2] : q.uq[8 + 4 * mb + i2]);
                    const float yv = acc[i2] + q.dsk * uv;
                    Y[((size_t)b * LP + 64 * c + t) * 512 + 16 * g + (lane & 15)] = (bf16_t)f2bf(gelu_tanh_f(yv)); }
            }
            asm volatile("s_waitcnt lgkmcnt(0)" ::: "memory");
        }
    }
    if (!FINAL) E[((size_t)(b * 132 + c) * 32 + g) * 64 + lane] = make_float2(xr, xi);
}
template <bool FINAL>
__device__ __forceinline__ void s5_run(const Params& p, LAS unsigned char* wl, int first, int stride, int nitems, int lane) {
    S5Ops cur, nxt;
    if (first < nitems) s5_load<FINAL>(p, first, lane, cur);
    for (int it = first; it < nitems; it += stride) {
        if (it + stride < nitems) s5_load<FINAL>(p, it + stride, lane, nxt);
        s5_compute<FINAL>(p, wl, it, lane, cur);
        cur = nxt;
    }
}
__device__ __forceinline__ unsigned long long rt() { return __builtin_amdgcn_s_memrealtime(); }
#define XB_TMO      128
#define XB_XCNT(j)  (256  + 64 * (j))
#define XB_XSUB(j)  (1280 + 64 * (j))
#define XB_XGEN(j)  (2304 + 64 * (j))
#define XB_TOP      3328
#define XB_TOPGEN   3392
#define XCD_BAR_WORDS 3456
#define XB_SPIN_CAP (1u << 18)

__device__ __forceinline__ unsigned xb_ld(unsigned* p)              { return __hip_atomic_load(p, __ATOMIC_RELAXED, __HIP_MEMORY_SCOPE_AGENT); }
__device__ __forceinline__ unsigned xb_add(unsigned* p, unsigned v) { return __hip_atomic_fetch_add(p, v, __ATOMIC_RELAXED, __HIP_MEMORY_SCOPE_AGENT); }
__device__ __forceinline__ unsigned xb_xcc_id() { return (unsigned)__builtin_amdgcn_s_getreg((3 << 11) | 20) & 0xFu; }
#define XB_SPIN(cond, bar) do { unsigned _sp = 0; while (cond) { __builtin_amdgcn_s_sleep(1); \
    if ((++_sp & 255u) == 0u) { if (xb_ld(&(bar)[XB_TMO])) break; if (_sp > XB_SPIN_CAP) { atomicAdd(&(bar)[XB_TMO], 1u); break; } } } } while (0)

struct XcdBarrier {
    unsigned* bar; unsigned x;
    volatile LAS unsigned* st;
};

__device__ __forceinline__ XcdBarrier xcd_barrier_post(unsigned* bar, volatile LAS unsigned* st) {
    XcdBarrier b; b.bar = bar; b.x = xb_xcc_id(); b.st = st;
    if (threadIdx.x == 0) (void)xb_add(&bar[XB_XCNT(b.x)], 1u);
    return b;
}
__device__ __forceinline__ void xcd_barrier_complete(unsigned* bar, unsigned x, unsigned& nloc, unsigned& nx) {
    const unsigned G = gridDim.x * gridDim.y * gridDim.z;
    unsigned sum, cnt, mine, sp = 0u;
    for (;;) {
        sum = 0u; cnt = 0u; mine = 0u;
#pragma unroll
        for (unsigned j = 0; j < 16; ++j) { const unsigned c = xb_ld(&bar[XB_XCNT(j)]); sum += c; cnt += (c > 0u) ? 1u : 0u; mine = (j == x) ? c : mine; }
        if (sum == G) break;
        __builtin_amdgcn_s_sleep(1);
        if ((++sp & 255u) == 0u) { if (xb_ld(&bar[XB_TMO])) break; if (sp > XB_SPIN_CAP) { atomicAdd(&bar[XB_TMO], 1u); break; } }
    }
    nloc = mine > 0u ? mine : 1u; nx = cnt > 0u ? cnt : 1u;
}

__device__ __forceinline__ void xcd_barrier(const XcdBarrier& b) {
    asm volatile("s_waitcnt vmcnt(0)" ::: "memory");
    __syncthreads();
    if (threadIdx.x == 0) {
        unsigned* bar = b.bar;
        __builtin_amdgcn_s_waitcnt(0);
        unsigned nloc = b.st[0], nx = b.st[1];
        if (nloc == 0u) { xcd_barrier_complete(bar, b.x, nloc, nx); b.st[0] = nloc; b.st[1] = nx; }
        const unsigned old = xb_add(&bar[XB_XSUB(b.x)], 1u);
        const unsigned gen = old / nloc;
        if (old + 1u == (gen + 1u) * nloc) {
            __builtin_amdgcn_fence(__ATOMIC_RELEASE, "agent");
            asm volatile("s_waitcnt vmcnt(0)" ::: "memory");
            const unsigned og = xb_add(&bar[XB_TOP], 1u);
            const unsigned tg = og / nx;
            if (og + 1u == (tg + 1u) * nx) xb_add(&bar[XB_TOPGEN], 1u);
            else XB_SPIN(xb_ld(&bar[XB_TOPGEN]) == tg, bar);
            __builtin_amdgcn_fence(__ATOMIC_ACQUIRE, "agent");
            xb_add(&bar[XB_XGEN(b.x)], 1u);
            asm volatile("s_waitcnt vmcnt(0)" ::: "memory");
        } else {
            XB_SPIN(xb_ld(&bar[XB_XGEN(b.x)]) == gen, bar);
            __builtin_amdgcn_fence(__ATOMIC_ACQUIRE, "agent");
            asm volatile("s_waitcnt vmcnt(0)" ::: "memory");
        }
    }
    __syncthreads();
}

__device__ __forceinline__ f32x4 meta_mm(const bf16_t* X, int ldx, const bf16_t* Wt, int K, int n0, int lane, int kb, int ke) {
    const bf16_t* ap = X + (size_t)(PADR + (lane & 15)) * ldx + 8 * (lane >> 4);
    const bf16_t* bp = Wt + (size_t)(n0 + (lane & 15)) * K + 8 * (lane >> 4);
    f32x4 acc = {0.f, 0.f, 0.f, 0.f};
#pragma unroll 4
    for (int k = kb; k < ke; k += 32) { const bf16x8 a = *(const bf16x8*)(ap + k), b = *(const bf16x8*)(bp + k); acc = __builtin_amdgcn_mfma_f32_16x16x32_bf16(a, b, acc, 0, 0, 0); }
    return acc;
}
template <int KIND>
__device__ __forceinline__ void meta_task(LAS unsigned char* lds, int wave, const bf16_t* X, int ldx, const bf16_t* Wt, int K, int n0, int lane, bf16_t* O, int ldc, const ssq_t* ssq_in, float* H, bf16_t* HB, ssq_t* ssq_out) {
    const int ks = K >> 3;
    f32x4 acc = meta_mm(X, ldx, Wt, K, n0, lane, wave * ks, (wave + 1) * ks);
    LAS f32x4* red = (LAS f32x4*)lds;
    red[wave * 64 + lane] = acc;
    __syncthreads();
    if (wave != 0) { __syncthreads(); return; }
#pragma unroll
    for (int w2 = 1; w2 < 8; ++w2) acc += red[w2 * 64 + lane];
    const int c = n0 + (lane & 15);
#pragma unroll
    for (int i = 0; i < 4; ++i) {
        const int r = PADR + 4 * (lane >> 4) + i;
        if (KIND == 0) {
            const float rs = ssq_rs(ssq_in + r);
            const bf16_t v = (bf16_t)f2bf(acc[i] * rs);
#pragma unroll
            for (int b = 0; b < NBATCH; ++b) O[(size_t)(b * LP + r) * ldc + c] = v;
        } else if (KIND == 1) {
            const float hv = bf2f((unsigned short)f2bf(bf2f(HB[(size_t)r * DM + c]) + acc[i]));
            float ss = hv * hv; ss += __shfl_xor(ss, 1); ss += __shfl_xor(ss, 2); ss += __shfl_xor(ss, 4); ss += __shfl_xor(ss, 8);
#pragma unroll
            for (int b = 0; b < NBATCH; ++b) { HB[(size_t)(b * LP + r) * DM + c] = (bf16_t)f2bf(hv); if ((lane & 15) == 0 && ssq_out) atomicAdd(ssq_out + b * LP + r, ssq_fix(ss)); }
        } else {
            const float rs = ssq_rs(ssq_in + r);
            const float v = acc[i] * rs, up = __shfl_xor(v, 4);
            if ((c & 4) == 0) O[(size_t)r * DFF + ((c >> 3) << 2) + (c & 3)] = (bf16_t)f2bf(v / (1.0f + __expf(-v)) * up);
        }
    }
    __syncthreads();
}
__device__ __forceinline__ void zero_pad_rows(bf16_t* B, int pitch, int gw, int NGW, int lane) {
    for (int r = gw; r < NBATCH * PADR; r += NGW) { u32x4* rp = (u32x4*)(B + (size_t)((r / PADR) * LP + (r % PADR)) * pitch);
        for (int j = lane; j < pitch / 8; j += 64) rp[j] = (u32x4){0u, 0u, 0u, 0u}; }
}
#ifndef REP3
#define REP3 1
#endif
#ifndef REP5
#define REP5 1
#endif
#ifndef REP10
#define REP10 1
#endif
#ifndef REP12
#define REP12 1
#endif
#ifndef REP0
#define REP0 1
#endif
#ifndef REP1
#define REP1 1
#endif
#ifndef REP2
#define REP2 1
#endif
#ifndef REP4
#define REP4 1
#endif
#ifndef REP6
#define REP6 1
#endif
#ifndef REP7
#define REP7 1
#endif
#ifndef REP8
#define REP8 1
#endif
#ifndef REP9
#define REP9 1
#endif
#ifndef REP11
#define REP11 1
#endif
__global__ void __launch_bounds__(NTHR, 2) mega_fwd(Params p) {
    extern __shared__ __attribute__((aligned(16))) unsigned char lds_raw[];
    LAS unsigned char* lds = (LAS unsigned char*)lds_raw;
    cg::grid_group grid = cg::this_grid();
    const int tid = threadIdx.x, lane = tid & 63, wave = __builtin_amdgcn_readfirstlane(tid >> 6);
    const int G = gridDim.x, gw = blockIdx.x * NW + wave, NGW = G * NW;
    unsigned char* ws = p.ws;
    unsigned* ctl = (unsigned*)(ws + WS_CTL);
    ssq_t* ssq = (ssq_t*)(ws + WS_SSQ);
    float* Fb = (float*)(ws + WS_F);
    float* H = (float*)(ws + WS_H);
    bf16_t* HB = (bf16_t*)(ws + WS_HB);
    bf16_t* QKV = (bf16_t*)(ws + WS_QKV);
    bf16_t* CAT = (bf16_t*)((unsigned char*)p.out + DO_CAT);
    float* STASH = (float*)((unsigned char*)p.out + DO_STASH);
    const int lo = p.ph_lo, hi_ph = p.ph_hi;
    volatile LAS unsigned* xst = (volatile LAS unsigned*)(lds + 131072 + 64);
    if (tid < 2) xst[tid] = 0u;
    __syncthreads();
    XcdBarrier xbar = xcd_barrier_post((unsigned*)(ws + WS_CTL + 16384), xst);
#ifndef PHMASK
#define PHMASK 0x3fff
#endif
#define IN(k) (((PHMASK >> (k)) & 1) && lo <= (k) && (k) < hi_ph)
#define SEAM(k) do { if (IN(k) && IN((k) + 1)) xcd_barrier(xbar); } while (0)
    if (p.ph_lo < 0) grid.sync();

    for (int rep = 0; rep < (IN(0) ? REP0 : 0); ++rep) {
        for (int i = blockIdx.x * NTHR + tid; i < 3 * MROWS; i += G * NTHR) ssq[MROWS + i] = 0ull;
        for (int row = gw; row < MROWS; row += NGW) {
            const int b = row / LP, pos = row % LP;
            f32x4 v[4]; float s = 0.f;
            if (pos < PADR) {
#pragma unroll
                for (int j = 0; j < 4; ++j) v[j] = (f32x4){0.f, 0.f, 0.f, 0.f};
            } else {
                const float* src = (pos < 256) ? (p.in[1] + (size_t)(pos - PADR) * DM) : (p.in[0] + ((size_t)b * SEQ + (pos - 256)) * DM);
#pragma unroll
                for (int j = 0; j < 4; ++j) { v[j] = ((const f32x4*)src)[lane + 64 * j]; s += (v[j][0] * v[j][0] + v[j][1] * v[j][1]) + (v[j][2] * v[j][2] + v[j][3] * v[j][3]); }
            }
            s = wave_sum(s);
#pragma unroll
            for (int j = 0; j < 4; ++j) {
                u32x2 w; w.x = pk2(v[j][0], v[j][1]); w.y = pk2(v[j][2], v[j][3]); ((u32x2*)(HB + (size_t)row * DM))[lane + 64 * j] = w; }
            if (lane == 0) ssq[row] = ssq_fix(s);
        }
        {
            LAS float* scr = (LAS float*)(lds + wave * 16384);
            const float* nmg = p.in[2]; const float* nfg = p.in[3];
            constexpr int I0 = 16 * 96, I1 = 16 * 32, I2 = 16 * 176, I3 = 44 * 32, I4 = 16 * 65, I5 = 8 * 16, I6 = 16 * 32, I7 = 16 * 176, I8 = 44 * 32;
            constexpr int NIT = I0 + I1 + I2 + I3 + I4 + I5 + I6 + I7 + I8;
            for (int it = gw; it < NIT; it += NGW) {
                int r = it;
                if (r < I0) { transpose_item(p.in[5], 1024, 3072, nmg, (bf16_t*)(ws + WS_W0IN), 1, scr, r, lane); continue; } r -= I0;
                if (r < I1) { transpose_item(p.in[6], 1024, 1024, nullptr, (bf16_t*)(ws + WS_W0OUT), 0, scr, r, lane); continue; } r -= I1;
                if (r < I2) { transpose_item(p.in[25], 1024, 5632, nfg, (bf16_t*)(ws + WS_WGU0), 3, scr, r, lane); continue; } r -= I2;
                if (r < I3) { transpose_item(p.in[26], 2816, 1024, nullptr, (bf16_t*)(ws + WS_WDN0), 0, scr, r, lane); continue; } r -= I3;
                if (r < I4) { transpose_item(p.in[12], 1024, 2056, nmg + 1024, (bf16_t*)(ws + WS_W1IN), 2, scr, r, lane); continue; } r -= I4;
                if (r < I5) { transpose_item(p.in[23], 512, 512, nullptr, (bf16_t*)(ws + WS_WGLU), 0, scr, r, lane); continue; } r -= I5;
                if (r < I6) { transpose_item(p.in[13], 1024, 1024, nullptr, (bf16_t*)(ws + WS_W1OUT), 0, scr, r, lane); continue; } r -= I6;
                if (r < I7) { transpose_item(p.in[25] + (size_t)1024 * 5632, 1024, 5632, nfg + 1024, (bf16_t*)(ws + WS_WGU1), 3, scr, r, lane); continue; } r -= I7;
                transpose_item(p.in[26] + (size_t)2816 * 1024, 2816, 1024, nullptr, (bf16_t*)(ws + WS_WDN1), 0, scr, r, lane);
            }
        }
        for (int idx = blockIdx.x * NTHR + tid; idx < 2048 * 16; idx += G * NTHR) {
            const int i = idx >> 4, h = idx & 15, g = i >> 6;
            const float lre = p.in[15][i], lim = p.in[16][i], dt = expf(p.in[17][g]);
            const float mag = expf(lre * dt), are = mag * cosf(lim * dt), aim = mag * sinf(lim * dt), den = lre * lre + lim * lim;
            const float gre = ((are - 1.0f) * lre + aim * lim) / den, gim = (aim * lre - (are - 1.0f) * lim) / den;
            if (h == 0) { float* ap = (float*)(ws + WS_S5A); ap[i] = are; ap[2048 + i] = aim; }
            float* bbr = (float*)(ws + WS_S5BB); float* bbi = bbr + 2048 * 16;
            bf16_t* bt = (bf16_t*)(ws + WS_S5BT) + ((size_t)g * 128 + (i & 63)) * 16;
            const float br = p.in[18][i * 16 + h], bi = p.in[19][i * 16 + h]; const float vr = gre * br - gim * bi, vi = gre * bi + gim * br;
            bbr[i * 16 + h] = vr; bbi[i * 16 + h] = vi; bt[h] = (bf16_t)f2bf(vr); bt[64 * 16 + h] = (bf16_t)f2bf(vi);
        }
        for (int i = blockIdx.x * NTHR + tid; i < 32 * 16 * 128; i += G * NTHR) {
            const int pp = i & 127, gh = i >> 7;
            const float v = (pp < 64) ? p.in[20][gh * 64 + pp] : -p.in[21][gh * 64 + (pp - 64)];
            ((bf16_t*)(ws + WS_S5CT))[i] = (bf16_t)f2bf(v);
        }
        for (int i = blockIdx.x * NTHR + tid; i < 8 * 1024; i += G * NTHR) {
            const int j = i >> 10, k = i & 1023;
            ((float*)(ws + WS_W1F))[i] = p.in[12][(size_t)k * 2056 + 1536 + j] * p.in[2][1024 + k];
        }
    }
    SEAM(0);

    for (int rep = 0; rep < (IN(1) ? REP1 : 0); ++rep) {
        pg8::Gemm g{HB, (const bf16_t*)(ws + WS_W0IN), MROWS, 3072, 1024}; pg8::StaticOrder S; S.init(NBATCH * SEQ, 3072, G, (int)blockIdx.x);
        pg8::EpiScaleBf16 E{QKV, 3072, ssq};
        pg8::gemm_phase<pg8::EpiScaleBf16, pg8::StaticOrder, true, true>(lds, g, S, E);
        if (rep == 0) { zero_pad_rows(QKV, 3072, gw, NGW, lane);
            for (int t = blockIdx.x; t < 3072 / 16; t += G) meta_task<0>(lds, wave, HB, DM, (const bf16_t*)(ws + WS_W0IN), 1024, 16 * t, lane, QKV, 3072, ssq, nullptr, nullptr, nullptr); }
    }
    SEAM(1);

    for (int rep = 0; rep < (IN(2) ? REP2 : 0); ++rep) {
        float lam;
        { const float a1 = wave_sum(p.in[7][lane] * p.in[8][lane]), a2 = wave_sum(p.in[9][lane] * p.in[10][lane]); lam = expf(a1) - expf(a2) + 0.2f; }
        constexpr int NDIFF = 16 * 33, NSB = 32 * 33;
        LAS int* misc = (LAS int*)(lds + att::L_MISC);
        for (;;) {
            if (tid == 0) misc[0] = (int)atomicAdd(ctl + rep, 1u);
            __syncthreads();
            int idx = misc[0];
            __syncthreads();
#ifdef REP2_DIFF_ONLY
            if (rep > 0 && idx >= NDIFF) break;
#endif
#ifdef REP2_SB_ONLY
            if (rep > 0) idx += NDIFF;
#endif
            if (idx >= NDIFF + NSB) break;
            if (idx < NDIFF) {
#ifndef NO_DIFF
                const int u = 32 - idx / 16, bh = idx % 16, b = bh >> 2, hd = bh & 3;
                const int r32 = lane & 31, hi = lane >> 5;
                f32x4* st = (f32x4*)(STASH + ((size_t)blockIdx.x * NTHR + tid) * 64);
#pragma unroll 1
                for (int comp = 0; comp < 2; ++comp) {
                    att::Args a{QKV, 3072, b * LP, u, 1536 + hd * 128 + comp * 64, 2048 + hd * 128 + comp * 64, 2560 + hd * 128, nullptr, 0.f};
                    f32x16 o[4]; float l;
                    att::run<1, 4, false>(lds, a, o, l);
                    const float inv = (l > 0.f) ? 1.0f / l : 0.f;
                    if (comp == 0) {
#pragma unroll
                        for (int c = 0; c < 4; ++c)
#pragma unroll
                            for (int g4 = 0; g4 < 4; ++g4) st[c * 4 + g4] = (f32x4){o[c][4 * g4] * inv, o[c][4 * g4 + 1] * inv, o[c][4 * g4 + 2] * inv, o[c][4 * g4 + 3] * inv};
                    } else {
                        float ss = 0.f;
#pragma unroll
                        for (int c = 0; c < 4; ++c)
#pragma unroll
                            for (int g4 = 0; g4 < 4; ++g4) { const f32x4 sv = st[c * 4 + g4];
#pragma unroll
                                for (int e = 0; e < 4; ++e) { const float v = sv[e] - lam * (o[c][4 * g4 + e] * inv); o[c][4 * g4 + e] = v; ss += v * v; } }
                        ss += __shfl_xor(ss, 32);
                        const float rs = 0.8f * rsqrtf(ss * (1.0f / 128.0f) + RMS_EPS);
                        const float* sg = p.in[11];
                        bf16_t* op = CAT + (size_t)(b * LP + 256 * u + 32 * wave + r32) * DM + 512 + hd * 128;
#pragma unroll
                        for (int c = 0; c < 4; ++c)
#pragma unroll
                            for (int g4 = 0; g4 < 4; ++g4) { const int dv = 32 * c + 8 * g4 + 4 * hi; const f32x4 gv = *(const f32x4*)(sg + dv);
                                u32x2 w; w.x = pk2(o[c][4 * g4] * rs * gv[0], o[c][4 * g4 + 1] * rs * gv[1]); w.y = pk2(o[c][4 * g4 + 2] * rs * gv[2], o[c][4 * g4 + 3] * rs * gv[3]);
                                *(u32x2*)(op + dv) = w; }
                    }
                }
#endif
            } else {
#ifndef NO_SB
                const int i2 = idx - NDIFF, u = 32 - i2 / 32, bh = i2 % 32, b = bh >> 3, h = bh & 7;
                const int r32 = lane & 31, hi = lane >> 5;
                att::Args a{QKV, 3072, b * LP, u, h * 64, 512 + h * 64, 1024 + h * 64, nullptr, 0.f};
                f32x16 o[2]; float l;
                att::run<0, 2, false>(lds, a, o, l);
                bf16_t* op = CAT + (size_t)(b * LP + 256 * u + 32 * wave + r32) * DM + h * 64;
#pragma unroll
                for (int c = 0; c < 2; ++c)
#pragma unroll
                    for (int g4 = 0; g4 < 4; ++g4) { const int dv = 32 * c + 8 * g4 + 4 * hi;
                        u32x2 w; w.x = pk2(o[c][4 * g4], o[c][4 * g4 + 1]); w.y = pk2(o[c][4 * g4 + 2], o[c][4 * g4 + 3]); *(u32x2*)(op + dv) = w; }
#endif
            }
        }
    }
    SEAM(2);

    if (IN(3)) {
        pg8::Gemm g{CAT, (const bf16_t*)(ws + WS_W0OUT), MROWS, 1024, 1024}; pg8::StaticOrder S; S.init(NBATCH * SEQ, 1024, G, (int)blockIdx.x);
        pg8::EpiResid<false> E{nullptr, HB, ssq + MROWS};
        pg8::gemm_phase<pg8::EpiResid<false>, pg8::StaticOrder, true, true>(lds, g, S, E);
        for (int t = blockIdx.x; t < 1024 / 16; t += G) meta_task<1>(lds, wave, CAT, DM, (const bf16_t*)(ws + WS_W0OUT), 1024, 16 * t, lane, nullptr, 0, nullptr, H, HB, ssq + MROWS);
    }
    SEAM(3);
    for (int rep = 0; rep < (IN(4) ? REP4 : 0); ++rep) {
        pg8::Gemm g{HB, (const bf16_t*)(ws + WS_WGU0), MROWS, 5632, 1024}; pg8::StaticOrder S; S.init(NBATCH * SEQ, 5632, G, (int)blockIdx.x);
        pg8::EpiSwiGLU E{QKV, ssq + MROWS};
        pg8::gemm_phase<pg8::EpiSwiGLU, pg8::StaticOrder, true, true>(lds, g, S, E);
        if (rep == 0) for (int t = blockIdx.x; t < 5632 / 16; t += G) meta_task<2>(lds, wave, HB, DM, (const bf16_t*)(ws + WS_WGU0), 1024, 16 * t, lane, QKV, 0, ssq + MROWS, nullptr, nullptr, nullptr);
    }
    SEAM(4);
    if (IN(5)) {
        pg8::Gemm g{QKV, (const bf16_t*)(ws + WS_WDN0), MROWS, 1024, 2816}; pg8::StaticOrder S; S.init(NBATCH * SEQ, 1024, G, (int)blockIdx.x);
        pg8::EpiResid<false> E{nullptr, HB, ssq + 2 * MROWS};
        pg8::gemm_phase<pg8::EpiResid<false>, pg8::StaticOrder, true, true>(lds, g, S, E);
        for (int t = blockIdx.x; t < 1024 / 16; t += G) meta_task<1>(lds, wave, QKV, DFF, (const bf16_t*)(ws + WS_WDN0), DFF, 16 * t, lane, nullptr, 0, nullptr, H, HB, ssq + 2 * MROWS);
    }
    SEAM(5);
    for (int rep = 0; rep < (IN(6) ? REP6 : 0); ++rep) {
        {
            pg8::Gemm g{HB, (const bf16_t*)(ws + WS_W1IN), MROWS, 2048, 1024}; pg8::StaticOrder S; S.init(NBATCH * SEQ, 2048, G, (int)blockIdx.x);
            pg8::EpiScaleBf16 E{QKV, 2048, ssq + 2 * MROWS};
            pg8::gemm_phase<pg8::EpiScaleBf16, pg8::StaticOrder, true, true>(lds, g, S, E);
        }
        if (rep == 0) { zero_pad_rows(QKV, 2048, gw, NGW, lane);
            for (int t = blockIdx.x; t < 2048 / 16; t += G) meta_task<0>(lds, wave, HB, DM, (const bf16_t*)(ws + WS_W1IN), 1024, 16 * t, lane, QKV, 2048, ssq + 2 * MROWS, nullptr, nullptr, nullptr); }
        const float* w1f = (const float*)(ws + WS_W1F);
        {
            u32x2 hw[4], hn[4];
            if (gw < MROWS) {
#pragma unroll
                for (int j = 0; j < 4; ++j) hw[j] = ((const u32x2*)(HB + (size_t)gw * DM))[lane + 64 * j];
            }
            for (int row = gw; row < MROWS; row += NGW) {
                const int b = row / LP, pos = row % LP;
                if (row + NGW < MROWS) {
#pragma unroll
                    for (int j = 0; j < 4; ++j) hn[j] = ((const u32x2*)(HB + (size_t)(row + NGW) * DM))[lane + 64 * j];
                }
                f32x4 v[4];
#pragma unroll
                for (int j = 0; j < 4; ++j) v[j] = (f32x4){bflo(hw[j].x), bfhi(hw[j].x), bflo(hw[j].y), bfhi(hw[j].y)};
                const float rs = ssq_rs(ssq + 2 * MROWS + row);
                float mine = 0.f;
#pragma unroll
                for (int hh = 0; hh < 8; ++hh) {
                    float d = 0.f;
#pragma unroll
                    for (int j = 0; j < 4; ++j) { const f32x4 wv = ((const f32x4*)(w1f + hh * 1024))[lane + 64 * j]; d += (v[j][0] * wv[0] + v[j][1] * wv[1]) + (v[j][2] * wv[2] + v[j][3] * wv[3]); }
                    d = wave_sum(d);
                    if (lane == hh) mine = d;
                }
                if (lane < 8) Fb[((size_t)b * 8 + lane) * LP + pos] = log_sigmoid_f(mine * rs + p.in[14][lane]);
#pragma unroll
                for (int j = 0; j < 4; ++j) hw[j] = hn[j];
            }
        }
    }
    SEAM(6);
    for (int rep = 0; rep < (IN(7) ? REP7 : 0); ++rep) {
        LAS float* sc = (LAS float*)lds;
        for (int chain = blockIdx.x; chain < (rep == 0 ? 32 : 0); chain += G) {
            float* Fc = Fb + (size_t)chain * LP;
            { float km = 0.f; const int cb = chain >> 3, ch = chain & 7;
              for (int j = 0; j < 17; ++j) { const int idx = tid * 17 + j; if (idx < LP) { const u32x4* kp = (const u32x4*)(QKV + ((size_t)cb * LP + idx) * 2048 + 512 + ch * 64); float s2 = 0.f;
#pragma unroll
                  for (int q4 = 0; q4 < 8; ++q4) { const u32x4 kv = kp[q4]; const float e0 = bflo(kv.x), e1 = bfhi(kv.x), e2 = bflo(kv.y), e3 = bfhi(kv.y), e4 = bflo(kv.z), e5 = bfhi(kv.z), e6 = bflo(kv.w), e7 = bfhi(kv.w);
                      s2 += (e0 * e0 + e1 * e1) + (e2 * e2 + e3 * e3) + (e4 * e4 + e5 * e5) + (e6 * e6 + e7 * e7); }
                  km = fmaxf(km, s2); } }
#pragma unroll
              for (int o2 = 32; o2 >= 1; o2 >>= 1) km = fmaxf(km, __shfl_xor(km, o2));
              if (lane == 0) sc[512 + wave] = km;
              __syncthreads();
              if (tid == 0) { float m8 = sc[512]; for (int w8 = 1; w8 < 8; ++w8) m8 = fmaxf(m8, sc[512 + w8]); ((float*)(ws + WS_CTL + 4096))[chain] = m8; }
              __syncthreads(); }
            float loc[17]; float run = 0.f;
#pragma unroll
            for (int j = 0; j < 17; ++j) { const int idx = tid * 17 + j; const float v = (idx < LP) ? Fc[idx] : 0.f; run += v; loc[j] = run; }
            sc[tid] = run;
            __syncthreads();
            for (int off = 1; off < NTHR; off <<= 1) { const float v = sc[tid] + ((tid >= off) ? sc[tid - off] : 0.f); __syncthreads(); sc[tid] = v; __syncthreads(); }
            const float base = sc[tid] - run;
#pragma unroll
            for (int j = 0; j < 17; ++j) { const int idx = tid * 17 + j; if (idx < LP) Fc[idx] = base + loc[j]; }
            __syncthreads();
        }
        __syncthreads();
        if (G > 64) { if (blockIdx.x >= 32) s5_run<false>(p, lds + wave * 16384, (blockIdx.x - 32) * NW + wave, (G - 32) * NW, 4 * 132 * 32, lane); }
        else s5_run<false>(p, lds + wave * 16384, gw, NGW, 4 * 132 * 32, lane);
    }
    SEAM(7);
    for (int rep = 0; rep < (IN(8) ? REP8 : 0); ++rep) {
        s5_run<true>(p, lds + wave * 16384, gw, NGW, 4 * 132 * 32, lane);
        __syncthreads();
        constexpr int NFOX = 32 * 33;
        LAS int* misc = (LAS int*)(lds + att::L_MISC);
        for (;;) {
            if (tid == 0) misc[0] = (int)atomicAdd(ctl + 64 + rep, 1u);
            __syncthreads();
            const int idx = misc[0];
            __syncthreads();
            if (idx >= NFOX) break;
            const int u = 32 - idx / 32, bh = idx % 32, b = bh >> 3, h = bh & 7;
            const int r32 = lane & 31, hi = lane >> 5;
            att::Args a{QKV, 2048, b * LP, u, h * 64, 512 + h * 64, 1024 + h * 64, Fb + (size_t)bh * LP, sqrtf(((const float*)(ws + WS_CTL + 4096))[bh])};
            f32x16 o[2]; float l;
            att::run<1, 2, true>(lds, a, o, l);
            const float inv = 1.0f / l;
            bf16_t* op = CAT + (size_t)(b * LP + 256 * u + 32 * wave + r32) * DM + h * 64;
#pragma unroll
            for (int c = 0; c < 2; ++c)
#pragma unroll
                for (int g4 = 0; g4 < 4; ++g4) { const int dv = 32 * c + 8 * g4 + 4 * hi;
                    u32x2 w; w.x = pk2(o[c][4 * g4] * inv, o[c][4 * g4 + 1] * inv); w.y = pk2(o[c][4 * g4 + 2] * inv, o[c][4 * g4 + 3] * inv); *(u32x2*)(op + dv) = w; }
        }
    }
    SEAM(8);
    for (int rep = 0; rep < (IN(9) ? REP9 : 0); ++rep) {
        pg8::Gemm g{(const bf16_t*)(ws + WS_Y), (const bf16_t*)(ws + WS_WGLU), MROWS, 512, 512}; pg8::StaticOrder S; S.init(NBATCH * SEQ, 512, G, (int)blockIdx.x);
        pg8::EpiGLU E{(const bf16_t*)(ws + WS_Y), p.in[24], CAT};
        pg8::gemm_phase<pg8::EpiGLU, pg8::StaticOrder, true, true>(lds, g, S, E);
    }
    SEAM(9);
    if (IN(10)) {
        pg8::Gemm g{CAT, (const bf16_t*)(ws + WS_W1OUT), MROWS, 1024, 1024}; pg8::StaticOrder S; S.init(NBATCH * SEQ, 1024, G, (int)blockIdx.x);
        pg8::EpiResid<false> E{nullptr, HB, ssq + 3 * MROWS};
        pg8::gemm_phase<pg8::EpiResid<false>, pg8::StaticOrder, true, true>(lds, g, S, E);
    }
    SEAM(10);
    for (int rep = 0; rep < (IN(11) ? REP11 : 0); ++rep) {
        pg8::Gemm g{HB, (const bf16_t*)(ws + WS_WGU1), MROWS, 5632, 1024}; pg8::StaticOrder S; S.init(NBATCH * SEQ, 5632, G, (int)blockIdx.x);
        pg8::EpiSwiGLU E{QKV, ssq + 3 * MROWS};
        pg8::gemm_phase<pg8::EpiSwiGLU, pg8::StaticOrder, true, true>(lds, g, S, E);
    }
    SEAM(11);
    if (IN(12)) {
        pg8::Gemm g{QKV, (const bf16_t*)(ws + WS_WDN1), MROWS, 1024, 2816}; pg8::StaticOrder S; S.init(NBATCH * SEQ, 1024, G, (int)blockIdx.x);
        pg8::EpiResid<true> E{H, HB, nullptr};
        pg8::gemm_phase<pg8::EpiResid<true>, pg8::StaticOrder, true, true>(lds, g, S, E);
    }
    SEAM(12);
#ifdef EXTRA_SYNCS
    for (int k = 0; k < EXTRA_SYNCS; ++k) xcd_barrier(xbar);
#endif
    if (IN(13)) {
        const float* fg = p.in[4];
        {
            f32x4 v[4], vn[4];
            if (gw < NBATCH * SEQ) { const size_t row0 = (size_t)(gw / SEQ) * LP + 256 + (gw % SEQ);
#pragma unroll
                for (int j = 0; j < 4; ++j) v[j] = ((const f32x4*)(H + row0 * DM))[lane + 64 * j]; }
            for (int r = gw; r < NBATCH * SEQ; r += NGW) {
                const int rn = r + NGW;
                if (rn < NBATCH * SEQ) { const size_t rown = (size_t)(rn / SEQ) * LP + 256 + (rn % SEQ);
#pragma unroll
                    for (int j = 0; j < 4; ++j) vn[j] = ((const f32x4*)(H + rown * DM))[lane + 64 * j]; }
                float s = 0.f;
#pragma unroll
                for (int j = 0; j < 4; ++j) s += (v[j][0] * v[j][0] + v[j][1] * v[j][1]) + (v[j][2] * v[j][2] + v[j][3] * v[j][3]);
                const float rs = rsqrtf(wave_sum(s) * (1.0f / 1024.0f) + RMS_EPS);
#pragma unroll
                for (int j = 0; j < 4; ++j) { const f32x4 gv = ((const f32x4*)fg)[lane + 64 * j]; ((f32x4*)(p.out + (size_t)r * DM))[lane + 64 * j] = v[j] * rs * gv; }
#pragma unroll
                for (int j = 0; j < 4; ++j) v[j] = vn[j];
            }
        }
    }
#undef IN
#undef SEAM
}

#ifndef N_LAUNCH_MODE
#define N_LAUNCH_MODE 1
#endif
extern "C" void kernel_launch(void* const* d_in, const int* in_sizes, int n_in, void* d_out, int out_size, void* d_ws, size_t ws_size, hipStream_t stream) {
    static int grid = 0;
    if (grid == 0) {
        if (n_in != 27 || ws_size < WS_END || out_size != NBATCH * SEQ * DM) { fprintf(stderr, "kernel_launch: unexpected shapes (n_in %d, ws %zu, out %d)\n", n_in, ws_size, out_size); grid = -1; return; }
        int dev = 0, cus = 0, per_cu = 0;
        (void)hipGetDevice(&dev); (void)hipDeviceGetAttribute(&cus, hipDeviceAttributeMultiprocessorCount, dev);
        if (hipFuncSetAttribute((const void*)mega_fwd, hipFuncAttributeMaxDynamicSharedMemorySize, LDS_BYTES) != hipSuccess) { fprintf(stderr, "kernel_launch: hipFuncSetAttribute failed\n"); grid = -1; return; }
        if (hipOccupancyMaxActiveBlocksPerMultiprocessor(&per_cu, (const void*)mega_fwd, NTHR, LDS_BYTES) != hipSuccess || per_cu < 1) { fprintf(stderr, "kernel_launch: occupancy query says %d\n", per_cu); per_cu = 1; }
        (void)hipGetLastError();
        grid = cus * 1;
        if (grid <= 0) grid = 256;
    }
    if (grid < 0) return;
    if (hipMemsetAsync((char*)d_ws + WS_CTL, 0, 65536, stream) != hipSuccess) { fprintf(stderr, "kernel_launch: memset of the control words failed\n"); return; }
    Params p{};
    for (int i = 0; i < 27; ++i) p.in[i] = (const float*)d_in[i];
    p.out = (float*)d_out; p.ws = (unsigned char*)d_ws;
#if N_LAUNCH_MODE == 1
    p.ph_lo = 0; p.ph_hi = 14;
    void* args[] = {&p};
    hipError_t e = hipLaunchCooperativeKernel((const void*)mega_fwd, dim3(grid), dim3(NTHR), args, LDS_BYTES, stream);
    if (e != hipSuccess) fprintf(stderr, "cooperative launch failed: %s (grid %d)\n", hipGetErrorString(e), grid);
#else
    for (int ph = 0; ph < 14; ++ph) { p.ph_lo = ph; p.ph_hi = ph + 1; hipLaunchKernelGGL(mega_fwd, dim3(grid), dim3(NTHR), LDS_BYTES, stream, p); }
#endif
}
```

```cpp
#include <hip/hip_runtime.h>
#include <hip/hip_cooperative_groups.h>
#include <cstdio>
#include <cstdint>
namespace cg = cooperative_groups;

#define LAS __attribute__((address_space(3)))
constexpr int DM = 1024, NBATCH = 4, SEQ = 8192, LP = 8448, PADR = 240, NMETA = 16, MROWS = NBATCH * LP;
constexpr int DFF = 2816, NW = 8, NTHR = 512;
constexpr float C2 = 0.125f * 1.4426950408889634f;
constexpr float LOG2E = 1.4426950408889634f;
constexpr float RMS_EPS = 1e-6f;
constexpr int LDS_BYTES = 147456;

constexpr size_t MiB = 1u << 20;
constexpr size_t WS_CTL = 0;
constexpr size_t WS_SSQ = 452 * MiB;
constexpr size_t WS_F = 2 * MiB;
constexpr size_t WS_S5A = 4 * MiB;
constexpr size_t WS_S5BB = 4 * MiB + 65536;
constexpr size_t WS_S5CT = 4 * MiB + 65536 + 262144;
constexpr size_t WS_W1F = 4 * MiB + 65536 + 262144 + 131072;
constexpr size_t WS_S5BT = 4 * MiB + 524288;
constexpr size_t WS_W0IN = 6 * MiB, WS_W0OUT = 12 * MiB, WS_WGU0 = 14 * MiB, WS_WDN0 = 25 * MiB, WS_W1IN = 31 * MiB, WS_WGLU = 35 * MiB, WS_W1OUT = 36 * MiB, WS_WGU1 = 38 * MiB, WS_WDN1 = 49 * MiB;
constexpr size_t WS_H = 56 * MiB;
constexpr size_t WS_HB = 188 * MiB;
constexpr size_t WS_QKV = 254 * MiB;
constexpr size_t WS_Y = 386 * MiB;
constexpr size_t WS_E = 419 * MiB;
constexpr size_t WS_END = 454 * MiB;
constexpr size_t DO_CAT = 0, DO_STASH = 66 * MiB;

typedef unsigned short bf16_t;
typedef short bf16x8 __attribute__((ext_vector_type(8)));
typedef float f32x4 __attribute__((ext_vector_type(4)));
typedef float f32x16 __attribute__((ext_vector_type(16)));
typedef unsigned u32x4 __attribute__((ext_vector_type(4)));
typedef unsigned u32x2 __attribute__((ext_vector_type(2)));
typedef short v4i16_t __attribute__((ext_vector_type(4)));

__device__ __forceinline__ unsigned f2bf(float f) { unsigned u = __builtin_bit_cast(unsigned, f); return (u + 0x7fffu + ((u >> 16) & 1u)) >> 16; }
__device__ __forceinline__ unsigned pk2(float lo, float hi) { return f2bf(lo) | (f2bf(hi) << 16); }
__device__ __forceinline__ float bf2f(unsigned short b) { return __builtin_bit_cast(float, (unsigned)b << 16); }
__device__ __forceinline__ float bflo(unsigned w) { return __builtin_bit_cast(float, w << 16); }
__device__ __forceinline__ float bfhi(unsigned w) { return __builtin_bit_cast(float, w & 0xffff0000u); }
__device__ __forceinline__ float wave_sum(float v) {
#pragma unroll
    for (int o = 32; o >= 1; o >>= 1) v += __shfl_xor(v, o);
    return v;
}
typedef unsigned long long ssq_t;
__device__ __forceinline__ ssq_t ssq_fix(float ss) { return (ssq_t)(ss * 16777216.0f + 0.5f); }
__device__ __forceinline__ float ssq_rs(const ssq_t* p) { const ssq_t v = __hip_atomic_load(p, __ATOMIC_RELAXED, __HIP_MEMORY_SCOPE_AGENT); return rsqrtf((float)v * (1.0f / (16777216.0f * 1024.0f)) + RMS_EPS); }
__device__ __forceinline__ float fexp2(float x) { return __builtin_amdgcn_exp2f(x); }
__device__ __forceinline__ float flog2(float x) { return __builtin_amdgcn_logf(x); }
namespace pg8 {
#define PG8_LAS __attribute__((address_space(3)))
typedef unsigned short bf16_t;
typedef short bf16x8 __attribute__((ext_vector_type(8)));
typedef float f32x4 __attribute__((ext_vector_type(4)));
typedef unsigned u32x4 __attribute__((ext_vector_type(4)));
constexpr int BM = 256, BK = 64, HALF = 128, HTB = HALF * BK * 2  , STAGE_BYTES = 8 * HTB, NXCD = 8, WGM = 8;

__host__ __device__ __forceinline__ int lds_byte(int r, int c) { const int st = (r >> 4) * 2 + (c >> 5), rr = r & 15, cc = c & 31, ob = rr * 64 + cc * 2; return st * 1024 + (ob ^ (((ob >> 9) & 1) << 5)); }
__host__ __device__ __forceinline__ void stage_rc(int b, int& R, int& C) { const int st = b / 1024, sb = b % 1024, swz = sb ^ (((sb >> 9) & 1) << 5); R = (st >> 1) * 16 + swz / 64; C = (st & 1) * 32 + (swz % 64) / 2; }
__host__ __device__ __forceinline__ int perm32(int rho) { const int n = rho >> 4, i = rho & 15; return 8 * (i >> 2) + 4 * n + (i & 3); }

struct Unit { int pm, pn; };
struct Gemm { const bf16_t* A; const bf16_t* Bt; int M, N, K; };

struct StaticOrder {
    int nM, nN, nwg, G, c;
    __host__ __device__ void init(int M, int N, int G_, int c_) { nM = M / BM; nN = N / BM; nwg = nM * nN; G = G_; c = c_; }
    __host__ __device__ bool next(int i, Unit& u) const {
        const long L = (long)i * G + c; if (L >= nwg) return false;
        int wgid = (int)L; { const int q = nwg / NXCD, r = nwg % NXCD, xcd = wgid % NXCD, off = wgid / NXCD; wgid = (xcd < r ? xcd * (q + 1) : r * (q + 1) + (xcd - r) * q) + off; }
        const int nig = WGM * nN, gid = wgid / nig, fm = gid * WGM, gsz = (nM - fm) < WGM ? (nM - fm) : WGM;
        u.pm = fm + ((wgid % nig) % gsz); u.pn = (wgid % nig) / gsz;
        u.pm = u.pm + (u.pm >> 5) + 1;
        return true;
    }
    __device__ __forceinline__ void a_ready(const Unit&) const {}
    __device__ __forceinline__ void done(const Unit&) const {}
};
__device__ __forceinline__ unsigned cvt_pk_bf16(float lo, float hi) { unsigned r; asm volatile("v_cvt_pk_bf16_f32 %0, %1, %2" : "=v"(r) : "v"(lo), "v"(hi)); return r; }
typedef float f32x2 __attribute__((ext_vector_type(2)));
struct EpiScaleBf16 {
    static constexpr bool PERM = true, AFTER_DRAIN = false;
    bf16_t* O; int ldc; const ssq_t* ssq;
    __device__ __forceinline__ void pre(const Unit& u, int wr, int fr, unsigned long long (&rsv)[8]) const {
#pragma unroll
        for (int ai = 0; ai < 2; ++ai)
#pragma unroll
            for (int m = 0; m < 4; ++m) rsv[ai * 4 + m] = __hip_atomic_load(ssq + u.pm * BM + ai * HALF + wr * 64 + m * 16 + fr, __ATOMIC_RELAXED, __HIP_MEMORY_SCOPE_AGENT);
    }
    __device__ __forceinline__ void operator()(const f32x4 (&acc)[2][2][4][2], const Unit& u, int wr, int wc, int fr, int fq, const unsigned long long (&rsv)[8]) const {
        const int col0 = u.pn * BM + wc * 32 + 8 * fq;
#pragma unroll
        for (int ai = 0; ai < 2; ++ai)
#pragma unroll
            for (int m = 0; m < 4; ++m) {
                const int row = u.pm * BM + ai * HALF + wr * 64 + m * 16 + fr;
                const float rs = rsqrtf((float)rsv[ai * 4 + m] * (1.0f / (16777216.0f * 1024.0f)) + 1e-6f);
                bf16_t* rowp = O + (size_t)row * ldc + col0;
#pragma unroll
                for (int bj = 0; bj < 2; ++bj) { const f32x4 v0 = acc[ai][bj][m][0] * rs, v1 = acc[ai][bj][m][1] * rs;
                    u32x4 w; w.x = cvt_pk_bf16(v0[0], v0[1]); w.y = cvt_pk_bf16(v0[2], v0[3]); w.z = cvt_pk_bf16(v1[0], v1[1]); w.w = cvt_pk_bf16(v1[2], v1[3]);
                    *(u32x4*)(rowp + bj * HALF) = w; } }
    }
};
template <bool FINAL>
struct EpiResid {
    static constexpr bool PERM = true, AFTER_DRAIN = false;
    float* hf; bf16_t* hb; ssq_t* ssq;
    __device__ __forceinline__ void pre(const Unit&, int, int, unsigned long long (&)[8]) const {}
    __device__ __forceinline__ void operator()(const f32x4 (&acc)[2][2][4][2], const Unit& u, int wr, int wc, int fr, int fq, const unsigned long long (&rsv)[8]) const {
        const int col0 = u.pn * BM + wc * 32 + 8 * fq;
#pragma unroll
        for (int ai = 0; ai < 2; ++ai)
#pragma unroll
            for (int m = 0; m < 4; ++m) {
                const int row = u.pm * BM + ai * HALF + wr * 64 + m * 16 + fr;
                float ss = 0.f;
#pragma unroll
                for (int bj = 0; bj < 2; ++bj) {
                    bf16_t* bp = hb + (size_t)row * 1024 + col0 + bj * HALF;
                    const u32x4 hv = *(const u32x4*)bp;
                    f32x4 v0 = acc[ai][bj][m][0], v1 = acc[ai][bj][m][1];
                    v0[0] += __builtin_bit_cast(float, hv.x << 16); v0[1] += __builtin_bit_cast(float, hv.x & 0xffff0000u); v0[2] += __builtin_bit_cast(float, hv.y << 16); v0[3] += __builtin_bit_cast(float, hv.y & 0xffff0000u);
                    v1[0] += __builtin_bit_cast(float, hv.z << 16); v1[1] += __builtin_bit_cast(float, hv.z & 0xffff0000u); v1[2] += __builtin_bit_cast(float, hv.w << 16); v1[3] += __builtin_bit_cast(float, hv.w & 0xffff0000u);
                    if (FINAL) { float* hp = hf + (size_t)row * 1024 + col0 + bj * HALF; *(f32x4*)hp = v0; *(f32x4*)(hp + 4) = v1; }
                    else {
                        u32x4 w; w.x = cvt_pk_bf16(v0[0], v0[1]); w.y = cvt_pk_bf16(v0[2], v0[3]); w.z = cvt_pk_bf16(v1[0], v1[1]); w.w = cvt_pk_bf16(v1[2], v1[3]);
                        *(u32x4*)bp = w;
                        const float r0 = __builtin_bit_cast(float, w.x << 16), r1 = __builtin_bit_cast(float, w.x & 0xffff0000u), r2 = __builtin_bit_cast(float, w.y << 16), r3 = __builtin_bit_cast(float, w.y & 0xffff0000u);
                        const float r4 = __builtin_bit_cast(float, w.z << 16), r5 = __builtin_bit_cast(float, w.z & 0xffff0000u), r6 = __builtin_bit_cast(float, w.w << 16), r7 = __builtin_bit_cast(float, w.w & 0xffff0000u);
                        ss += (r0 * r0 + r1 * r1) + (r2 * r2 + r3 * r3) + (r4 * r4 + r5 * r5) + (r6 * r6 + r7 * r7);
                    }
                }
                if (!FINAL) { ss += __shfl_xor(ss, 16); ss += __shfl_xor(ss, 32); if (fq == 0) atomicAdd(ssq + row, ssq_fix(ss)); }
            }
    }
};
struct EpiSwiGLU {
    static constexpr bool PERM = true, AFTER_DRAIN = false;
    bf16_t* O; const ssq_t* ssq;
    __device__ __forceinline__ void pre(const Unit& u, int wr, int fr, unsigned long long (&rsv)[8]) const {
#pragma unroll
        for (int ai = 0; ai < 2; ++ai)
#pragma unroll
            for (int m = 0; m < 4; ++m) rsv[ai * 4 + m] = __hip_atomic_load(ssq + u.pm * BM + ai * HALF + wr * 64 + m * 16 + fr, __ATOMIC_RELAXED, __HIP_MEMORY_SCOPE_AGENT);
    }
    __device__ __forceinline__ void operator()(const f32x4 (&acc)[2][2][4][2], const Unit& u, int wr, int wc, int fr, int fq, const unsigned long long (&rsv)[8]) const {
        const int col0 = u.pn * BM + wc * 32 + 8 * fq;
#pragma unroll
        for (int ai = 0; ai < 2; ++ai)
#pragma unroll
            for (int m = 0; m < 4; ++m) {
                const int row = u.pm * BM + ai * HALF + wr * 64 + m * 16 + fr;
                const float rs = rsqrtf((float)rsv[ai * 4 + m] * (1.0f / (16777216.0f * 1024.0f)) + 1e-6f);
#pragma unroll
                for (int bj = 0; bj < 2; ++bj) { const f32x4 g = acc[ai][bj][m][0] * rs, up = acc[ai][bj][m][1] * rs; float a[4];
#pragma unroll
                    for (int e = 0; e < 4; ++e) a[e] = g[e] * __builtin_amdgcn_rcpf(1.0f + __builtin_amdgcn_exp2f(-1.4426950408889634f * g[e])) * up[e];
                    u32x2 w; w.x = cvt_pk_bf16(a[0], a[1]); w.y = cvt_pk_bf16(a[2], a[3]);
                    *(u32x2*)(O + (size_t)row * 2816 + ((col0 + bj * HALF) >> 1)) = w; } }
    }
};
struct EpiGLU {
    static constexpr bool PERM = true, AFTER_DRAIN = false;
    const bf16_t* Y; const float* bias; bf16_t* O;
    __device__ __forceinline__ void pre(const Unit&, int, int, unsigned long long (&)[8]) const {}
    __device__ __forceinline__ void operator()(const f32x4 (&acc)[2][2][4][2], const Unit& u, int wr, int wc, int fr, int fq, const unsigned long long (&rsv)[8]) const {
        const int col0 = u.pn * BM + wc * 32 + 8 * fq;
#pragma unroll
        for (int ai = 0; ai < 2; ++ai)
#pragma unroll
            for (int m = 0; m < 4; ++m) {
                const int row = u.pm * BM + ai * HALF + wr * 64 + m * 16 + fr;
#pragma unroll
                for (int bj = 0; bj < 2; ++bj) { const int col = col0 + bj * HALF;
                    const u32x4 yv = *(const u32x4*)(Y + (size_t)row * 512 + col);
                    const f32x4 b0 = *(const f32x4*)(bias + col), b1 = *(const f32x4*)(bias + col + 4);
                    const f32x4 z0 = acc[ai][bj][m][0] + b0, z1 = acc[ai][bj][m][1] + b1; float o[8];
                    const float yy[8] = {__builtin_bit_cast(float, yv.x << 16), __builtin_bit_cast(float, yv.x & 0xffff0000u), __builtin_bit_cast(float, yv.y << 16), __builtin_bit_cast(float, yv.y & 0xffff0000u),
                                         __builtin_bit_cast(float, yv.z << 16), __builtin_bit_cast(float, yv.z & 0xffff0000u), __builtin_bit_cast(float, yv.w << 16), __builtin_bit_cast(float, yv.w & 0xffff0000u)};
#pragma unroll
                    for (int e = 0; e < 4; ++e) { o[e] = yy[e] * __builtin_amdgcn_rcpf(1.0f + __builtin_amdgcn_exp2f(-1.4426950408889634f * z0[e])); o[4 + e] = yy[4 + e] * __builtin_amdgcn_rcpf(1.0f + __builtin_amdgcn_exp2f(-1.4426950408889634f * z1[e])); }
                    u32x4 w; w.x = cvt_pk_bf16(o[0], o[1]); w.y = cvt_pk_bf16(o[2], o[3]); w.z = cvt_pk_bf16(o[4], o[5]); w.w = cvt_pk_bf16(o[6], o[7]);
                    *(u32x4*)(O + (size_t)row * 1024 + 512 + col) = w; } }
    }
};
template <class Epi, class Sched, bool ALIGN_EPI = false, bool SP2 = false>
__device__ __forceinline__ void gemm_phase(PG8_LAS unsigned char* lds, const Gemm g, const Sched& S, const Epi& E) {
    int tid_l = threadIdx.x; asm volatile("" : "+v"(tid_l));
    const int tid = tid_l, wid = __builtin_amdgcn_readfirstlane(tid >> 6), lane = tid & 63, wr = wid >> 2, wc = wid & 3, fr = lane & 15, fq = lane >> 4;
    const int K = g.K, nt = K / BK;
    unsigned voffA[2], voffB[2];
#pragma unroll
    for (int i = 0; i < 2; ++i) { int R, C; stage_rc(tid * 16 + i * 8192, R, C); const int Rb = Epi::PERM ? ((R & ~31) + perm32(R & 31)) : R;
        voffA[i] = (unsigned)(R * K + C) * 2u; voffB[i] = (unsigned)(Rb * K + C) * 2u; }
    const size_t kstep = (size_t)(BK * 2);
    const size_t hstep = (size_t)HALF * K * 2;
    const size_t tstep = 2 * hstep;
    const unsigned ldsw = (unsigned)wid * 1024u;
    const int aoff = lds_byte(wr * 64 + fr, fq * 8), boff = lds_byte(wc * 32 + fr, fq * 8);
#define PG8_SA(b, h) (((b) * 2 + (h)) * HTB)
#define PG8_SB(b, h) ((4 + (b) * 2 + (h)) * HTB)
#define PG8_STAGE(bufoff, gbase, voff) do { _Pragma("unroll") for (int _i = 0; _i < 2; ++_i) \
        __builtin_amdgcn_global_load_lds((const unsigned*)((const char*)(gbase) + (voff)[_i]), (PG8_LAS unsigned*)(lds + (bufoff) + ldsw + _i * 8192), 16, 0, 0); } while (0)
#define PG8_LDA(dst, b, h) do { _Pragma("unroll") for (int m = 0; m < 4; ++m) _Pragma("unroll") for (int k = 0; k < 2; ++k) dst[m][k] = *(const PG8_LAS bf16x8*)(lds + PG8_SA(b, h) + aoff + m * 2048 + k * 1024); } while (0)
#define PG8_LDB(dst, b, h) do { _Pragma("unroll") for (int n = 0; n < 2; ++n) _Pragma("unroll") for (int k = 0; k < 2; ++k) dst[n][k] = *(const PG8_LAS bf16x8*)(lds + PG8_SB(b, h) + boff + n * 2048 + k * 1024); } while (0)
#define PG8_MMA(ai, bj, At, Bt) do { __builtin_amdgcn_s_setprio(1); _Pragma("unroll") for (int m = 0; m < 4; ++m) _Pragma("unroll") for (int n = 0; n < 2; ++n) _Pragma("unroll") for (int k = 0; k < 2; ++k) \
        acc[ai][bj][m][n] = __builtin_amdgcn_mfma_f32_16x16x32_bf16(Bt[n][k], At[m][k], acc[ai][bj][m][n], 0, 0, 0); __builtin_amdgcn_s_setprio(0); } while (0)
#define PG8_WAIT_V(n) asm volatile("s_waitcnt vmcnt(" #n ")" ::: "memory")
#define PG8_WAIT_L(n) asm volatile("s_waitcnt lgkmcnt(" #n ")" ::: "memory")
#define PG8_BAR __builtin_amdgcn_s_barrier()
#define PG8_SCHED __builtin_amdgcn_sched_barrier(0)
    Unit cur, nxt; int ui = 0;
    if (!S.next(0, cur)) return;
    f32x4 acc[2][2][4][2];
    unsigned long long rsv[8];
#pragma unroll
    for (int i_ = 0; i_ < 8; ++i_) rsv[i_] = 0ull;
#pragma unroll
    for (int a = 0; a < 2; ++a)
#pragma unroll
        for (int b = 0; b < 2; ++b)
#pragma unroll
            for (int m = 0; m < 4; ++m)
#pragma unroll
                for (int n = 0; n < 2; ++n) acc[a][b][m][n] = (f32x4){0.f, 0.f, 0.f, 0.f};
    bf16x8 At[4][2], B0[2][2], B1[2][2];
    const char* cA = (const char*)g.A + (size_t)cur.pm * tstep; const char* cB = (const char*)g.Bt + (size_t)cur.pn * tstep;
    S.a_ready(cur);
    if constexpr (SP2) {
        PG8_STAGE(PG8_SB(0, 0), cB, voffB); PG8_STAGE(PG8_SB(0, 1), cB + hstep, voffB); PG8_STAGE(PG8_SA(0, 0), cA, voffA); PG8_STAGE(PG8_SA(0, 1), cA + hstep, voffA);
        if (wr == 1) PG8_BAR;
        PG8_WAIT_V(2); PG8_BAR;
        PG8_STAGE(PG8_SB(1, 0), cB + kstep, voffB); PG8_STAGE(PG8_SA(1, 0), cA + kstep, voffA); PG8_STAGE(PG8_SB(1, 1), cB + hstep + kstep, voffB);
        PG8_WAIT_V(6); PG8_BAR;
    } else {
        PG8_STAGE(PG8_SB(0, 0), cB, voffB); PG8_STAGE(PG8_SA(0, 0), cA, voffA); PG8_STAGE(PG8_SB(0, 1), cB + hstep, voffB); PG8_STAGE(PG8_SA(0, 1), cA + hstep, voffA);
        if (wr == 1) PG8_BAR;
        PG8_WAIT_V(4); PG8_BAR;
        PG8_STAGE(PG8_SB(1, 0), cB + kstep, voffB); PG8_STAGE(PG8_SA(1, 0), cA + kstep, voffA); PG8_STAGE(PG8_SB(1, 1), cB + hstep + kstep, voffB);
        PG8_WAIT_V(6); PG8_BAR;
    }
    for (;;) {
        const bool has_next = S.next(ui + 1, nxt);
        const char* nA = has_next ? (const char*)g.A + (size_t)nxt.pm * tstep : cA; const char* nB = has_next ? (const char*)g.Bt + (size_t)nxt.pn * tstep : cB;
        for (int t = 0; t < nt; t += 2) {
            const bool last = (t == nt - 2);
            if (last) E.pre(cur, wr, fr, rsv);
            const char* a1 = cA + (size_t)(t + 1) * kstep;
            const char* a2 = last ? nA : cA + (size_t)(t + 2) * kstep; const char* b2 = last ? nB : cB + (size_t)(t + 2) * kstep;
            const char* a3 = a2 + kstep; const char* b3 = b2 + kstep;
            if (last && has_next) S.a_ready(nxt);
            if constexpr (SP2) {
            PG8_LDB(B0, 0, 0); PG8_LDB(B1, 0, 1); PG8_SCHED; PG8_LDA(At, 0, 0); PG8_STAGE(PG8_SA(1, 1), a1 + hstep, voffA);
            PG8_WAIT_V(8); PG8_WAIT_L(0); PG8_BAR; PG8_MMA(0, 0, At, B0); PG8_MMA(0, 1, At, B1); PG8_BAR; PG8_SCHED;
            PG8_LDA(At, 0, 1); PG8_STAGE(PG8_SB(0, 0), b2, voffB); PG8_STAGE(PG8_SB(0, 1), b2 + hstep, voffB); PG8_STAGE(PG8_SA(0, 0), a2, voffA);
            PG8_WAIT_V(8); PG8_WAIT_L(0); PG8_BAR; PG8_MMA(1, 0, At, B0); PG8_MMA(1, 1, At, B1); PG8_BAR; PG8_SCHED;
            PG8_LDB(B0, 1, 0); PG8_LDB(B1, 1, 1); PG8_SCHED; PG8_LDA(At, 1, 0); PG8_STAGE(PG8_SA(0, 1), a2 + hstep, voffA);
            PG8_WAIT_V(8); PG8_WAIT_L(0); PG8_BAR; PG8_MMA(0, 0, At, B0); PG8_MMA(0, 1, At, B1); PG8_BAR; PG8_SCHED;
            PG8_LDA(At, 1, 1); PG8_STAGE(PG8_SB(1, 0), b3, voffB); PG8_STAGE(PG8_SB(1, 1), b3 + hstep, voffB); PG8_STAGE(PG8_SA(1, 0), a3, voffA);
            PG8_WAIT_V(8); PG8_WAIT_L(0); PG8_BAR; PG8_MMA(1, 0, At, B0); PG8_MMA(1, 1, At, B1); PG8_BAR; PG8_SCHED;
            } else {
            PG8_LDB(B0, 0, 0); PG8_SCHED; PG8_LDA(At, 0, 0); PG8_STAGE(PG8_SA(1, 1), a1 + hstep, voffA);
            PG8_WAIT_L(8); PG8_BAR; PG8_WAIT_L(0); PG8_MMA(0, 0, At, B0); PG8_BAR; PG8_SCHED;
            PG8_LDB(B1, 0, 1); PG8_STAGE(PG8_SB(0, 0), b2, voffB);
            PG8_BAR; PG8_WAIT_L(0); PG8_MMA(0, 1, At, B1); PG8_BAR;
            PG8_LDA(At, 0, 1); PG8_STAGE(PG8_SA(0, 0), a2, voffA);
            PG8_BAR; PG8_WAIT_L(0); PG8_MMA(1, 0, At, B0); PG8_BAR; PG8_SCHED;
            PG8_STAGE(PG8_SB(0, 1), b2 + hstep, voffB);
            PG8_WAIT_V(6); PG8_BAR; PG8_MMA(1, 1, At, B1); PG8_BAR;
            PG8_LDB(B0, 1, 0); PG8_SCHED; PG8_LDA(At, 1, 0); PG8_STAGE(PG8_SA(0, 1), a2 + hstep, voffA);
            PG8_WAIT_L(8); PG8_BAR; PG8_WAIT_L(0); PG8_MMA(0, 0, At, B0); PG8_BAR; PG8_SCHED;
            PG8_LDB(B1, 1, 1); PG8_STAGE(PG8_SB(1, 0), b3, voffB);
            PG8_BAR; PG8_WAIT_L(0); PG8_MMA(0, 1, At, B1); PG8_BAR;
            PG8_LDA(At, 1, 1); PG8_STAGE(PG8_SA(1, 0), a3, voffA);
            PG8_BAR; PG8_WAIT_L(0); PG8_MMA(1, 0, At, B0); PG8_BAR; PG8_SCHED;
            PG8_STAGE(PG8_SB(1, 1), b3 + hstep, voffB);
            PG8_WAIT_V(6); PG8_BAR; PG8_MMA(1, 1, At, B1); PG8_BAR;
            }
        }
        if constexpr (ALIGN_EPI) { if (wr == 0) PG8_BAR; }
        if constexpr (!Epi::AFTER_DRAIN) { E(acc, cur, wr, wc, fr, fq, rsv); S.done(cur); }
        if (!has_next) break;
#pragma unroll
        for (int a = 0; a < 2; ++a)
#pragma unroll
            for (int b = 0; b < 2; ++b)
#pragma unroll
                for (int m = 0; m < 4; ++m)
#pragma unroll
                    for (int n = 0; n < 2; ++n) acc[a][b][m][n] = (f32x4){0.f, 0.f, 0.f, 0.f};
        cur = nxt; cA = nA; cB = nB; ++ui;
        if constexpr (ALIGN_EPI) { if (wr == 1) PG8_BAR; }
    }
    PG8_WAIT_V(0);
    if constexpr (!ALIGN_EPI) { if (wr == 0) PG8_BAR; }
    PG8_BAR;
    if constexpr (Epi::AFTER_DRAIN) { E.fused(acc, cur, wr, wc, fr, fq, lds, wid, lane); S.done(cur); }
#undef PG8_SA
#undef PG8_SB
#undef PG8_STAGE
#undef PG8_LDA
#undef PG8_LDB
#undef PG8_MMA
#undef PG8_WAIT_V
#undef PG8_WAIT_L
#undef PG8_BAR
#undef PG8_SCHED
}
}
namespace att {
constexpr int KROW = 144, KBUF = 64 * KROW;
constexpr int VBUF = 16384;
constexpr int L_K = 0, L_V = 2 * KBUF, L_BIAS = L_V + 3 * VBUF, L_FLAG = L_BIAS + 2 * 64 * 4, L_MISC = L_FLAG + 64, L_END = L_MISC + 64;
__device__ __forceinline__ int crow(int r, int hi) { return (r & 3) + 8 * (r >> 2) + 4 * hi; }
__device__ __forceinline__ unsigned cvtpk(float lo, float hi) { unsigned r; asm volatile("v_cvt_pk_bf16_f32 %0, %1, %2" : "=v"(r) : "v"(lo), "v"(hi)); return r; }

struct Args { const bf16_t* qkv; int pitch; int rowb; int u; int qcol, kcol, vcol; const float* F; float kmax; };


template <bool MASKED>
__device__ __forceinline__ void sb_tile(f32x16 (&x)[2], float& carry, int tlo, int hi, int qpos) {
#pragma unroll
                for (int xt = 1; xt >= 0; --xt) {
                    float lm[16], G[4], Gp[4];
#pragma unroll
                    for (int r = 0; r < 16; ++r) {
                        const float z = x[xt][r], sp = fmaxf(z, 0.f) + flog2(1.0f + fexp2(-fabsf(z)));
                        bool valid = true;
                        if (MASKED) { const int kvp = tlo + 32 * xt + crow(r, hi); valid = (kvp < qpos) && (kvp >= PADR); }
                        lm[r] = valid ? -sp : 0.f;
                        x[xt][r] = valid ? (z - sp) : -1e30f;
                    }
#pragma unroll
                    for (int g = 0; g < 4; ++g) { G[g] = (lm[4 * g] + lm[4 * g + 1]) + (lm[4 * g + 2] + lm[4 * g + 3]); Gp[g] = __shfl_xor(G[g], 32); }
                    float runv = carry;
#pragma unroll
                    for (int g = 3; g >= 0; --g) {
                        const float g1 = hi ? G[g] : Gp[g], g0 = hi ? Gp[g] : G[g];
                        const float sg = hi ? runv : (runv + g1);
                        const float c3 = sg, c2 = c3 + lm[4 * g + 3], c1 = c2 + lm[4 * g + 2], c0 = c1 + lm[4 * g + 1];
                        x[xt][4 * g + 3] = fexp2(x[xt][4 * g + 3] + c3); x[xt][4 * g + 2] = fexp2(x[xt][4 * g + 2] + c2);
                        x[xt][4 * g + 1] = fexp2(x[xt][4 * g + 1] + c1); x[xt][4 * g] = fexp2(x[xt][4 * g] + c0);
                        runv = runv + (g1 + g0);
                    }
                    carry = runv;
                }
}
template <int MODE, int NDV, bool BIAS>
__device__ __forceinline__ void tile_compute(LAS unsigned char* lds, int kt, int buf, int vs, const bf16x8 (&qf)[4], f32x16 (&o)[NDV],
                                             float& mrun, float& lrun, float& carry, f32x16& negm, f32x16& osum, bool wdone, bool& pend, int& vsp, int w, int lane, int r32, int hi, int qmin, int qpos, unsigned vlane) {
#define ATT_PV(VS_) do { const unsigned vba = (unsigned)(uintptr_t)(lds + L_V + (VS_) * VBUF + vlane);     \
        _Pragma("unroll") for (int ks = 0; ks < 4; ++ks) { \
            v4i16_t lo_[NDV], hh_[NDV]; \
            _Pragma("unroll") for (int c = 0; c < NDV; ++c) { \
                asm volatile("ds_read_b64_tr_b16 %0, %1 offset:%c2" : "=&v"(lo_[c]) : "v"(vba), "i"((2 * ks) * (NDV * 512) + 512 * c) : "memory"); \
                asm volatile("ds_read_b64_tr_b16 %0, %1 offset:%c2" : "=&v"(hh_[c]) : "v"(vba), "i"((2 * ks + 1) * (NDV * 512) + 512 * c) : "memory"); } \
            if (NDV == 4) asm volatile("s_waitcnt lgkmcnt(0)" : "+v"(lo_[0]), "+v"(hh_[0]), "+v"(lo_[1]), "+v"(hh_[1]), "+v"(lo_[2 % NDV]), "+v"(hh_[2 % NDV]), "+v"(lo_[3 % NDV]), "+v"(hh_[3 % NDV]) :: "memory");     \
            else asm volatile("s_waitcnt lgkmcnt(0)" : "+v"(lo_[0]), "+v"(hh_[0]), "+v"(lo_[1]), "+v"(hh_[1]) :: "memory"); \
            bf16x8 pb; { u32x4 t4 = {pk[ks][0], pk[ks][1], pk[ks][2], pk[ks][3]}; pb = __builtin_bit_cast(bf16x8, t4); } \
            _Pragma("unroll") for (int c = 0; c < NDV; ++c) { \
                const bf16x8 va = {lo_[c][0], lo_[c][1], lo_[c][2], lo_[c][3], hh_[c][0], hh_[c][1], hh_[c][2], hh_[c][3]}; \
                o[c] = __builtin_amdgcn_mfma_f32_32x32x16_bf16(va, pb, o[c], 0, 0, 0); } } } while (0)
        const int tlo = 64 * kt;
        const bool skip = wdone || ((MODE == 0) ? (tlo >= qmin + 31) : (tlo > qmin + 31));
        if (!skip) {
            unsigned pk[4][4];
            const bool needmask = (kt == 3) || ((MODE == 0) ? (tlo + 63 >= qmin) : (tlo + 63 > qmin));
            const LAS unsigned char* kb = lds + L_K + buf * KBUF + r32 * KROW + 16 * hi;
            f32x16 x[2];
#pragma unroll
            for (int xt = 0; xt < 2; ++xt) {
                if (BIAS) {
                    const LAS float* bp = (const LAS float*)(lds + L_BIAS + buf * 256) + 32 * xt + 4 * hi;
#pragma unroll
                    for (int g = 0; g < 4; ++g) { const f32x4 bv = *(const LAS f32x4*)(bp + 8 * g); x[xt][4 * g] = bv[0]; x[xt][4 * g + 1] = bv[1]; x[xt][4 * g + 2] = bv[2]; x[xt][4 * g + 3] = bv[3]; }
                } else if (MODE == 0) {
#pragma unroll
                    for (int r = 0; r < 16; ++r) x[xt][r] = 0.f;
                }
#pragma unroll
                for (int d0 = 0; d0 < 4; ++d0) { const bf16x8 kf = *(const LAS bf16x8*)(kb + xt * 32 * KROW + 32 * d0);
                    if (MODE == 1 && !BIAS && d0 == 0) x[xt] = __builtin_amdgcn_mfma_f32_32x32x16_bf16(kf, qf[d0], negm, 0, 0, 0);
                    else x[xt] = __builtin_amdgcn_mfma_f32_32x32x16_bf16(kf, qf[d0], x[xt], 0, 0, 0); }
            }
            if (MODE == 1) {
                if (needmask) {
#pragma unroll
                    for (int xt = 0; xt < 2; ++xt)
#pragma unroll
                        for (int r = 0; r < 16; ++r) { const int kvp = tlo + 32 * xt + crow(r, hi); if (kvp > qpos || kvp < PADR) x[xt][r] = -1e30f; }
                }
                float mx = x[0][0];
#pragma unroll
                for (int r = 1; r < 16; ++r) mx = fmaxf(mx, x[0][r]);
#pragma unroll
                for (int r = 0; r < 16; ++r) mx = fmaxf(mx, x[1][r]);
                if (BIAS) {
                    mx = fmaxf(mx, __shfl_xor(mx, 32));
                    const float mnew = fmaxf(mrun, mx), alpha = fexp2(mrun - mnew); mrun = mnew;
#pragma unroll
                    for (int xt = 0; xt < 2; ++xt)
#pragma unroll
                        for (int r = 0; r < 16; ++r) x[xt][r] = fexp2(x[xt][r] - mnew);
                    if (__any(alpha != 1.0f)) {
#pragma unroll
                        for (int c = 0; c < NDV; ++c)
#pragma unroll
                            for (int r = 0; r < 16; ++r) o[c][r] *= alpha;
#pragma unroll
                        for (int r = 0; r < 16; ++r) osum[r] *= alpha;
                    }
                } else {
                    const bool first = (carry == 0.f);
                    if (first || __any(mx > 8.0f)) {
                        carry = 1.f;
                        mx = fmaxf(mx, __shfl_xor(mx, 32));
                        const float dl = first ? ((mx > -1e29f) ? mx : 0.f) : fmaxf(mx, 0.f);
                        const float alpha = first ? 1.0f : fexp2(-dl);
                        mrun += dl; lrun *= alpha;
#pragma unroll
                        for (int xt = 0; xt < 2; ++xt)
#pragma unroll
                            for (int r = 0; r < 16; ++r) x[xt][r] -= dl;
#pragma unroll
                        for (int r = 0; r < 16; ++r) negm[r] = -mrun;
#pragma unroll
                        for (int c = 0; c < NDV; ++c)
#pragma unroll
                            for (int r = 0; r < 16; ++r) o[c][r] *= alpha;
                    }
                    float ps = 0.f;
#pragma unroll
                    for (int xt = 0; xt < 2; ++xt)
#pragma unroll
                        for (int r = 0; r < 16; ++r) { const float pv = fexp2(x[xt][r]); x[xt][r] = pv; ps += pv; }
                    lrun += ps;
                }
            } else {
                if (needmask) sb_tile<true>(x, carry, tlo, hi, qpos); else sb_tile<false>(x, carry, tlo, hi, qpos);
            }
#pragma unroll
            for (int ks = 0; ks < 4; ++ks)
#pragma unroll
                for (int j = 0; j < 4; ++j) pk[ks][j] = cvtpk(x[ks >> 1][8 * (ks & 1) + 2 * j], x[ks >> 1][8 * (ks & 1) + 2 * j + 1]);
            if (BIAS) {
                const bf16x8 ones = {(short)0x3F80, (short)0x3F80, (short)0x3F80, (short)0x3F80, (short)0x3F80, (short)0x3F80, (short)0x3F80, (short)0x3F80};
#pragma unroll
                for (int ks = 0; ks < 4; ++ks) { const u32x4 t4 = {pk[ks][0], pk[ks][1], pk[ks][2], pk[ks][3]}; osum = __builtin_amdgcn_mfma_f32_32x32x16_bf16(ones, __builtin_bit_cast(bf16x8, t4), osum, 0, 0, 0); }
            }
            ATT_PV(vs);
        }
}
#undef ATT_PV

template <int MODE, int NDV, bool BIAS>
__device__ __forceinline__ void run(LAS unsigned char* lds, const Args& a, f32x16 (&o)[NDV], float& l_out) {
    int tid_l = threadIdx.x; asm volatile("" : "+v"(tid_l));
    const int tid = tid_l, lane = tid & 63, w = __builtin_amdgcn_readfirstlane(tid >> 6), r32 = lane & 31, hi = lane >> 5;
    const int qmin = 256 * a.u + 32 * w, qpos = qmin + r32;
    constexpr int NV = NDV / 2;
    bf16x8 qf[4];
    { const bf16_t* qp = a.qkv + (size_t)(a.rowb + qpos) * a.pitch + a.qcol + 8 * hi;
#pragma unroll
      for (int d0 = 0; d0 < 4; ++d0) qf[d0] = *(const bf16x8*)(qp + 16 * d0); }
    float qkb = 0.f;
    if (BIAS) { float s2 = 0.f;
#pragma unroll
        for (int d0 = 0; d0 < 4; ++d0)
#pragma unroll
            for (int j = 0; j < 8; ++j) { const float qv = bf2f((unsigned short)qf[d0][j]); s2 += qv * qv; }
        s2 += __shfl_xor(s2, 32); qkb = sqrtf(s2) * a.kmax * 1.001f + 1e-3f; }
    const int kr = tid >> 3, kc = tid & 7;
    const bf16_t* kg = a.qkv + (size_t)(a.rowb + kr) * a.pitch + a.kcol + 8 * kc;
    const unsigned klds = kr * KROW + kc * 16;
    const bf16_t* vg[NV]; unsigned vlds[NV];
#pragma unroll
    for (int j = 0; j < NV; ++j) {
        int vr, ch; if (NDV == 2) { vr = tid >> 3; ch = tid & 7; } else { vr = (tid >> 4) + 32 * j; ch = tid & 15; }
        vg[j] = a.qkv + (size_t)(a.rowb + vr) * a.pitch + a.vcol + 8 * ch;
        vlds[j] = (vr >> 3) * (NDV * 512) + (ch >> 2) * 512 + (vr & 7) * 64 + (ch & 3) * 16;
    }
    const size_t tstride = (size_t)64 * a.pitch;
    float fq0 = 0.f; if (BIAS) fq0 = a.F[256 * a.u];
    const int ntile = 4 * a.u + 1;
#define ATT_TILE(i) ((MODE == 0 || BIAS) ? (4 * a.u + 3 - (i)) : (3 + (i)))
    u32x4 kregA, vregA[NV]; float bregA = 0.f, ubnA = 0.f, ubn_next = 0.f;
#define ATT_LOADX(KR, VR, BR, UB, kt) do { KR = *(const u32x4*)(kg + (size_t)(kt) * tstride); _Pragma("unroll") for (int j_ = 0; j_ < NV; ++j_) VR[j_] = *(const u32x4*)(vg[j_] + (size_t)(kt) * tstride); \
        if (BIAS) { if (tid < 64) BR = (fq0 - a.F[64 * (kt) + tid]) * LOG2E; UB = (fq0 - a.F[64 * (kt) + 63]) * LOG2E; } } while (0)
#define ATT_WRITEX(KR, VR, BR, UB, b, vs_) do { *(LAS u32x4*)(lds + L_K + (b) * KBUF + klds) = KR; _Pragma("unroll") for (int j_ = 0; j_ < NV; ++j_) *(LAS u32x4*)(lds + L_V + (vs_) * VBUF + vlds[j_]) = VR[j_]; \
        if (BIAS) { if (tid < 64) *(LAS float*)(lds + L_BIAS + (b) * 256 + tid * 4) = BR; ubn_next = UB; } } while (0)
#define ATT_LOADA(kt) ATT_LOADX(kregA, vregA, bregA, ubnA, kt)
#define ATT_WRITEA(b, vs_) ATT_WRITEX(kregA, vregA, bregA, ubnA, b, vs_)
#pragma unroll
    for (int c = 0; c < NDV; ++c)
#pragma unroll
        for (int r = 0; r < 16; ++r) o[c][r] = 0.f;
    float mrun = (MODE == 1 && !BIAS) ? 0.f : -1e30f, lrun = 0.f, carry = 0.f;
    f32x16 negm, osum;
#pragma unroll
    for (int r = 0; r < 16; ++r) { negm[r] = 0.f; osum[r] = 0.f; }
    const unsigned vlane = 64 * (4 * hi + ((lane & 15) >> 2)) + 32 * ((lane >> 4) & 1) + 8 * (lane & 3);
    ATT_LOADA(ATT_TILE(0)); ATT_WRITEA(0, 0);
    asm volatile("" :: "v"(qf[0]), "v"(qf[1]), "v"(qf[2]), "v"(qf[3]));
    __syncthreads();
    bool pend = false; int vsp = 0, vs = 0;
#define ATT_ITER(i_) do { \
        const int kt_ = ATT_TILE(i_), buf_ = (i_) & 1; vs = (i_) % 3; \
        if ((i_) + 1 < ntile) ATT_LOADA(ATT_TILE((i_) + 1)); \
        bool wdone_ = false; if (MODE == 0) wdone_ = __all(carry < -160.0f) != 0; if (BIAS) wdone_ = __all(qkb + ub_cur - mrun < -160.0f) != 0; \
        tile_compute<MODE, NDV, BIAS>(lds, kt_, buf_, vs, qf, o, mrun, lrun, carry, negm, osum, wdone_, pend, vsp, w, lane, r32, hi, qmin, qpos, vlane); \
        if (MODE == 0) { const int ok = __all(carry < -160.0f) ? 1 : 0; if (lane == 0) *(LAS int*)(lds + L_FLAG + (buf_ * 8 + w) * 4) = ok; } \
        if ((i_) + 1 < ntile) ATT_WRITEA(buf_ ^ 1, ((i_) + 1) % 3); \
        ub_cur = ubn_next; \
        if (BIAS) { const int ok = __all(qkb + ubn_next - mrun < -160.0f) ? 1 : 0; if (lane == 0) *(LAS int*)(lds + L_FLAG + (buf_ * 8 + w) * 4) = ok; } \
        __syncthreads(); \
        if (MODE == 0 || BIAS) { const LAS int* fl = (const LAS int*)(lds + L_FLAG + buf_ * 32); \
            if (fl[0] & fl[1] & fl[2] & fl[3] & fl[4] & fl[5] & fl[6] & fl[7]) stop = true; } } while (0)
    bool stop = false;
    float ub_cur = ubn_next;
    for (int i = 0; i < ntile && !stop; ++i) ATT_ITER(i);
    __syncthreads();
    l_out = BIAS ? osum[0] : (lrun + __shfl_xor(lrun, 32));
#undef ATT_TILE
#undef ATT_LOADX
#undef ATT_WRITEX
#undef ATT_LOADA
#undef ATT_WRITEA
#undef ATT_ITER
}
}
struct Params { const float* in[27]; float* out; unsigned char* ws; int ph_lo, ph_hi; };

__device__ __forceinline__ float log_sigmoid_f(float x) { return -(fmaxf(-x, 0.f) + log1pf(expf(-fabsf(x)))); }
__device__ __forceinline__ float gelu_tanh_f(float x) { const float z = 0.7978845608028654f * (x + 0.044715f * x * x * x); const float t = 1.0f - 2.0f / (__expf(2.0f * z) + 1.0f); return 0.5f * x * (1.0f + t); }

__device__ __forceinline__ void map_col(int kind, int n, int& dr, float& sc) {
    sc = 1.0f; dr = n;
    if (kind == 1) { if (n < 512 || (n >= 1536 && n < 2048)) sc = C2; }
    else if (kind == 2) { if (n < 512) sc = C2; else if (n >= 1536 && n < 1544) dr = -1; else if (n >= 1544) dr = n - 8; }
    else if (kind == 3) { if (n < 2816) dr = 8 * (n >> 2) + (n & 3); else { const int j = n - 2816; dr = 8 * (j >> 2) + 4 + (j & 3); } }
}
__device__ __forceinline__ void transpose_item(const float* W, int K, int N, const float* gk, bf16_t* WT, int kind, LAS float* scr, int item, int lane) {
    const int nblk = (N + 31) / 32, kb = item / nblk, nb = item % nblk, k0 = 64 * kb, n0 = 32 * nb;
    float wv[32];
    { const int n = n0 + (lane & 31); const bool inb = n < N; const float* wp = W + (size_t)(k0 + (lane >> 5)) * N + (inb ? n : 0);
#pragma unroll
      for (int i = 0; i < 32; ++i) wv[i] = inb ? wp[(size_t)(2 * i) * N] : 0.f;
      if (gk) {
#pragma unroll
          for (int i = 0; i < 32; ++i) wv[i] *= gk[k0 + 2 * i + (lane >> 5)];
      }
#pragma unroll
      for (int i = 0; i < 32; ++i) scr[(2 * i + (lane >> 5)) * 33 + (lane & 31)] = wv[i]; }
    asm volatile("s_waitcnt lgkmcnt(0)" ::: "memory");
    const int c = lane & 7;
#pragma unroll
    for (int j = 0; j < 4; ++j) { const int nl = (lane >> 3) + 8 * j, n = n0 + nl;
        if (n < N) { int dr; float sc; map_col(kind, n, dr, sc);
            if (dr >= 0) { const LAS float* s = scr + (8 * c) * 33 + nl;
                u32x4 o; o.x = pk2(s[0 * 33] * sc, s[1 * 33] * sc); o.y = pk2(s[2 * 33] * sc, s[3 * 33] * sc); o.z = pk2(s[4 * 33] * sc, s[5 * 33] * sc); o.w = pk2(s[6 * 33] * sc, s[7 * 33] * sc);
                *(u32x4*)(WT + (size_t)dr * K + k0 + 8 * c) = o; } } }
    asm volatile("s_waitcnt lgkmcnt(0)" ::: "memory");
}

struct S5Ops { float ar, ai, dsk; bf16x8 bfr[4], af[2], cf[4]; unsigned short uq[16]; };
template <bool FINAL>
__device__ __forceinline__ void s5_load(const Params& p, int item, int lane, S5Ops& q) {
    const int g = item & 31, bc = item >> 5, c = bc % 132, b = bc / 132;
    const unsigned char* ws = p.ws;
    const bf16_t* qkv = (const bf16_t*)(ws + WS_QKV);
    const float* a_re_p = (const float*)(ws + WS_S5A); const float* a_im_p = a_re_p + 2048;
    const int gp = g * 64 + lane, r32 = lane & 31, hi = lane >> 5;
    q.ar = a_re_p[gp]; q.ai = a_im_p[gp];
    { const bf16_t* bt = (const bf16_t*)(ws + WS_S5BT) + ((size_t)g * 128 + r32) * 16 + 8 * hi;
#pragma unroll
      for (int pb = 0; pb < 4; ++pb) q.bfr[pb] = *(const bf16x8*)(bt + pb * 32 * 16); }
    const bf16_t* urow = qkv + ((size_t)b * LP + 64 * c) * 2048 + 1536 + 16 * g;
#pragma unroll
    for (int sub = 0; sub < 2; ++sub) q.af[sub] = *(const bf16x8*)(urow + (size_t)(32 * sub + r32) * 2048 + 8 * hi);
    q.dsk = 0.f;
    if (FINAL) {
        const bf16_t* ct = (const bf16_t*)(ws + WS_S5CT) + ((size_t)g * 16 + (lane & 15)) * 128 + 8 * (lane >> 4);
#pragma unroll
        for (int ks = 0; ks < 4; ++ks) q.cf[ks] = *(const bf16x8*)(ct + 32 * ks);
        q.dsk = p.in[22][g * 16 + (lane & 15)];
#pragma unroll
        for (int k = 0; k < 16; ++k) { const int t = 32 * (k >> 3) + 16 * ((k >> 2) & 1) + 4 * (lane >> 4) + (k & 3); q.uq[k] = urow[(size_t)t * 2048 + (lane & 15)]; }
    }
}
template <bool FINAL>
__device__ __forceinline__ void s5_compute(const Params& p, LAS unsigned char* wl  , int item, int lane, const S5Ops& q) {
    const int g = item & 31, bc = item >> 5, c = bc % 132, b = bc / 132;
    const unsigned char* ws = p.ws;
    float2* E = (float2*)(ws + WS_E);
    const int r32 = lane & 31, hi = lane >> 5;
    const float ar = q.ar, ai = q.ai;
    float xr = 0.f, xi = 0.f;
    if (FINAL) {
        float pr_ = ar, pi_ = ai;
#pragma unroll
        for (int s = 0; s < 6; ++s) { const float nr = pr_ * pr_ - pi_ * pi_, ni = 2.0f * pr_ * pi_; pr_ = nr; pi_ = ni; }
        const float2* Eb = E + ((size_t)b * 132 * 32 + g) * 64 + lane;
        int cc = 0;
        for (; cc + 8 <= c; cc += 8) {
            float2 e[8];
#pragma unroll
            for (int k = 0; k < 8; ++k) e[k] = Eb[(size_t)(cc + k) * 32 * 64];
#pragma unroll
            for (int k = 0; k < 8; ++k) { const float nr = pr_ * xr - pi_ * xi + e[k].x, ni = pr_ * xi + pi_ * xr + e[k].y; xr = nr; xi = ni; }
        }
        for (; cc < c; ++cc) { const float2 e = Eb[(size_t)cc * 32 * 64]; const float nr = pr_ * xr - pi_ * xi + e.x, ni = pr_ * xi + pi_ * xr + e.y; xr = nr; xi = ni; }
    }
    LAS float* BU = (LAS float*)wl;
#pragma unroll 1
    for (int sub = 0; sub < 2; ++sub) {
#pragma unroll
        for (int pb = 0; pb < 4; ++pb) {
            f32x16 z;
#pragma unroll
            for (int r = 0; r < 16; ++r) z[r] = 0.f;
            const f32x16 d = __builtin_amdgcn_mfma_f32_32x32x16_bf16(sub == 0 ? q.af[0] : q.af[1], q.bfr[pb], z, 0, 0, 0);
#pragma unroll
            for (int r = 0; r < 16; ++r) BU[((r & 3) + 8 * (r >> 2) + 4 * hi) * 128 + 32 * pb + r32] = d[r];
        }
        asm volatile("s_waitcnt lgkmcnt(0)" ::: "memory");
        const unsigned xb_re = (unsigned)(uintptr_t)wl + (((unsigned)lane >> 3) << 4) + (((unsigned)lane & 7u) << 1), xb_im = xb_re + 128u;
#pragma unroll 1
        for (int h2 = 0; h2 < 2; ++h2) {
            const LAS float* BUh = BU + h2 * 16 * 128;
            const unsigned xr_b = xb_re + h2 * 8192u, xi_b = xb_im + h2 * 8192u;
#pragma unroll
            for (int t16 = 0; t16 < 16; ++t16) {
                const float sr = BUh[t16 * 128 + lane], si = BUh[t16 * 128 + 64 + lane];
                const float nr = ar * xr - ai * xi + sr, ni = ar * xi + ai * xr + si; xr = nr; xi = ni;
                if (FINAL) {
                    const unsigned xp = pg8::cvt_pk_bf16(xr, xi);
                    *(LAS bf16_t*)((LAS unsigned char*)(uintptr_t)(xr_b ^ (unsigned)(t16 << 4)) + t16 * 512) = (bf16_t)(xp & 0xffffu);
                    *(LAS bf16_t*)((LAS unsigned char*)(uintptr_t)(xi_b ^ (unsigned)(t16 << 4)) + t16 * 512) = (bf16_t)(xp >> 16);
                }
            }
        }
        if (FINAL) {
            asm volatile("s_waitcnt lgkmcnt(0)" ::: "memory");
            bf16_t* Y = (bf16_t*)(ws + WS_Y);
#pragma unroll
            for (int mb = 0; mb < 2; ++mb) {
                f32x4 acc = {0.f, 0.f, 0.f, 0.f};
                const int tr = 16 * mb + (lane & 15);
#pragma unroll
                for (int ks = 0; ks < 4; ++ks) { const bf16x8 xf = *(const LAS bf16x8*)(wl + tr * 512 + (((4 * ks + (lane >> 4)) ^ (tr & 15)) << 4));
                    acc = __builtin_amdgcn_mfma_f32_16x16x32_bf16(xf, q.cf[ks], acc, 0, 0, 0); }
#pragma unroll
                for (int i2 = 0; i2 < 4; ++i2) { const int t = 32 * sub + 16 * mb + 4 * (lane >> 4) + i2;
                    const float uv = bf2f(sub == 0 ? q.uq[4 * mb + i2] : q.uq[8 + 4 * mb + i2]);
                    const float yv = acc[i2] + q.dsk * uv;
                    Y[((size_t)b * LP + 64 * c + t) * 512 + 16 * g + (lane & 15)] = (bf16_t)f2bf(gelu_tanh_f(yv)); }
            }
            asm volatile("s_waitcnt lgkmcnt(0)" ::: "memory");
        }
    }
    if (!FINAL) E[((size_t)(b * 132 + c) * 32 + g) * 64 + lane] = make_float2(xr, xi);
}
template <bool FINAL>
__device__ __forceinline__ void s5_run(const Params& p, LAS unsigned char* wl, int first, int stride, int nitems, int lane) {
    S5Ops cur, nxt;
    if (first < nitems) s5_load<FINAL>(p, first, lane, cur);
    for (int it = first; it < nitems; it += stride) {
        if (it + stride < nitems) s5_load<FINAL>(p, it + stride, lane, nxt);
        s5_compute<FINAL>(p, wl, it, lane, cur);
        cur = nxt;
    }
}
__device__ __forceinline__ unsigned long long rt() { return __builtin_amdgcn_s_memrealtime(); }
#define XB_TMO      128
#define XB_XCNT(j)  (256  + 64 * (j))
#define XB_XSUB(j)  (1280 + 64 * (j))
#define XB_XGEN(j)  (2304 + 64 * (j))
#define XB_TOP      3328
#define XB_TOPGEN   3392
#define XCD_BAR_WORDS 3456
#define XB_SPIN_CAP (1u << 18)

__device__ __forceinline__ unsigned xb_ld(unsigned* p)              { return __hip_atomic_load(p, __ATOMIC_RELAXED, __HIP_MEMORY_SCOPE_AGENT); }
__device__ __forceinline__ unsigned xb_add(unsigned* p, unsigned v) { return __hip_atomic_fetch_add(p, v, __ATOMIC_RELAXED, __HIP_MEMORY_SCOPE_AGENT); }
__device__ __forceinline__ unsigned xb_xcc_id() { return (unsigned)__builtin_amdgcn_s_getreg((3 << 11) | 20) & 0xFu; }
#define XB_SPIN(cond, bar) do { unsigned _sp = 0; while (cond) { __builtin_amdgcn_s_sleep(1); \
    if ((++_sp & 255u) == 0u) { if (xb_ld(&(bar)[XB_TMO])) break; if (_sp > XB_SPIN_CAP) { atomicAdd(&(bar)[XB_TMO], 1u); break; } } } } while (0)

struct XcdBarrier {
    unsigned* bar; unsigned x;
    volatile LAS unsigned* st;
};

__device__ __forceinline__ XcdBarrier xcd_barrier_post(unsigned* bar, volatile LAS unsigned* st) {
    XcdBarrier b; b.bar = bar; b.x = xb_xcc_id(); b.st = st;
    if (threadIdx.x == 0) (void)xb_add(&bar[XB_XCNT(b.x)], 1u);
    return b;
}
__device__ __forceinline__ void xcd_barrier_complete(unsigned* bar, unsigned x, unsigned& nloc, unsigned& nx) {
    const unsigned G = gridDim.x * gridDim.y * gridDim.z;
    unsigned sum, cnt, mine, sp = 0u;
    for (;;) {
        sum = 0u; cnt = 0u; mine = 0u;
#pragma unroll
        for (unsigned j = 0; j < 16; ++j) { const unsigned c = xb_ld(&bar[XB_XCNT(j)]); sum += c; cnt += (c > 0u) ? 1u : 0u; mine = (j == x) ? c : mine; }
        if (sum == G) break;
        __builtin_amdgcn_s_sleep(1);
        if ((++sp & 255u) == 0u) { if (xb_ld(&bar[XB_TMO])) break; if (sp > XB_SPIN_CAP) { atomicAdd(&bar[XB_TMO], 1u); break; } }
    }
    nloc = mine > 0u ? mine : 1u; nx = cnt > 0u ? cnt : 1u;
}

__device__ __forceinline__ void xcd_barrier(const XcdBarrier& b) {
    asm volatile("s_waitcnt vmcnt(0)" ::: "memory");
    __syncthreads();
    if (threadIdx.x == 0) {
        unsigned* bar = b.bar;
        __builtin_amdgcn_s_waitcnt(0);
        unsigned nloc = b.st[0], nx = b.st[1];
        if (nloc == 0u) { xcd_barrier_complete(bar, b.x, nloc, nx); b.st[0] = nloc; b.st[1] = nx; }
        const unsigned old = xb_add(&bar[XB_XSUB(b.x)], 1u);
        const unsigned gen = old / nloc;
        if (old + 1u == (gen + 1u) * nloc) {
            __builtin_amdgcn_fence(__ATOMIC_RELEASE, "agent");
            asm volatile("s_waitcnt vmcnt(0)" ::: "memory");
            const unsigned og = xb_add(&bar[XB_TOP], 1u);
            const unsigned tg = og / nx;
            if (og + 1u == (tg + 1u) * nx) xb_add(&bar[XB_TOPGEN], 1u);
            else XB_SPIN(xb_ld(&bar[XB_TOPGEN]) == tg, bar);
            __builtin_amdgcn_fence(__ATOMIC_ACQUIRE, "agent");
            xb_add(&bar[XB_XGEN(b.x)], 1u);
            asm volatile("s_waitcnt vmcnt(0)" ::: "memory");
        } else {
            XB_SPIN(xb_ld(&bar[XB_XGEN(b.x)]) == gen, bar);
            __builtin_amdgcn_fence(__ATOMIC_ACQUIRE, "agent");
            asm volatile("s_waitcnt vmcnt(0)" ::: "memory");
        }
    }
    __syncthreads();
}

__device__ __forceinline__ f32x4 meta_mm(const bf16_t* X, int ldx, const bf16_t* Wt, int K, int n0, int lane, int kb, int ke) {
    const bf16_t* ap = X + (size_t)(PADR + (lane & 15)) * ldx + 8 * (lane >> 4);
    const bf16_t* bp = Wt + (size_t)(n0 + (lane & 15)) * K + 8 * (lane >> 4);
    f32x4 acc = {0.f, 0.f, 0.f, 0.f};
#pragma unroll 4
    for (int k = kb; k < ke; k += 32) { const bf16x8 a = *(const bf16x8*)(ap + k), b = *(const bf16x8*)(bp + k); acc = __builtin_amdgcn_mfma_f32_16x16x32_bf16(a, b, acc, 0, 0, 0); }
    return acc;
}
template <int KIND>
__device__ __forceinline__ void meta_task(LAS unsigned char* lds, int wave, const bf16_t* X, int ldx, const bf16_t* Wt, int K, int n0, int lane, bf16_t* O, int ldc, const ssq_t* ssq_in, float* H, bf16_t* HB, ssq_t* ssq_out) {
    const int ks = K >> 3;
    f32x4 acc = meta_mm(X, ldx, Wt, K, n0, lane, wave * ks, (wave + 1) * ks);
    LAS f32x4* red = (LAS f32x4*)lds;
    red[wave * 64 + lane] = acc;
    __syncthreads();
    if (wave != 0) { __syncthreads(); return; }
#pragma unroll
    for (int w2 = 1; w2 < 8; ++w2) acc += red[w2 * 64 + lane];
    const int c = n0 + (lane & 15);
#pragma unroll
    for (int i = 0; i < 4; ++i) {
        const int r = PADR + 4 * (lane >> 4) + i;
        if (KIND == 0) {
            const float rs = ssq_rs(ssq_in + r);
            const bf16_t v = (bf16_t)f2bf(acc[i] * rs);
#pragma unroll
            for (int b = 0; b < NBATCH; ++b) O[(size_t)(b * LP + r) * ldc + c] = v;
        } else if (KIND == 1) {
            const float hv = bf2f((unsigned short)f2bf(bf2f(HB[(size_t)r * DM + c]) + acc[i]));
            float ss = hv * hv; ss += __shfl_xor(ss, 1); ss += __shfl_xor(ss, 2); ss += __shfl_xor(ss, 4); ss += __shfl_xor(ss, 8);
#pragma unroll
            for (int b = 0; b < NBATCH; ++b) { HB[(size_t)(b * LP + r) * DM + c] = (bf16_t)f2bf(hv); if ((lane & 15) == 0 && ssq_out) atomicAdd(ssq_out + b * LP + r, ssq_fix(ss)); }
        } else {
            const float rs = ssq_rs(ssq_in + r);
            const float v = acc[i] * rs, up = __shfl_xor(v, 4);
            if ((c & 4) == 0) O[(size_t)r * DFF + ((c >> 3) << 2) + (c & 3)] = (bf16_t)f2bf(v / (1.0f + __expf(-v)) * up);
        }
    }
    __syncthreads();
}
__device__ __forceinline__ void zero_pad_rows(bf16_t* B, int pitch, int gw, int NGW, int lane) {
    for (int r = gw; r < NBATCH * PADR; r += NGW) { u32x4* rp = (u32x4*)(B + (size_t)((r / PADR) * LP + (r % PADR)) * pitch);
        for (int j = lane; j < pitch / 8; j += 64) rp[j] = (u32x4){0u, 0u, 0u, 0u}; }
}
#ifndef REP3
#define REP3 1
#endif
#ifndef REP5
#define REP5 1
#endif
#ifndef REP10
#define REP10 1
#endif
#ifndef REP12
#define REP12 1
#endif
#ifndef REP0
#define REP0 1
#endif
#ifndef REP1
#define REP1 1
#endif
#ifndef REP2
#define REP2 1
#endif
#ifndef REP4
#define REP4 1
#endif
#ifndef REP6
#define REP6 1
#endif
#ifndef REP7
#define REP7 1
#endif
#ifndef REP8
#define REP8 1
#endif
#ifndef REP9
#define REP9 1
#endif
#ifndef REP11
#define REP11 1
#endif
__global__ void __launch_bounds__(NTHR, 2) mega_fwd(Params p) {
    extern __shared__ __attribute__((aligned(16))) unsigned char lds_raw[];
    LAS unsigned char* lds = (LAS unsigned char*)lds_raw;
    cg::grid_group grid = cg::this_grid();
    const int tid = threadIdx.x, lane = tid & 63, wave = __builtin_amdgcn_readfirstlane(tid >> 6);
    const int G = gridDim.x, gw = blockIdx.x * NW + wave, NGW = G * NW;
    unsigned char* ws = p.ws;
    unsigned* ctl = (unsigned*)(ws + WS_CTL);
    ssq_t* ssq = (ssq_t*)(ws + WS_SSQ);
    float* Fb = (float*)(ws + WS_F);
    float* H = (float*)(ws + WS_H);
    bf16_t* HB = (bf16_t*)(ws + WS_HB);
    bf16_t* QKV = (bf16_t*)(ws + WS_QKV);
    bf16_t* CAT = (bf16_t*)((unsigned char*)p.out + DO_CAT);
    float* STASH = (float*)((unsigned char*)p.out + DO_STASH);
    const int lo = p.ph_lo, hi_ph = p.ph_hi;
    volatile LAS unsigned* xst = (volatile LAS unsigned*)(lds + 131072 + 64);
    if (tid < 2) xst[tid] = 0u;
    __syncthreads();
    XcdBarrier xbar = xcd_barrier_post((unsigned*)(ws + WS_CTL + 16384), xst);
#ifndef PHMASK
#define PHMASK 0x3fff
#endif
#define IN(k) (((PHMASK >> (k)) & 1) && lo <= (k) && (k) < hi_ph)
#define SEAM(k) do { if (IN(k) && IN((k) + 1)) xcd_barrier(xbar); } while (0)
    if (p.ph_lo < 0) grid.sync();

    for (int rep = 0; rep < (IN(0) ? REP0 : 0); ++rep) {
        for (int i = blockIdx.x * NTHR + tid; i < 3 * MROWS; i += G * NTHR) ssq[MROWS + i] = 0ull;
        for (int row = gw; row < MROWS; row += NGW) {
            const int b = row / LP, pos = row % LP;
            f32x4 v[4]; float s = 0.f;
            if (pos < PADR) {
#pragma unroll
                for (int j = 0; j < 4; ++j) v[j] = (f32x4){0.f, 0.f, 0.f, 0.f};
            } else {
                const float* src = (pos < 256) ? (p.in[1] + (size_t)(pos - PADR) * DM) : (p.in[0] + ((size_t)b * SEQ + (pos - 256)) * DM);
#pragma unroll
                for (int j = 0; j < 4; ++j) { v[j] = ((const f32x4*)src)[lane + 64 * j]; s += (v[j][0] * v[j][0] + v[j][1] * v[j][1]) + (v[j][2] * v[j][2] + v[j][3] * v[j][3]); }
            }
            s = wave_sum(s);
#pragma unroll
            for (int j = 0; j < 4; ++j) {
                u32x2 w; w.x = pk2(v[j][0], v[j][1]); w.y = pk2(v[j][2], v[j][3]); ((u32x2*)(HB + (size_t)row * DM))[lane + 64 * j] = w; }
            if (lane == 0) ssq[row] = ssq_fix(s);
        }
        {
            LAS float* scr = (LAS float*)(lds + wave * 16384);
            const float* nmg = p.in[2]; const float* nfg = p.in[3];
            constexpr int I0 = 16 * 96, I1 = 16 * 32, I2 = 16 * 176, I3 = 44 * 32, I4 = 16 * 65, I5 = 8 * 16, I6 = 16 * 32, I7 = 16 * 176, I8 = 44 * 32;
            constexpr int NIT = I0 + I1 + I2 + I3 + I4 + I5 + I6 + I7 + I8;
            for (int it = gw; it < NIT; it += NGW) {
                int r = it;
                if (r < I0) { transpose_item(p.in[5], 1024, 3072, nmg, (bf16_t*)(ws + WS_W0IN), 1, scr, r, lane); continue; } r -= I0;
                if (r < I1) { transpose_item(p.in[6], 1024, 1024, nullptr, (bf16_t*)(ws + WS_W0OUT), 0, scr, r, lane); continue; } r -= I1;
                if (r < I2) { transpose_item(p.in[25], 1024, 5632, nfg, (bf16_t*)(ws + WS_WGU0), 3, scr, r, lane); continue; } r -= I2;
                if (r < I3) { transpose_item(p.in[26], 2816, 1024, nullptr, (bf16_t*)(ws + WS_WDN0), 0, scr, r, lane); continue; } r -= I3;
                if (r < I4) { transpose_item(p.in[12], 1024, 2056, nmg + 1024, (bf16_t*)(ws + WS_W1IN), 2, scr, r, lane); continue; } r -= I4;
                if (r < I5) { transpose_item(p.in[23], 512, 512, nullptr, (bf16_t*)(ws + WS_WGLU), 0, scr, r, lane); continue; } r -= I5;
                if (r < I6) { transpose_item(p.in[13], 1024, 1024, nullptr, (bf16_t*)(ws + WS_W1OUT), 0, scr, r, lane); continue; } r -= I6;
                if (r < I7) { transpose_item(p.in[25] + (size_t)1024 * 5632, 1024, 5632, nfg + 1024, (bf16_t*)(ws + WS_WGU1), 3, scr, r, lane); continue; } r -= I7;
                transpose_item(p.in[26] + (size_t)2816 * 1024, 2816, 1024, nullptr, (bf16_t*)(ws + WS_WDN1), 0, scr, r, lane);
            }
        }
        for (int idx = blockIdx.x * NTHR + tid; idx < 2048 * 16; idx += G * NTHR) {
            const int i = idx >> 4, h = idx & 15, g = i >> 6;
            const float lre = p.in[15][i], lim = p.in[16][i], dt = expf(p.in[17][g]);
            const float mag = expf(lre * dt), are = mag * cosf(lim * dt), aim = mag * sinf(lim * dt), den = lre * lre + lim * lim;
            const float gre = ((are - 1.0f) * lre + aim * lim) / den, gim = (aim * lre - (are - 1.0f) * lim) / den;
            if (h == 0) { float* ap = (float*)(ws + WS_S5A); ap[i] = are; ap[2048 + i] = aim; }
            float* bbr = (float*)(ws + WS_S5BB); float* bbi = bbr + 2048 * 16;
            bf16_t* bt = (bf16_t*)(ws + WS_S5BT) + ((size_t)g * 128 + (i & 63)) * 16;
            const float br = p.in[18][i * 16 + h], bi = p.in[19][i * 16 + h]; const float vr = gre * br - gim * bi, vi = gre * bi + gim * br;
            bbr[i * 16 + h] = vr; bbi[i * 16 + h] = vi; bt[h] = (bf16_t)f2bf(vr); bt[64 * 16 + h] = (bf16_t)f2bf(vi);
        }
        for (int i = blockIdx.x * NTHR + tid; i < 32 * 16 * 128; i += G * NTHR) {
            const int pp = i & 127, gh = i >> 7;
            const float v = (pp < 64) ? p.in[20][gh * 64 + pp] : -p.in[21][gh * 64 + (pp - 64)];
            ((bf16_t*)(ws + WS_S5CT))[i] = (bf16_t)f2bf(v);
        }
        for (int i = blockIdx.x * NTHR + tid; i < 8 * 1024; i += G * NTHR) {
            const int j = i >> 10, k = i & 1023;
            ((float*)(ws + WS_W1F))[i] = p.in[12][(size_t)k * 2056 + 1536 + j] * p.in[2][1024 + k];
        }
    }
    SEAM(0);

    for (int rep = 0; rep < (IN(1) ? REP1 : 0); ++rep) {
        pg8::Gemm g{HB, (const bf16_t*)(ws + WS_W0IN), MROWS, 3072, 1024}; pg8::StaticOrder S; S.init(NBATCH * SEQ, 3072, G, (int)blockIdx.x);
        pg8::EpiScaleBf16 E{QKV, 3072, ssq};
        pg8::gemm_phase<pg8::EpiScaleBf16, pg8::StaticOrder, true, true>(lds, g, S, E);
        if (rep == 0) { zero_pad_rows(QKV, 3072, gw, NGW, lane);
            for (int t = blockIdx.x; t < 3072 / 16; t += G) meta_task<0>(lds, wave, HB, DM, (const bf16_t*)(ws + WS_W0IN), 1024, 16 * t, lane, QKV, 3072, ssq, nullptr, nullptr, nullptr); }
    }
    SEAM(1);

    for (int rep = 0; rep < (IN(2) ? REP2 : 0); ++rep) {
        float lam;
        { const float a1 = wave_sum(p.in[7][lane] * p.in[8][lane]), a2 = wave_sum(p.in[9][lane] * p.in[10][lane]); lam = expf(a1) - expf(a2) + 0.2f; }
        constexpr int NDIFF = 16 * 33, NSB = 32 * 33;
        LAS int* misc = (LAS int*)(lds + att::L_MISC);
        for (;;) {
            if (tid == 0) misc[0] = (int)atomicAdd(ctl + rep, 1u);
            __syncthreads();
            int idx = misc[0];
            __syncthreads();
#ifdef REP2_DIFF_ONLY
            if (rep > 0 && idx >= NDIFF) break;
#endif
#ifdef REP2_SB_ONLY
            if (rep > 0) idx += NDIFF;
#endif
            if (idx >= NDIFF + NSB) break;
            if (idx < NDIFF) {
#ifndef NO_DIFF
                const int u = 32 - idx / 16, bh = idx % 16, b = bh >> 2, hd = bh & 3;
                const int r32 = lane & 31, hi = lane >> 5;
                f32x4* st = (f32x4*)(STASH + ((size_t)blockIdx.x * NTHR + tid) * 64);
#pragma unroll 1
                for (int comp = 0; comp < 2; ++comp) {
                    att::Args a{QKV, 3072, b * LP, u, 1536 + hd * 128 + comp * 64, 2048 + hd * 128 + comp * 64, 2560 + hd * 128, nullptr, 0.f};
                    f32x16 o[4]; float l;
                    att::run<1, 4, false>(lds, a, o, l);
                    const float inv = (l > 0.f) ? 1.0f / l : 0.f;
                    if (comp == 0) {
#pragma unroll
                        for (int c = 0; c < 4; ++c)
#pragma unroll
                            for (int g4 = 0; g4 < 4; ++g4) st[c * 4 + g4] = (f32x4){o[c][4 * g4] * inv, o[c][4 * g4 + 1] * inv, o[c][4 * g4 + 2] * inv, o[c][4 * g4 + 3] * inv};
                    } else {
                        float ss = 0.f;
#pragma unroll
                        for (int c = 0; c < 4; ++c)
#pragma unroll
                            for (int g4 = 0; g4 < 4; ++g4) { const f32x4 sv = st[c * 4 + g4];
#pragma unroll
                                for (int e = 0; e < 4; ++e) { const float v = sv[e] - lam * (o[c][4 * g4 + e] * inv); o[c][4 * g4 + e] = v; ss += v * v; } }
                        ss += __shfl_xor(ss, 32);
                        const float rs = 0.8f * rsqrtf(ss * (1.0f / 128.0f) + RMS_EPS);
                        const float* sg = p.in[11];
                        bf16_t* op = CAT + (size_t)(b * LP + 256 * u + 32 * wave + r32) * DM + 512 + hd * 128;
#pragma unroll
                        for (int c = 0; c < 4; ++c)
#pragma unroll
                            for (int g4 = 0; g4 < 4; ++g4) { const int dv = 32 * c + 8 * g4 + 4 * hi; const f32x4 gv = *(const f32x4*)(sg + dv);
                                u32x2 w; w.x = pk2(o[c][4 * g4] * rs * gv[0], o[c][4 * g4 + 1] * rs * gv[1]); w.y = pk2(o[c][4 * g4 + 2] * rs * gv[2], o[c][4 * g4 + 3] * rs * gv[3]);
                                *(u32x2*)(op + dv) = w; }
                    }
                }
#endif
            } else {
#ifndef NO_SB
                const int i2 = idx - NDIFF, u = 32 - i2 / 32, bh = i2 % 32, b = bh >> 3, h = bh & 7;
                const int r32 = lane & 31, hi = lane >> 5;
                att::Args a{QKV, 3072, b * LP, u, h * 64, 512 + h * 64, 1024 + h * 64, nullptr, 0.f};
                f32x16 o[2]; float l;
                att::run<0, 2, false>(lds, a, o, l);
                bf16_t* op = CAT + (size_t)(b * LP + 256 * u + 32 * wave + r32) * DM + h * 64;
#pragma unroll
                for (int c = 0; c < 2; ++c)
#pragma unroll
                    for (int g4 = 0; g4 < 4; ++g4) { const int dv = 32 * c + 8 * g4 + 4 * hi;
                        u32x2 w; w.x = pk2(o[c][4 * g4], o[c][4 * g4 + 1]); w.y = pk2(o[c][4 * g4 + 2], o[c][4 * g4 + 3]); *(u32x2*)(op + dv) = w; }
#endif
            }
        }
    }
    SEAM(2);

    if (IN(3)) {
        pg8::Gemm g{CAT, (const bf16_t*)(ws + WS_W0OUT), MROWS, 1024, 1024}; pg8::StaticOrder S; S.init(NBATCH * SEQ, 1024, G, (int)blockIdx.x);
        pg8::EpiResid<false> E{nullptr, HB, ssq + MROWS};
        pg8::gemm_phase<pg8::EpiResid<false>, pg8::StaticOrder, true, true>(lds, g, S, E);
        for (int t = blockIdx.x; t < 1024 / 16; t += G) meta_task<1>(lds, wave, CAT, DM, (const bf16_t*)(ws + WS_W0OUT), 1024, 16 * t, lane, nullptr, 0, nullptr, H, HB, ssq + MROWS);
    }
    SEAM(3);
    for (int rep = 0; rep < (IN(4) ? REP4 : 0); ++rep) {
        pg8::Gemm g{HB, (const bf16_t*)(ws + WS_WGU0), MROWS, 5632, 1024}; pg8::StaticOrder S; S.init(NBATCH * SEQ, 5632, G, (int)blockIdx.x);
        pg8::EpiSwiGLU E{QKV, ssq + MROWS};
        pg8::gemm_phase<pg8::EpiSwiGLU, pg8::StaticOrder, true, true>(lds, g, S, E);
        if (rep == 0) for (int t = blockIdx.x; t < 5632 / 16; t += G) meta_task<2>(lds, wave, HB, DM, (const bf16_t*)(ws + WS_WGU0), 1024, 16 * t, lane, QKV, 0, ssq + MROWS, nullptr, nullptr, nullptr);
    }
    SEAM(4);
    if (IN(5)) {
        pg8::Gemm g{QKV, (const bf16_t*)(ws + WS_WDN0), MROWS, 1024, 2816}; pg8::StaticOrder S; S.init(NBATCH * SEQ, 1024, G, (int)blockIdx.x);
        pg8::EpiResid<false> E{nullptr, HB, ssq + 2 * MROWS};
        pg8::gemm_phase<pg8::EpiResid<false>, pg8::StaticOrder, true, true>(lds, g, S, E);
        for (int t = blockIdx.x; t < 1024 / 16; t += G) meta_task<1>(lds, wave, QKV, DFF, (const bf16_t*)(ws + WS_WDN0), DFF, 16 * t, lane, nullptr, 0, nullptr, H, HB, ssq + 2 * MROWS);
    }
    SEAM(5);
    for (int rep = 0; rep < (IN(6) ? REP6 : 0); ++rep) {
        {
            pg8::Gemm g{HB, (const bf16_t*)(ws + WS_W1IN), MROWS, 2048, 1024}; pg8::StaticOrder S; S.init(NBATCH * SEQ, 2048, G, (int)blockIdx.x);
            pg8::EpiScaleBf16 E{QKV, 2048, ssq + 2 * MROWS};
            pg8::gemm_phase<pg8::EpiScaleBf16, pg8::StaticOrder, true, true>(lds, g, S, E);
        }
        if (rep == 0) { zero_pad_rows(QKV, 2048, gw, NGW, lane);
            for (int t = blockIdx.x; t < 2048 / 16; t += G) meta_task<0>(lds, wave, HB, DM, (const bf16_t*)(ws + WS_W1IN), 1024, 16 * t, lane, QKV, 2048, ssq + 2 * MROWS, nullptr, nullptr, nullptr); }
        const float* w1f = (const float*)(ws + WS_W1F);
        {
            u32x2 hw[4], hn[4];
            if (gw < MROWS) {
#pragma unroll
                for (int j = 0; j < 4; ++j) hw[j] = ((const u32x2*)(HB + (size_t)gw * DM))[lane + 64 * j];
            }
            for (int row = gw; row < MROWS; row += NGW) {
                const int b = row / LP, pos = row % LP;
                if (row + NGW < MROWS) {
#pragma unroll
                    for (int j = 0; j < 4; ++j) hn[j] = ((const u32x2*)(HB + (size_t)(row + NGW) * DM))[lane + 64 * j];
                }
                f32x4 v[4];
#pragma unroll
                for (int j = 0; j < 4; ++j) v[j] = (f32x4){bflo(hw[j].x), bfhi(hw[j].x), bflo(hw[j].y), bfhi(hw[j].y)};
                const float rs = ssq_rs(ssq + 2 * MROWS + row);
                float mine = 0.f;
#pragma unroll
                for (int hh = 0; hh < 8; ++hh) {
                    float d = 0.f;
#pragma unroll
                    for (int j = 0; j < 4; ++j) { const f32x4 wv = ((const f32x4*)(w1f + hh * 1024))[lane + 64 * j]; d += (v[j][0] * wv[0] + v[j][1] * wv[1]) + (v[j][2] * wv[2] + v[j][3] * wv[3]); }
                    d = wave_sum(d);
                    if (lane == hh) mine = d;
                }
                if (lane < 8) Fb[((size_t)b * 8 + lane) * LP + pos] = log_sigmoid_f(mine * rs + p.in[14][lane]);
#pragma unroll
                for (int j = 0; j < 4; ++j) hw[j] = hn[j];
            }
        }
    }
    SEAM(6);
    for (int rep = 0; rep < (IN(7) ? REP7 : 0); ++rep) {
        LAS float* sc = (LAS float*)lds;
        for (int chain = blockIdx.x; chain < (rep == 0 ? 32 : 0); chain += G) {
            float* Fc = Fb + (size_t)chain * LP;
            { float km = 0.f; const int cb = chain >> 3, ch = chain & 7;
              for (int j = 0; j < 17; ++j) { const int idx = tid * 17 + j; if (idx < LP) { const u32x4* kp = (const u32x4*)(QKV + ((size_t)cb * LP + idx) * 2048 + 512 + ch * 64); float s2 = 0.f;
#pragma unroll
                  for (int q4 = 0; q4 < 8; ++q4) { const u32x4 kv = kp[q4]; const float e0 = bflo(kv.x), e1 = bfhi(kv.x), e2 = bflo(kv.y), e3 = bfhi(kv.y), e4 = bflo(kv.z), e5 = bfhi(kv.z), e6 = bflo(kv.w), e7 = bfhi(kv.w);
                      s2 += (e0 * e0 + e1 * e1) + (e2 * e2 + e3 * e3) + (e4 * e4 + e5 * e5) + (e6 * e6 + e7 * e7); }
                  km = fmaxf(km, s2); } }
#pragma unroll
              for (int o2 = 32; o2 >= 1; o2 >>= 1) km = fmaxf(km, __shfl_xor(km, o2));
              if (lane == 0) sc[512 + wave] = km;
              __syncthreads();
              if (tid == 0) { float m8 = sc[512]; for (int w8 = 1; w8 < 8; ++w8) m8 = fmaxf(m8, sc[512 + w8]); ((float*)(ws + WS_CTL + 4096))[chain] = m8; }
              __syncthreads(); }
            float loc[17]; float run = 0.f;
#pragma unroll
            for (int j = 0; j < 17; ++j) { const int idx = tid * 17 + j; const float v = (idx < LP) ? Fc[idx] : 0.f; run += v; loc[j] = run; }
            sc[tid] = run;
            __syncthreads();
            for (int off = 1; off < NTHR; off <<= 1) { const float v = sc[tid] + ((tid >= off) ? sc[tid - off] : 0.f); __syncthreads(); sc[tid] = v; __syncthreads(); }
            const float base = sc[tid] - run;
#pragma unroll
            for (int j = 0; j < 17; ++j) { const int idx = tid * 17 + j; if (idx < LP) Fc[idx] = base + loc[j]; }
            __syncthreads();
        }
        __syncthreads();
        if (G > 64) { if (blockIdx.x >= 32) s5_run<false>(p, lds + wave * 16384, (blockIdx.x - 32) * NW + wave, (G - 32) * NW, 4 * 132 * 32, lane); }
        else s5_run<false>(p, lds + wave * 16384, gw, NGW, 4 * 132 * 32, lane);
    }
    SEAM(7);
    for (int rep = 0; rep < (IN(8) ? REP8 : 0); ++rep) {
        s5_run<true>(p, lds + wave * 16384, gw, NGW, 4 * 132 * 32, lane);
        __syncthreads();
        constexpr int NFOX = 32 * 33;
        LAS int* misc = (LAS int*)(lds + att::L_MISC);
        for (;;) {
            if (tid == 0) misc[0] = (int)atomicAdd(ctl + 64 + rep, 1u);
            __syncthreads();
            const int idx = misc[0];
            __syncthreads();
            if (idx >= NFOX) break;
            const int u = 32 - idx / 32, bh = idx % 32, b = bh >> 3, h = bh & 7;
            const int r32 = lane & 31, hi = lane >> 5;
            att::Args a{QKV, 2048, b * LP, u, h * 64, 512 + h * 64, 1024 + h * 64, Fb + (size_t)bh * LP, sqrtf(((const float*)(ws + WS_CTL + 4096))[bh])};
            f32x16 o[2]; float l;
            att::run<1, 2, true>(lds, a, o, l);
            const float inv = 1.0f / l;
            bf16_t* op = CAT + (size_t)(b * LP + 256 * u + 32 * wave + r32) * DM + h * 64;
#pragma unroll
            for (int c = 0; c < 2; ++c)
#pragma unroll
                for (int g4 = 0; g4 < 4; ++g4) { const int dv = 32 * c + 8 * g4 + 4 * hi;
                    u32x2 w; w.x = pk2(o[c][4 * g4] * inv, o[c][4 * g4 + 1] * inv); w.y = pk2(o[c][4 * g4 + 2] * inv, o[c][4 * g4 + 3] * inv); *(u32x2*)(op + dv) = w; }
        }
    }
    SEAM(8);
    for (int rep = 0; rep < (IN(9) ? REP9 : 0); ++rep) {
        pg8::Gemm g{(const bf16_t*)(ws + WS_Y), (const bf16_t*)(ws + WS_WGLU), MROWS, 512, 512}; pg8::StaticOrder S; S.init(NBATCH * SEQ, 512, G, (int)blockIdx.x);
        pg8::EpiGLU E{(const bf16_t*)(ws + WS_Y), p.in[24], CAT};
        pg8::gemm_phase<pg8::EpiGLU, pg8::StaticOrder, true, true>(lds, g, S, E);
    }
    SEAM(9);
    if (IN(10)) {
        pg8::Gemm g{CAT, (const bf16_t*)(ws + WS_W1OUT), MROWS, 1024, 1024}; pg8::StaticOrder S; S.init(NBATCH * SEQ, 1024, G, (int)blockIdx.x);
        pg8::EpiResid<false> E{nullptr, HB, ssq + 3 * MROWS};
        pg8::gemm_phase<pg8::EpiResid<false>, pg8::StaticOrder, true, true>(lds, g, S, E);
    }
    SEAM(10);
    for (int rep = 0; rep < (IN(11) ? REP11 : 0); ++rep) {
        pg8::Gemm g{HB, (const bf16_t*)(ws + WS_WGU1), MROWS, 5632, 1024}; pg8::StaticOrder S; S.init(NBATCH * SEQ, 5632, G, (int)blockIdx.x);
        pg8::EpiSwiGLU E{QKV, ssq + 3 * MROWS};
        pg8::gemm_phase<pg8::EpiSwiGLU, pg8::StaticOrder, true, true>(lds, g, S, E);
    }
    SEAM(11);
    if (IN(12)) {
        pg8::Gemm g{QKV, (const bf16_t*)(ws + WS_WDN1), MROWS, 1024, 2816}; pg8::StaticOrder S; S.init(NBATCH * SEQ, 1024, G, (int)blockIdx.x);
        pg8::EpiResid<true> E{H, HB, nullptr};
        pg8::gemm_phase<pg8::EpiResid<true>, pg8::StaticOrder, true, true>(lds, g, S, E);
    }
    SEAM(12);
#ifdef EXTRA_SYNCS
    for (int k = 0; k < EXTRA_SYNCS; ++k) xcd_barrier(xbar);
#endif
    if (IN(13)) {
        const float* fg = p.in[4];
        {
            f32x4 v[4], vn[4];
            if (gw < NBATCH * SEQ) { const size_t row0 = (size_t)(gw / SEQ) * LP + 256 + (gw % SEQ);
#pragma unroll
                for (int j = 0; j < 4; ++j) v[j] = ((const f32x4*)(H + row0 * DM))[lane + 64 * j]; }
            for (int r = gw; r < NBATCH * SEQ; r += NGW) {
                const int rn = r + NGW;
                if (rn < NBATCH * SEQ) { const size_t rown = (size_t)(rn / SEQ) * LP + 256 + (rn % SEQ);
#pragma unroll
                    for (int j = 0; j < 4; ++j) vn[j] = ((const f32x4*)(H + rown * DM))[lane + 64 * j]; }
                float s = 0.f;
#pragma unroll
                for (int j = 0; j < 4; ++j) s += (v[j][0] * v[j][0] + v[j][1] * v[j][1]) + (v[j][2] * v[j][2] + v[j][3] * v[j][3]);
                const float rs = rsqrtf(wave_sum(s) * (1.0f / 1024.0f) + RMS_EPS);
#pragma unroll
                for (int j = 0; j < 4; ++j) { const f32x4 gv = ((const f32x4*)fg)[lane + 64 * j]; ((f32x4*)(p.out + (size_t)r * DM))[lane + 64 * j] = v[j] * rs * gv; }
#pragma unroll
                for (int j = 0; j < 4; ++j) v[j] = vn[j];
            }
        }
    }
#undef IN
#undef SEAM
}

#ifndef N_LAUNCH_MODE
#define N_LAUNCH_MODE 1
#endif
extern "C" void kernel_launch(void* const* d_in, const int* in_sizes, int n_in, void* d_out, int out_size, void* d_ws, size_t ws_size, hipStream_t stream) {
    static int grid = 0;
    if (grid == 0) {
        if (n_in != 27 || ws_size < WS_END || out_size != NBATCH * SEQ * DM) { fprintf(stderr, "kernel_launch: unexpected shapes (n_in %d, ws %zu, out %d)\n", n_in, ws_size, out_size); grid = -1; return; }
        int dev = 0, cus = 0, per_cu = 0;
        (void)hipGetDevice(&dev); (void)hipDeviceGetAttribute(&cus, hipDeviceAttributeMultiprocessorCount, dev);
        if (hipFuncSetAttribute((const void*)mega_fwd, hipFuncAttributeMaxDynamicSharedMemorySize, LDS_BYTES) != hipSuccess) { fprintf(stderr, "kernel_launch: hipFuncSetAttribute failed\n"); grid = -1; return; }
        if (hipOccupancyMaxActiveBlocksPerMultiprocessor(&per_cu, (const void*)mega_fwd, NTHR, LDS_BYTES) != hipSuccess || per_cu < 1) { fprintf(stderr, "kernel_launch: occupancy query says %d\n", per_cu); per_cu = 1; }
        (void)hipGetLastError();
        grid = cus * 1;
        if (grid <= 0) grid = 256;
    }
    if (grid < 0) return;
    if (hipMemsetAsync((char*)d_ws + WS_CTL, 0, 65536, stream) != hipSuccess) { fprintf(stderr, "kernel_launch: memset of the control words failed\n"); return; }
    Params p{};
    for (int i = 0; i < 27; ++i) p.in[i] = (const float*)d_in[i];
    p.out = (float*)d_out; p.ws = (unsigned char*)d_ws;
#if N_LAUNCH_MODE == 1
    p.ph_lo = 0; p.ph_hi = 14;
    void* args[] = {&p};
    hipError_t e = hipLaunchCooperativeKernel((const void*)mega_fwd, dim3(grid), dim3(NTHR), args, LDS_BYTES, stream);
    if (e != hipSuccess) fprintf(stderr, "cooperative launch failed: %s (grid %d)\n", hipGetErrorString(e), grid);
#else
    for (int ph = 0; ph < 14; ++ph) { p.ph_lo = ph; p.ph_hi = ph + 1; hipLaunchKernelGGL(mega_fwd, dim3(grid), dim3(NTHR), LDS_BYTES, stream, p); }
#endif
}
```

```cpp
#include <hip/hip_runtime.h>
#include <hip/hip_cooperative_groups.h>
#include <cstdio>
#include <cstdint>
namespace cg = cooperative_groups;

#define LAS __attribute__((address_space(3)))
constexpr int DM = 1024, NBATCH = 4, SEQ = 8192, LP = 8448, PADR = 240, NMETA = 16, MROWS = NBATCH * LP;
constexpr int DFF = 2816, NW = 8, NTHR = 512;
constexpr float C2 = 0.125f * 1.4426950408889634f;
constexpr float LOG2E = 1.4426950408889634f;
constexpr float RMS_EPS = 1e-6f;
constexpr int LDS_BYTES = 147456;

constexpr size_t MiB = 1u << 20;
constexpr size_t WS_CTL = 0;
constexpr size_t WS_SSQ = 452 * MiB;
constexpr size_t WS_F = 2 * MiB;
constexpr size_t WS_S5A = 4 * MiB;
constexpr size_t WS_S5BB = 4 * MiB + 65536;
constexpr size_t WS_S5CT = 4 * MiB + 65536 + 262144;
constexpr size_t WS_W1F = 4 * MiB + 65536 + 262144 + 131072;
constexpr size_t WS_S5BT = 4 * MiB + 524288;
constexpr size_t WS_W0IN = 6 * MiB, WS_W0OUT = 12 * MiB, WS_WGU0 = 14 * MiB, WS_WDN0 = 25 * MiB, WS_W1IN = 31 * MiB, WS_WGLU = 35 * MiB, WS_W1OUT = 36 * MiB, WS_WGU1 = 38 * MiB, WS_WDN1 = 49 * MiB;
constexpr size_t WS_H = 56 * MiB;
constexpr size_t WS_HB = 188 * MiB;
constexpr size_t WS_QKV = 254 * MiB;
constexpr size_t WS_Y = 386 * MiB;
constexpr size_t WS_E = 419 * MiB;
constexpr size_t WS_END = 454 * MiB;
constexpr size_t DO_CAT = 0, DO_STASH = 66 * MiB;

typedef unsigned short bf16_t;
typedef short bf16x8 __attribute__((ext_vector_type(8)));
typedef float f32x4 __attribute__((ext_vector_type(4)));
typedef float f32x16 __attribute__((ext_vector_type(16)));
typedef unsigned u32x4 __attribute__((ext_vector_type(4)));
typedef unsigned u32x2 __attribute__((ext_vector_type(2)));
typedef short v4i16_t __attribute__((ext_vector_type(4)));

__device__ __forceinline__ unsigned f2bf(float f) { unsigned u = __builtin_bit_cast(unsigned, f); return (u + 0x7fffu + ((u >> 16) & 1u)) >> 16; }
__device__ __forceinline__ unsigned pk2(float lo, float hi) { return f2bf(lo) | (f2bf(hi) << 16); }
__device__ __forceinline__ float bf2f(unsigned short b) { return __builtin_bit_cast(float, (unsigned)b << 16); }
__device__ __forceinline__ float bflo(unsigned w) { return __builtin_bit_cast(float, w << 16); }
__device__ __forceinline__ float bfhi(unsigned w) { return __builtin_bit_cast(float, w & 0xffff0000u); }
__device__ __forceinline__ float wave_sum(float v) {
#pragma unroll
    for (int o = 32; o >= 1; o >>= 1) v += __shfl_xor(v, o);
    return v;
}
typedef unsigned long long ssq_t;
__device__ __forceinline__ ssq_t ssq_fix(float ss) { return (ssq_t)(ss * 16777216.0f + 0.5f); }
__device__ __forceinline__ float ssq_rs(const ssq_t* p) { const ssq_t v = __hip_atomic_load(p, __ATOMIC_RELAXED, __HIP_MEMORY_SCOPE_AGENT); return rsqrtf((float)v * (1.0f / (16777216.0f * 1024.0f)) + RMS_EPS); }
__device__ __forceinline__ float fexp2(float x) { return __builtin_amdgcn_exp2f(x); }
__device__ __forceinline__ float flog2(float x) { return __builtin_amdgcn_logf(x); }
namespace pg8 {
#define PG8_LAS __attribute__((address_space(3)))
typedef unsigned short bf16_t;
typedef short bf16x8 __attribute__((ext_vector_type(8)));
typedef float f32x4 __attribute__((ext_vector_type(4)));
typedef unsigned u32x4 __attribute__((ext_vector_type(4)));
constexpr int BM = 256, BK = 64, HALF = 128, HTB = HALF * BK * 2  , STAGE_BYTES = 8 * HTB, NXCD = 8, WGM = 8;

__host__ __device__ __forceinline__ int lds_byte(int r, int c) { const int st = (r >> 4) * 2 + (c >> 5), rr = r & 15, cc = c & 31, ob = rr * 64 + cc * 2; return st * 1024 + (ob ^ (((ob >> 9) & 1) << 5)); }
__host__ __device__ __forceinline__ void stage_rc(int b, int& R, int& C) { const int st = b / 1024, sb = b % 1024, swz = sb ^ (((sb >> 9) & 1) << 5); R = (st >> 1) * 16 + swz / 64; C = (st & 1) * 32 + (swz % 64) / 2; }
__host__ __device__ __forceinline__ int perm32(int rho) { const int n = rho >> 4, i = rho & 15; return 8 * (i >> 2) + 4 * n + (i & 3); }

struct Unit { int pm, pn; };
struct Gemm { const bf16_t* A; const bf16_t* Bt; int M, N, K; };

struct StaticOrder {
    int nM, nN, nwg, G, c;
    __host__ __device__ void init(int M, int N, int G_, int c_) { nM = M / BM; nN = N / BM; nwg = nM * nN; G = G_; c = c_; }
    __host__ __device__ bool next(int i, Unit& u) const {
        const long L = (long)i * G + c; if (L >= nwg) return false;
        int wgid = (int)L; { const int q = nwg / NXCD, r = nwg % NXCD, xcd = wgid % NXCD, off = wgid / NXCD; wgid = (xcd < r ? xcd * (q + 1) : r * (q + 1) + (xcd - r) * q) + off; }
        const int nig = WGM * nN, gid = wgid / nig, fm = gid * WGM, gsz = (nM - fm) < WGM ? (nM - fm) : WGM;
        u.pm = fm + ((wgid % nig) % gsz); u.pn = (wgid % nig) / gsz;
        u.pm = u.pm + (u.pm >> 5) + 1;
        return true;
    }
    __device__ __forceinline__ void a_ready(const Unit&) const {}
    __device__ __forceinline__ void done(const Unit&) const {}
};
__device__ __forceinline__ unsigned cvt_pk_bf16(float lo, float hi) { unsigned r; asm volatile("v_cvt_pk_bf16_f32 %0, %1, %2" : "=v"(r) : "v"(lo), "v"(hi)); return r; }
typedef float f32x2 __attribute__((ext_vector_type(2)));
struct EpiScaleBf16 {
    static constexpr bool PERM = true, AFTER_DRAIN = false;
    bf16_t* O; int ldc; const ssq_t* ssq;
    __device__ __forceinline__ void pre(const Unit& u, int wr, int fr, unsigned long long (&rsv)[8]) const {
#pragma unroll
        for (int ai = 0; ai < 2; ++ai)
#pragma unroll
            for (int m = 0; m < 4; ++m) rsv[ai * 4 + m] = __hip_atomic_load(ssq + u.pm * BM + ai * HALF + wr * 64 + m * 16 + fr, __ATOMIC_RELAXED, __HIP_MEMORY_SCOPE_AGENT);
    }
    __device__ __forceinline__ void operator()(const f32x4 (&acc)[2][2][4][2], const Unit& u, int wr, int wc, int fr, int fq, const unsigned long long (&rsv)[8]) const {
        const int col0 = u.pn * BM + wc * 32 + 8 * fq;
#pragma unroll
        for (int ai = 0; ai < 2; ++ai)
#pragma unroll
            for (int m = 0; m < 4; ++m) {
                const int row = u.pm * BM + ai * HALF + wr * 64 + m * 16 + fr;
                const float rs = rsqrtf((float)rsv[ai * 4 + m] * (1.0f / (16777216.0f * 1024.0f)) + 1e-6f);
                bf16_t* rowp = O + (size_t)row * ldc + col0;
#pragma unroll
                for (int bj = 0; bj < 2; ++bj) { const f32x4 v0 = acc[ai][bj][m][0] * rs, v1 = acc[ai][bj][m][1] * rs;
                    u32x4 w; w.x = cvt_pk_bf16(v0[0], v0[1]); w.y = cvt_pk_bf16(v0[2], v0[3]); w.z = cvt_pk_bf16(v1[0], v1[1]); w.w = cvt_pk_bf16(v1[2], v1[3]);
                    *(u32x4*)(rowp + bj * HALF) = w; } }
    }
};
template <bool FINAL>
struct EpiResid {
    static constexpr bool PERM = true, AFTER_DRAIN = false;
    float* hf; bf16_t* hb; ssq_t* ssq;
    __device__ __forceinline__ void pre(const Unit&, int, int, unsigned long long (&)[8]) const {}
    __device__ __forceinline__ void operator()(const f32x4 (&acc)[2][2][4][2], const Unit& u, int wr, int wc, int fr, int fq, const unsigned long long (&rsv)[8]) const {
        const int col0 = u.pn * BM + wc * 32 + 8 * fq;
#pragma unroll
        for (int ai = 0; ai < 2; ++ai)
#pragma unroll
            for (int m = 0; m < 4; ++m) {
                const int row = u.pm * BM + ai * HALF + wr * 64 + m * 16 + fr;
                float ss = 0.f;
#pragma unroll
                for (int bj = 0; bj < 2; ++bj) {
                    bf16_t* bp = hb + (size_t)row * 1024 + col0 + bj * HALF;
                    const u32x4 hv = *(const u32x4*)bp;
                    f32x4 v0 = acc[ai][bj][m][0], v1 = acc[ai][bj][m][1];
                    v0[0] += __builtin_bit_cast(float, hv.x << 16); v0[1] += __builtin_bit_cast(float, hv.x & 0xffff0000u); v0[2] += __builtin_bit_cast(float, hv.y << 16); v0[3] += __builtin_bit_cast(float, hv.y & 0xffff0000u);
                    v1[0] += __builtin_bit_cast(float, hv.z << 16); v1[1] += __builtin_bit_cast(float, hv.z & 0xffff0000u); v1[2] += __builtin_bit_cast(float, hv.w << 16); v1[3] += __builtin_bit_cast(float, hv.w & 0xffff0000u);
                    if (FINAL) { float* hp = hf + (size_t)row * 1024 + col0 + bj * HALF; *(f32x4*)hp = v0; *(f32x4*)(hp + 4) = v1; }
                    else {
                        u32x4 w; w.x = cvt_pk_bf16(v0[0], v0[1]); w.y = cvt_pk_bf16(v0[2], v0[3]); w.z = cvt_pk_bf16(v1[0], v1[1]); w.w = cvt_pk_bf16(v1[2], v1[3]);
                        *(u32x4*)bp = w;
                        const float r0 = __builtin_bit_cast(float, w.x << 16), r1 = __builtin_bit_cast(float, w.x & 0xffff0000u), r2 = __builtin_bit_cast(float, w.y << 16), r3 = __builtin_bit_cast(float, w.y & 0xffff0000u);
                        const float r4 = __builtin_bit_cast(float, w.z << 16), r5 = __builtin_bit_cast(float, w.z & 0xffff0000u), r6 = __builtin_bit_cast(float, w.w << 16), r7 = __builtin_bit_cast(float, w.w & 0xffff0000u);
                        ss += (r0 * r0 + r1 * r1) + (r2 * r2 + r3 * r3) + (r4 * r4 + r5 * r5) + (r6 * r6 + r7 * r7);
                    }
                }
                if (!FINAL) { ss += __shfl_xor(ss, 16); ss += __shfl_xor(ss, 32); if (fq == 0) atomicAdd(ssq + row, ssq_fix(ss)); }
            }
    }
};
struct EpiSwiGLU {
    static constexpr bool PERM = true, AFTER_DRAIN = false;
    bf16_t* O; const ssq_t* ssq;
    __device__ __forceinline__ void pre(const Unit& u, int wr, int fr, unsigned long long (&rsv)[8]) const {
#pragma unroll
        for (int ai = 0; ai < 2; ++ai)
#pragma unroll
            for (int m = 0; m < 4; ++m) rsv[ai * 4 + m] = __hip_atomic_load(ssq + u.pm * BM + ai * HALF + wr * 64 + m * 16 + fr, __ATOMIC_RELAXED, __HIP_MEMORY_SCOPE_AGENT);
    }
    __device__ __forceinline__ void operator()(const f32x4 (&acc)[2][2][4][2], const Unit& u, int wr, int wc, int fr, int fq, const unsigned long long (&rsv)[8]) const {
        const int col0 = u.pn * BM + wc * 32 + 8 * fq;
#pragma unroll
        for (int ai = 0; ai < 2; ++ai)
#pragma unroll
            for (int m = 0; m < 4; ++m) {
                const int row = u.pm * BM + ai * HALF + wr * 64 + m * 16 + fr;
                const float rs = rsqrtf((float)rsv[ai * 4 + m] * (1.0f / (16777216.0f * 1024.0f)) + 1e-6f);
#pragma unroll
                for (int bj = 0; bj < 2; ++bj) { const f32x4 g = acc[ai][bj][m][0] * rs, up = acc[ai][bj][m][1] * rs; float a[4];
#pragma unroll
                    for (int e = 0; e < 4; ++e) a[e] = g[e] * __builtin_amdgcn_rcpf(1.0f + __builtin_amdgcn_exp2f(-1.4426950408889634f * g[e])) * up[e];
                    u32x2 w; w.x = cvt_pk_bf16(a[0], a[1]); w.y = cvt_pk_bf16(a[2], a[3]);
                    *(u32x2*)(O + (size_t)row * 2816 + ((col0 + bj * HALF) >> 1)) = w; } }
    }
};
struct EpiGLU {
    static constexpr bool PERM = true, AFTER_DRAIN = false;
    const bf16_t* Y; const float* bias; bf16_t* O;
    __device__ __forceinline__ void pre(const Unit&, int, int, unsigned long long (&)[8]) const {}
    __device__ __forceinline__ void operator()(const f32x4 (&acc)[2][2][4][2], const Unit& u, int wr, int wc, int fr, int fq, const unsigned long long (&rsv)[8]) const {
        const int col0 = u.pn * BM + wc * 32 + 8 * fq;
#pragma unroll
        for (int ai = 0; ai < 2; ++ai)
#pragma unroll
            for (int m = 0; m < 4; ++m) {
                const int row = u.pm * BM + ai * HALF + wr * 64 + m * 16 + fr;
#pragma unroll
                for (int bj = 0; bj < 2; ++bj) { const int col = col0 + bj * HALF;
                    const u32x4 yv = *(const u32x4*)(Y + (size_t)row * 512 + col);
                    const f32x4 b0 = *(const f32x4*)(bias + col), b1 = *(const f32x4*)(bias + col + 4);
                    const f32x4 z0 = acc[ai][bj][m][0] + b0, z1 = acc[ai][bj][m][1] + b1; float o[8];
                    const float yy[8] = {__builtin_bit_cast(float, yv.x << 16), __builtin_bit_cast(float, yv.x & 0xffff0000u), __builtin_bit_cast(float, yv.y << 16), __builtin_bit_cast(float, yv.y & 0xffff0000u),
                                         __builtin_bit_cast(float, yv.z << 16), __builtin_bit_cast(float, yv.z & 0xffff0000u), __builtin_bit_cast(float, yv.w << 16), __builtin_bit_cast(float, yv.w & 0xffff0000u)};
#pragma unroll
                    for (int e = 0; e < 4; ++e) { o[e] = yy[e] * __builtin_amdgcn_rcpf(1.0f + __builtin_amdgcn_exp2f(-1.4426950408889634f * z0[e])); o[4 + e] = yy[4 + e] * __builtin_amdgcn_rcpf(1.0f + __builtin_amdgcn_exp2f(-1.4426950408889634f * z1[e])); }
                    u32x4 w; w.x = cvt_pk_bf16(o[0], o[1]); w.y = cvt_pk_bf16(o[2], o[3]); w.z = cvt_pk_bf16(o[4], o[5]); w.w = cvt_pk_bf16(o[6], o[7]);
                    *(u32x4*)(O + (size_t)row * 1024 + 512 + col) = w; } }
    }
};
template <class Epi, class Sched, bool ALIGN_EPI = false, bool SP2 = false>
__device__ __forceinline__ void gemm_phase(PG8_LAS unsigned char* lds, const Gemm g, const Sched& S, const Epi& E) {
    int tid_l = threadIdx.x; asm volatile("" : "+v"(tid_l));
    const int tid = tid_l, wid = __builtin_amdgcn_readfirstlane(tid >> 6), lane = tid & 63, wr = wid >> 2, wc = wid & 3, fr = lane & 15, fq = lane >> 4;
    const int K = g.K, nt = K / BK;
    unsigned voffA[2], voffB[2];
#pragma unroll
    for (int i = 0; i < 2; ++i) { int R, C; stage_rc(tid * 16 + i * 8192, R, C); const int Rb = Epi::PERM ? ((R & ~31) + perm32(R & 31)) : R;
        voffA[i] = (unsigned)(R * K + C) * 2u; voffB[i] = (unsigned)(Rb * K + C) * 2u; }
    const size_t kstep = (size_t)(BK * 2);
    const size_t hstep = (size_t)HALF * K * 2;
    const size_t tstep = 2 * hstep;
    const unsigned ldsw = (unsigned)wid * 1024u;
    const int aoff = lds_byte(wr * 64 + fr, fq * 8), boff = lds_byte(wc * 32 + fr, fq * 8);
#define PG8_SA(b, h) (((b) * 2 + (h)) * HTB)
#define PG8_SB(b, h) ((4 + (b) * 2 + (h)) * HTB)
#define PG8_STAGE(bufoff, gbase, voff) do { _Pragma("unroll") for (int _i = 0; _i < 2; ++_i) \
        __builtin_amdgcn_global_load_lds((const unsigned*)((const char*)(gbase) + (voff)[_i]), (PG8_LAS unsigned*)(lds + (bufoff) + ldsw + _i * 8192), 16, 0, 0); } while (0)
#define PG8_LDA(dst, b, h) do { _Pragma("unroll") for (int m = 0; m < 4; ++m) _Pragma("unroll") for (int k = 0; k < 2; ++k) dst[m][k] = *(const PG8_LAS bf16x8*)(lds + PG8_SA(b, h) + aoff + m * 2048 + k * 1024); } while (0)
#define PG8_LDB(dst, b, h) do { _Pragma("unroll") for (int n = 0; n < 2; ++n) _Pragma("unroll") for (int k = 0; k < 2; ++k) dst[n][k] = *(const PG8_LAS bf16x8*)(lds + PG8_SB(b, h) + boff + n * 2048 + k * 1024); } while (0)
#define PG8_MMA(ai, bj, At, Bt) do { __builtin_amdgcn_s_setprio(1); _Pragma("unroll") for (int m = 0; m < 4; ++m) _Pragma("unroll") for (int n = 0; n < 2; ++n) _Pragma("unroll") for (int k = 0; k < 2; ++k) \
        acc[ai][bj][m][n] = __builtin_amdgcn_mfma_f32_16x16x32_bf16(Bt[n][k], At[m][k], acc[ai][bj][m][n], 0, 0, 0); __builtin_amdgcn_s_setprio(0); } while (0)
#define PG8_WAIT_V(n) asm volatile("s_waitcnt vmcnt(" #n ")" ::: "memory")
#define PG8_WAIT_L(n) asm volatile("s_waitcnt lgkmcnt(" #n ")" ::: "memory")
#define PG8_BAR __builtin_amdgcn_s_barrier()
#define PG8_SCHED __builtin_amdgcn_sched_barrier(0)
    Unit cur, nxt; int ui = 0;
    if (!S.next(0, cur)) return;
    f32x4 acc[2][2][4][2];
    unsigned long long rsv[8];
#pragma unroll
    for (int i_ = 0; i_ < 8; ++i_) rsv[i_] = 0ull;
#pragma unroll
    for (int a = 0; a < 2; ++a)
#pragma unroll
        for (int b = 0; b < 2; ++b)
#pragma unroll
            for (int m = 0; m < 4; ++m)
#pragma unroll
                for (int n = 0; n < 2; ++n) acc[a][b][m][n] = (f32x4){0.f, 0.f, 0.f, 0.f};
    bf16x8 At[4][2], B0[2][2], B1[2][2];
    const char* cA = (const char*)g.A + (size_t)cur.pm * tstep; const char* cB = (const char*)g.Bt + (size_t)cur.pn * tstep;
    S.a_ready(cur);
    if constexpr (SP2) {
        PG8_STAGE(PG8_SB(0, 0), cB, voffB); PG8_STAGE(PG8_SB(0, 1), cB + hstep, voffB); PG8_STAGE(PG8_SA(0, 0), cA, voffA); PG8_STAGE(PG8_SA(0, 1), cA + hstep, voffA);
        if (wr == 1) PG8_BAR;
        PG8_WAIT_V(2); PG8_BAR;
        PG8_STAGE(PG8_SB(1, 0), cB + kstep, voffB); PG8_STAGE(PG8_SA(1, 0), cA + kstep, voffA); PG8_STAGE(PG8_SB(1, 1), cB + hstep + kstep, voffB);
        PG8_WAIT_V(6); PG8_BAR;
    } else {
        PG8_STAGE(PG8_SB(0, 0), cB, voffB); PG8_STAGE(PG8_SA(0, 0), cA, voffA); PG8_STAGE(PG8_SB(0, 1), cB + hstep, voffB); PG8_STAGE(PG8_SA(0, 1), cA + hstep, voffA);
        if (wr == 1) PG8_BAR;
        PG8_WAIT_V(4); PG8_BAR;
        PG8_STAGE(PG8_SB(1, 0), cB + kstep, voffB); PG8_STAGE(PG8_SA(1, 0), cA + kstep, voffA); PG8_STAGE(PG8_SB(1, 1), cB + hstep + kstep, voffB);
        PG8_WAIT_V(6); PG8_BAR;
    }
    for (;;) {
        const bool has_next = S.next(ui + 1, nxt);
        const char* nA = has_next ? (const char*)g.A + (size_t)nxt.pm * tstep : cA; const char* nB = has_next ? (const char*)g.Bt + (size_t)nxt.pn * tstep : cB;
        for (int t = 0; t < nt; t += 2) {
            const bool last = (t == nt - 2);
            if (last) E.pre(cur, wr, fr, rsv);
            const char* a1 = cA + (size_t)(t + 1) * kstep;
            const char* a2 = last ? nA : cA + (size_t)(t + 2) * kstep; const char* b2 = last ? nB : cB + (size_t)(t + 2) * kstep;
            const char* a3 = a2 + kstep; const char* b3 = b2 + kstep;
            if (last && has_next) S.a_ready(nxt);
            if constexpr (SP2) {
            PG8_LDB(B0, 0, 0); PG8_LDB(B1, 0, 1); PG8_SCHED; PG8_LDA(At, 0, 0); PG8_STAGE(PG8_SA(1, 1), a1 + hstep, voffA);
            PG8_WAIT_V(8); PG8_WAIT_L(0); PG8_BAR; PG8_MMA(0, 0, At, B0); PG8_MMA(0, 1, At, B1); PG8_BAR; PG8_SCHED;
            PG8_LDA(At, 0, 1); PG8_STAGE(PG8_SB(0, 0), b2, voffB); PG8_STAGE(PG8_SB(0, 1), b2 + hstep, voffB); PG8_STAGE(PG8_SA(0, 0), a2, voffA);
            PG8_WAIT_V(8); PG8_WAIT_L(0); PG8_BAR; PG8_MMA(1, 0, At, B0); PG8_MMA(1, 1, At, B1); PG8_BAR; PG8_SCHED;
            PG8_LDB(B0, 1, 0); PG8_LDB(B1, 1, 1); PG8_SCHED; PG8_LDA(At, 1, 0); PG8_STAGE(PG8_SA(0, 1), a2 + hstep, voffA);
            PG8_WAIT_V(8); PG8_WAIT_L(0); PG8_BAR; PG8_MMA(0, 0, At, B0); PG8_MMA(0, 1, At, B1); PG8_BAR; PG8_SCHED;
            PG8_LDA(At, 1, 1); PG8_STAGE(PG8_SB(1, 0), b3, voffB); PG8_STAGE(PG8_SB(1, 1), b3 + hstep, voffB); PG8_STAGE(PG8_SA(1, 0), a3, voffA);
            PG8_WAIT_V(8); PG8_WAIT_L(0); PG8_BAR; PG8_MMA(1, 0, At, B0); PG8_MMA(1, 1, At, B1); PG8_BAR; PG8_SCHED;
            } else {
            PG8_LDB(B0, 0, 0); PG8_SCHED; PG8_LDA(At, 0, 0); PG8_STAGE(PG8_SA(1, 1), a1 + hstep, voffA);
            PG8_WAIT_L(8); PG8_BAR; PG8_WAIT_L(0); PG8_MMA(0, 0, At, B0); PG8_BAR; PG8_SCHED;
            PG8_LDB(B1, 0, 1); PG8_STAGE(PG8_SB(0, 0), b2, voffB);
            PG8_BAR; PG8_WAIT_L(0); PG8_MMA(0, 1, At, B1); PG8_BAR;
            PG8_LDA(At, 0, 1); PG8_STAGE(PG8_SA(0, 0), a2, voffA);
            PG8_BAR; PG8_WAIT_L(0); PG8_MMA(1, 0, At, B0); PG8_BAR; PG8_SCHED;
            PG8_STAGE(PG8_SB(0, 1), b2 + hstep, voffB);
            PG8_WAIT_V(6); PG8_BAR; PG8_MMA(1, 1, At, B1); PG8_BAR;
            PG8_LDB(B0, 1, 0); PG8_SCHED; PG8_LDA(At, 1, 0); PG8_STAGE(PG8_SA(0, 1), a2 + hstep, voffA);
            PG8_WAIT_L(8); PG8_BAR; PG8_WAIT_L(0); PG8_MMA(0, 0, At, B0); PG8_BAR; PG8_SCHED;
            PG8_LDB(B1, 1, 1); PG8_STAGE(PG8_SB(1, 0), b3, voffB);
            PG8_BAR; PG8_WAIT_L(0); PG8_MMA(0, 1, At, B1); PG8_BAR;
            PG8_LDA(At, 1, 1); PG8_STAGE(PG8_SA(1, 0), a3, voffA);
            PG8_BAR; PG8_WAIT_L(0); PG8_MMA(1, 0, At, B0); PG8_BAR; PG8_SCHED;
            PG8_STAGE(PG8_SB(1, 1), b3 + hstep, voffB);
            PG8_WAIT_V(6); PG8_BAR; PG8_MMA(1, 1, At, B1); PG8_BAR;
            }
        }
        if constexpr (ALIGN_EPI) { if (wr == 0) PG8_BAR; }
        if constexpr (!Epi::AFTER_DRAIN) { E(acc, cur, wr, wc, fr, fq, rsv); S.done(cur); }
        if (!has_next) break;
#pragma unroll
        for (int a = 0; a < 2; ++a)
#pragma unroll
            for (int b = 0; b < 2; ++b)
#pragma unroll
                for (int m = 0; m < 4; ++m)
#pragma unroll
                    for (int n = 0; n < 2; ++n) acc[a][b][m][n] = (f32x4){0.f, 0.f, 0.f, 0.f};
        cur = nxt; cA = nA; cB = nB; ++ui;
        if constexpr (ALIGN_EPI) { if (wr == 1) PG8_BAR; }
    }
    PG8_WAIT_V(0);
    if constexpr (!ALIGN_EPI) { if (wr == 0) PG8_BAR; }
    PG8_BAR;
    if constexpr (Epi::AFTER_DRAIN) { E.fused(acc, cur, wr, wc, fr, fq, lds, wid, lane); S.done(cur); }
#undef PG8_SA
#undef PG8_SB
#undef PG8_STAGE
#undef PG8_LDA
#undef PG8_LDB
#undef PG8_MMA
#undef PG8_WAIT_V
#undef PG8_WAIT_L
#undef PG8_BAR
#undef PG8_SCHED
}
}
namespace att {
constexpr int KROW = 144, KBUF = 64 * KROW;
constexpr int VBUF = 16384;
constexpr int L_K = 0, L_V = 2 * KBUF, L_BIAS = L_V + 3 * VBUF, L_FLAG = L_BIAS + 2 * 64 * 4, L_MISC = L_FLAG + 64, L_END = L_MISC + 64;
__device__ __forceinline__ int crow(int r, int hi) { return (r & 3) + 8 * (r >> 2) + 4 * hi; }
__device__ __forceinline__ unsigned cvtpk(float lo, float hi) { unsigned r; asm volatile("v_cvt_pk_bf16_f32 %0, %1, %2" : "=v"(r) : "v"(lo), "v"(hi)); return r; }

struct Args { const bf16_t* qkv; int pitch; int rowb; int u; int qcol, kcol, vcol; const float* F; float kmax; };


template <bool MASKED>
__device__ __forceinline__ void sb_tile(f32x16 (&x)[2], float& carry, int tlo, int hi, int qpos) {
#pragma unroll
                for (int xt = 1; xt >= 0; --xt) {
                    float lm[16], G[4], Gp[4];
#pragma unroll
                    for (int r = 0; r < 16; ++r) {
                        const float z = x[xt][r], sp = __builtin_amdgcn_fmed3f(z, 0.f, __builtin_inff()) + flog2(1.0f + fexp2(-fabsf(z)));
                        bool valid = true;
                        if (MASKED) { const int kvp = tlo + 32 * xt + crow(r, hi); valid = (kvp < qpos) && (kvp >= PADR); }
                        lm[r] = valid ? -sp : 0.f;
                        x[xt][r] = valid ? (z - sp) : -1e30f;
                    }
#pragma unroll
                    for (int g = 0; g < 4; ++g) { G[g] = (lm[4 * g] + lm[4 * g + 1]) + (lm[4 * g + 2] + lm[4 * g + 3]); Gp[g] = __shfl_xor(G[g], 32); }
                    float runv = carry;
#pragma unroll
                    for (int g = 3; g >= 0; --g) {
                        const float g1 = hi ? G[g] : Gp[g], g0 = hi ? Gp[g] : G[g];
                        const float sg = hi ? runv : (runv + g1);
                        const float c3 = sg, c2 = c3 + lm[4 * g + 3], c1 = c2 + lm[4 * g + 2], c0 = c1 + lm[4 * g + 1];
                        x[xt][4 * g + 3] = fexp2(x[xt][4 * g + 3] + c3); x[xt][4 * g + 2] = fexp2(x[xt][4 * g + 2] + c2);
                        x[xt][4 * g + 1] = fexp2(x[xt][4 * g + 1] + c1); x[xt][4 * g] = fexp2(x[xt][4 * g] + c0);
                        runv = runv + (g1 + g0);
                    }
                    carry = runv;
                }
}
template <int MODE, int NDV, bool BIAS>
__device__ __forceinline__ void tile_compute(LAS unsigned char* lds, int kt, int buf, int vs, const bf16x8 (&qf)[4], f32x16 (&o)[NDV],
                                             float& mrun, float& lrun, float& carry, f32x16& negm, f32x16& osum, bool wdone, bool& pend, int& vsp, int w, int lane, int r32, int hi, int qmin, int qpos, unsigned vlane) {
#define ATT_PV(VS_) do { const unsigned vba = (unsigned)(uintptr_t)(lds + L_V + (VS_) * VBUF + vlane);     \
        _Pragma("unroll") for (int ks = 0; ks < 4; ++ks) { \
            v4i16_t lo_[NDV], hh_[NDV]; \
            _Pragma("unroll") for (int c = 0; c < NDV; ++c) { \
                asm volatile("ds_read_b64_tr_b16 %0, %1 offset:%c2" : "=&v"(lo_[c]) : "v"(vba), "i"((2 * ks) * (NDV * 512) + 512 * c) : "memory"); \
                asm volatile("ds_read_b64_tr_b16 %0, %1 offset:%c2" : "=&v"(hh_[c]) : "v"(vba), "i"((2 * ks + 1) * (NDV * 512) + 512 * c) : "memory"); } \
            if (NDV == 4) asm volatile("s_waitcnt lgkmcnt(0)" : "+v"(lo_[0]), "+v"(hh_[0]), "+v"(lo_[1]), "+v"(hh_[1]), "+v"(lo_[2 % NDV]), "+v"(hh_[2 % NDV]), "+v"(lo_[3 % NDV]), "+v"(hh_[3 % NDV]) :: "memory");     \
            else asm volatile("s_waitcnt lgkmcnt(0)" : "+v"(lo_[0]), "+v"(hh_[0]), "+v"(lo_[1]), "+v"(hh_[1]) :: "memory"); \
            bf16x8 pb; { u32x4 t4 = {pk[ks][0], pk[ks][1], pk[ks][2], pk[ks][3]}; pb = __builtin_bit_cast(bf16x8, t4); } \
            _Pragma("unroll") for (int c = 0; c < NDV; ++c) { \
                const bf16x8 va = {lo_[c][0], lo_[c][1], lo_[c][2], lo_[c][3], hh_[c][0], hh_[c][1], hh_[c][2], hh_[c][3]}; \
                o[c] = __builtin_amdgcn_mfma_f32_32x32x16_bf16(va, pb, o[c], 0, 0, 0); } } } while (0)
        const int tlo = 64 * kt;
        const bool skip = wdone || ((MODE == 0) ? (tlo >= qmin + 31) : (tlo > qmin + 31));
        if (!skip) {
            unsigned pk[4][4];
            const bool needmask = (kt == 3) || ((MODE == 0) ? (tlo + 63 >= qmin) : (tlo + 63 > qmin));
            const LAS unsigned char* kb = lds + L_K + buf * KBUF + r32 * KROW + 16 * hi;
            f32x16 x[2];
#pragma unroll
            for (int xt = 0; xt < 2; ++xt) {
                if (BIAS) {
                    const LAS float* bp = (const LAS float*)(lds + L_BIAS + buf * 256) + 32 * xt + 4 * hi;
#pragma unroll
                    for (int g = 0; g < 4; ++g) { const f32x4 bv = *(const LAS f32x4*)(bp + 8 * g); x[xt][4 * g] = bv[0]; x[xt][4 * g + 1] = bv[1]; x[xt][4 * g + 2] = bv[2]; x[xt][4 * g + 3] = bv[3]; }
                } else if (MODE == 0) {
#pragma unroll
                    for (int r = 0; r < 16; ++r) x[xt][r] = 0.f;
                }
#pragma unroll
                for (int d0 = 0; d0 < 4; ++d0) { const bf16x8 kf = *(const LAS bf16x8*)(kb + xt * 32 * KROW + 32 * d0);
                    if (MODE == 1 && !BIAS && d0 == 0) x[xt] = __builtin_amdgcn_mfma_f32_32x32x16_bf16(kf, qf[d0], negm, 0, 0, 0);
                    else x[xt] = __builtin_amdgcn_mfma_f32_32x32x16_bf16(kf, qf[d0], x[xt], 0, 0, 0); }
            }
            if (MODE == 1) {
                if (needmask) {
#pragma unroll
                    for (int xt = 0; xt < 2; ++xt)
#pragma unroll
                        for (int r = 0; r < 16; ++r) { const int kvp = tlo + 32 * xt + crow(r, hi); if (kvp > qpos || kvp < PADR) x[xt][r] = -1e30f; }
                }
                float mx = x[0][0];
#pragma unroll
                for (int r = 1; r < 16; ++r) mx = fmaxf(mx, x[0][r]);
#pragma unroll
                for (int r = 0; r < 16; ++r) mx = fmaxf(mx, x[1][r]);
                if (BIAS) {
                    mx = fmaxf(mx, __shfl_xor(mx, 32));
                    const float mnew = fmaxf(mrun, mx), alpha = fexp2(mrun - mnew); mrun = mnew;
#pragma unroll
                    for (int xt = 0; xt < 2; ++xt)
#pragma unroll
                        for (int r = 0; r < 16; ++r) x[xt][r] = fexp2(x[xt][r] - mnew);
                    if (__any(alpha != 1.0f)) {
#pragma unroll
                        for (int c = 0; c < NDV; ++c)
#pragma unroll
                            for (int r = 0; r < 16; ++r) o[c][r] *= alpha;
#pragma unroll
                        for (int r = 0; r < 16; ++r) osum[r] *= alpha;
                    }
                } else {
                    const bool first = (carry == 0.f);
                    if (first || __any(mx > 8.0f)) {
                        carry = 1.f;
                        mx = fmaxf(mx, __shfl_xor(mx, 32));
                        const float dl = first ? ((mx > -1e29f) ? mx : 0.f) : fmaxf(mx, 0.f);
                        const float alpha = first ? 1.0f : fexp2(-dl);
                        mrun += dl; lrun *= alpha;
#pragma unroll
                        for (int xt = 0; xt < 2; ++xt)
#pragma unroll
                            for (int r = 0; r < 16; ++r) x[xt][r] -= dl;
#pragma unroll
                        for (int r = 0; r < 16; ++r) negm[r] = -mrun;
#pragma unroll
                        for (int c = 0; c < NDV; ++c)
#pragma unroll
                            for (int r = 0; r < 16; ++r) o[c][r] *= alpha;
                    }
                    float ps = 0.f;
#pragma unroll
                    for (int xt = 0; xt < 2; ++xt)
#pragma unroll
                        for (int r = 0; r < 16; ++r) { const float pv = fexp2(x[xt][r]); x[xt][r] = pv; ps += pv; }
                    lrun += ps;
                }
            } else {
                if (needmask) sb_tile<true>(x, carry, tlo, hi, qpos); else sb_tile<false>(x, carry, tlo, hi, qpos);
            }
#pragma unroll
            for (int ks = 0; ks < 4; ++ks)
#pragma unroll
                for (int j = 0; j < 4; ++j) pk[ks][j] = cvtpk(x[ks >> 1][8 * (ks & 1) + 2 * j], x[ks >> 1][8 * (ks & 1) + 2 * j + 1]);
            if (BIAS) {
                const bf16x8 ones = {(short)0x3F80, (short)0x3F80, (short)0x3F80, (short)0x3F80, (short)0x3F80, (short)0x3F80, (short)0x3F80, (short)0x3F80};
#pragma unroll
                for (int ks = 0; ks < 4; ++ks) { const u32x4 t4 = {pk[ks][0], pk[ks][1], pk[ks][2], pk[ks][3]}; osum = __builtin_amdgcn_mfma_f32_32x32x16_bf16(ones, __builtin_bit_cast(bf16x8, t4), osum, 0, 0, 0); }
            }
            ATT_PV(vs);
        }
}
#undef ATT_PV

template <int MODE, int NDV, bool BIAS>
__device__ __forceinline__ void run(LAS unsigned char* lds, const Args& a, f32x16 (&o)[NDV], float& l_out) {
    int tid_l = threadIdx.x; asm volatile("" : "+v"(tid_l));
    const int tid = tid_l, lane = tid & 63, w = __builtin_amdgcn_readfirstlane(tid >> 6), r32 = lane & 31, hi = lane >> 5;
    const int qmin = 256 * a.u + 32 * w, qpos = qmin + r32;
    constexpr int NV = NDV / 2;
    bf16x8 qf[4];
    { const bf16_t* qp = a.qkv + (size_t)(a.rowb + qpos) * a.pitch + a.qcol + 8 * hi;
#pragma unroll
      for (int d0 = 0; d0 < 4; ++d0) qf[d0] = *(const bf16x8*)(qp + 16 * d0); }
    float qkb = 0.f;
    if (BIAS) { float s2 = 0.f;
#pragma unroll
        for (int d0 = 0; d0 < 4; ++d0)
#pragma unroll
            for (int j = 0; j < 8; ++j) { const float qv = bf2f((unsigned short)qf[d0][j]); s2 += qv * qv; }
        s2 += __shfl_xor(s2, 32); qkb = sqrtf(s2) * a.kmax * 1.001f + 1e-3f; }
    const int kr = tid >> 3, kc = tid & 7;
    const bf16_t* kg = a.qkv + (size_t)(a.rowb + kr) * a.pitch + a.kcol + 8 * kc;
    const unsigned klds = kr * KROW + kc * 16;
    const bf16_t* vg[NV]; unsigned vlds[NV];
#pragma unroll
    for (int j = 0; j < NV; ++j) {
        int vr, ch; if (NDV == 2) { vr = tid >> 3; ch = tid & 7; } else { vr = (tid >> 4) + 32 * j; ch = tid & 15; }
        vg[j] = a.qkv + (size_t)(a.rowb + vr) * a.pitch + a.vcol + 8 * ch;
        vlds[j] = (vr >> 3) * (NDV * 512) + (ch >> 2) * 512 + (vr & 7) * 64 + (ch & 3) * 16;
    }
    const size_t tstride = (size_t)64 * a.pitch;
    float fq0 = 0.f; if (BIAS) fq0 = a.F[256 * a.u];
    const int ntile = 4 * a.u + 1;
#define ATT_TILE(i) ((MODE == 0 || BIAS) ? (4 * a.u + 3 - (i)) : (3 + (i)))
    u32x4 kregA, vregA[NV]; float bregA = 0.f, ubnA = 0.f, ubn_next = 0.f;
#define ATT_LOADX(KR, VR, BR, UB, kt) do { KR = *(const u32x4*)(kg + (size_t)(kt) * tstride); _Pragma("unroll") for (int j_ = 0; j_ < NV; ++j_) VR[j_] = *(const u32x4*)(vg[j_] + (size_t)(kt) * tstride); \
        if (BIAS) { if (tid < 64) BR = (fq0 - a.F[64 * (kt) + tid]) * LOG2E; UB = (fq0 - a.F[64 * (kt) + 63]) * LOG2E; } } while (0)
#define ATT_WRITEX(KR, VR, BR, UB, b, vs_) do { *(LAS u32x4*)(lds + L_K + (b) * KBUF + klds) = KR; _Pragma("unroll") for (int j_ = 0; j_ < NV; ++j_) *(LAS u32x4*)(lds + L_V + (vs_) * VBUF + vlds[j_]) = VR[j_]; \
        if (BIAS) { if (tid < 64) *(LAS float*)(lds + L_BIAS + (b) * 256 + tid * 4) = BR; ubn_next = UB; } } while (0)
#define ATT_LOADA(kt) ATT_LOADX(kregA, vregA, bregA, ubnA, kt)
#define ATT_WRITEA(b, vs_) ATT_WRITEX(kregA, vregA, bregA, ubnA, b, vs_)
#pragma unroll
    for (int c = 0; c < NDV; ++c)
#pragma unroll
        for (int r = 0; r < 16; ++r) o[c][r] = 0.f;
    float mrun = (MODE == 1 && !BIAS) ? 0.f : -1e30f, lrun = 0.f, carry = 0.f;
    f32x16 negm, osum;
#pragma unroll
    for (int r = 0; r < 16; ++r) { negm[r] = 0.f; osum[r] = 0.f; }
    const unsigned vlane = 64 * (4 * hi + ((lane & 15) >> 2)) + 32 * ((lane >> 4) & 1) + 8 * (lane & 3);
    ATT_LOADA(ATT_TILE(0)); ATT_WRITEA(0, 0);
    asm volatile("" :: "v"(qf[0]), "v"(qf[1]), "v"(qf[2]), "v"(qf[3]));
    __syncthreads();
    bool pend = false; int vsp = 0, vs = 0;
#define ATT_ITER(i_) do { \
        const int kt_ = ATT_TILE(i_), buf_ = (i_) & 1; vs = (i_) % 3; \
        if ((i_) + 1 < ntile) ATT_LOADA(ATT_TILE((i_) + 1)); \
        bool wdone_ = false; if (MODE == 0) wdone_ = __all(carry < -160.0f) != 0; if (BIAS) wdone_ = __all(qkb + ub_cur - mrun < -160.0f) != 0; \
        tile_compute<MODE, NDV, BIAS>(lds, kt_, buf_, vs, qf, o, mrun, lrun, carry, negm, osum, wdone_, pend, vsp, w, lane, r32, hi, qmin, qpos, vlane); \
        if (MODE == 0) { const int ok = __all(carry < -160.0f) ? 1 : 0; if (lane == 0) *(LAS int*)(lds + L_FLAG + (buf_ * 8 + w) * 4) = ok; } \
        if ((i_) + 1 < ntile) ATT_WRITEA(buf_ ^ 1, ((i_) + 1) % 3); \
        ub_cur = ubn_next; \
        if (BIAS) { const int ok = __all(qkb + ubn_next - mrun < -160.0f) ? 1 : 0; if (lane == 0) *(LAS int*)(lds + L_FLAG + (buf_ * 8 + w) * 4) = ok; } \
        __syncthreads(); \
        if (MODE == 0 || BIAS) { const LAS int* fl = (const LAS int*)(lds + L_FLAG + buf_ * 32); \
            if (fl[0] & fl[1] & fl[2] & fl[3] & fl[4] & fl[5] & fl[6] & fl[7]) stop = true; } } while (0)
    bool stop = false;
    float ub_cur = ubn_next;
    for (int i = 0; i < ntile && !stop; ++i) ATT_ITER(i);
    __syncthreads();
    l_out = BIAS ? osum[0] : (lrun + __shfl_xor(lrun, 32));
#undef ATT_TILE
#undef ATT_LOADX
#undef ATT_WRITEX
#undef ATT_LOADA
#undef ATT_WRITEA
#undef ATT_ITER
}
}
struct Params { const float* in[27]; float* out; unsigned char* ws; int ph_lo, ph_hi; };

__device__ __forceinline__ float log_sigmoid_f(float x) { return -(fmaxf(-x, 0.f) + log1pf(expf(-fabsf(x)))); }
__device__ __forceinline__ float gelu_tanh_f(float x) { const float z = 0.7978845608028654f * (x + 0.044715f * x * x * x); const float t = 1.0f - 2.0f / (__expf(2.0f * z) + 1.0f); return 0.5f * x * (1.0f + t); }

__device__ __forceinline__ void map_col(int kind, int n, int& dr, float& sc) {
    sc = 1.0f; dr = n;
    if (kind == 1) { if (n < 512 || (n >= 1536 && n < 2048)) sc = C2; }
    else if (kind == 2) { if (n < 512) sc = C2; else if (n >= 1536 && n < 1544) dr = -1; else if (n >= 1544) dr = n - 8; }
    else if (kind == 3) { if (n < 2816) dr = 8 * (n >> 2) + (n & 3); else { const int j = n - 2816; dr = 8 * (j >> 2) + 4 + (j & 3); } }
}
__device__ __forceinline__ void transpose_item(const float* W, int K, int N, const float* gk, bf16_t* WT, int kind, LAS float* scr, int item, int lane) {
    const int nblk = (N + 31) / 32, kb = item / nblk, nb = item % nblk, k0 = 64 * kb, n0 = 32 * nb;
    float wv[32];
    { const int n = n0 + (lane & 31); const bool inb = n < N; const float* wp = W + (size_t)(k0 + (lane >> 5)) * N + (inb ? n : 0);
#pragma unroll
      for (int i = 0; i < 32; ++i) wv[i] = inb ? wp[(size_t)(2 * i) * N] : 0.f;
      if (gk) {
#pragma unroll
          for (int i = 0; i < 32; ++i) wv[i] *= gk[k0 + 2 * i + (lane >> 5)];
      }
#pragma unroll
      for (int i = 0; i < 32; ++i) scr[(2 * i + (lane >> 5)) * 33 + (lane & 31)] = wv[i]; }
    asm volatile("s_waitcnt lgkmcnt(0)" ::: "memory");
    const int c = lane & 7;
#pragma unroll
    for (int j = 0; j < 4; ++j) { const int nl = (lane >> 3) + 8 * j, n = n0 + nl;
        if (n < N) { int dr; float sc; map_col(kind, n, dr, sc);
            if (dr >= 0) { const LAS float* s = scr + (8 * c) * 33 + nl;
                u32x4 o; o.x = pk2(s[0 * 33] * sc, s[1 * 33] * sc); o.y = pk2(s[2 * 33] * sc, s[3 * 33] * sc); o.z = pk2(s[4 * 33] * sc, s[5 * 33] * sc); o.w = pk2(s[6 * 33] * sc, s[7 * 33] * sc);
                *(u32x4*)(WT + (size_t)dr * K + k0 + 8 * c) = o; } } }
    asm volatile("s_waitcnt lgkmcnt(0)" ::: "memory");
}

struct S5Ops { float ar, ai, dsk; bf16x8 bfr[4], af[2], cf[4]; unsigned short uq[16]; };
template <bool FINAL>
__device__ __forceinline__ void s5_load(const Params& p, int item, int lane, S5Ops& q) {
    const int g = item & 31, bc = item >> 5, c = bc % 132, b = bc / 132;
    const unsigned char* ws = p.ws;
    const bf16_t* qkv = (const bf16_t*)(ws + WS_QKV);
    const float* a_re_p = (const float*)(ws + WS_S5A); const float* a_im_p = a_re_p + 2048;
    const int gp = g * 64 + lane, r32 = lane & 31, hi = lane >> 5;
    q.ar = a_re_p[gp]; q.ai = a_im_p[gp];
    { const bf16_t* bt = (const bf16_t*)(ws + WS_S5BT) + ((size_t)g * 128 + r32) * 16 + 8 * hi;
#pragma unroll
      for (int pb = 0; pb < 4; ++pb) q.bfr[pb] = *(const bf16x8*)(bt + pb * 32 * 16); }
    const bf16_t* urow = qkv + ((size_t)b * LP + 64 * c) * 2048 + 1536 + 16 * g;
#pragma unroll
    for (int sub = 0; sub < 2; ++sub) q.af[sub] = *(const bf16x8*)(urow + (size_t)(32 * sub + r32) * 2048 + 8 * hi);
    q.dsk = 0.f;
    if (FINAL) {
        const bf16_t* ct = (const bf16_t*)(ws + WS_S5CT) + ((size_t)g * 16 + (lane & 15)) * 128 + 8 * (lane >> 4);
#pragma unroll
        for (int ks = 0; ks < 4; ++ks) q.cf[ks] = *(const bf16x8*)(ct + 32 * ks);
        q.dsk = p.in[22][g * 16 + (lane & 15)];
#pragma unroll
        for (int k = 0; k < 16; ++k) { const int t = 32 * (k >> 3) + 16 * ((k >> 2) & 1) + 4 * (lane >> 4) + (k & 3); q.uq[k] = urow[(size_t)t * 2048 + (lane & 15)]; }
    }
}
template <bool FINAL>
__device__ __forceinline__ void s5_compute(const Params& p, LAS unsigned char* wl  , int item, int lane, const S5Ops& q) {
    const int g = item & 31, bc = item >> 5, c = bc % 132, b = bc / 132;
    const unsigned char* ws = p.ws;
    float2* E = (float2*)(ws + WS_E);
    const int r32 = lane & 31, hi = lane >> 5;
    const float ar = q.ar, ai = q.ai;
    float xr = 0.f, xi = 0.f;
    if (FINAL) {
        float pr_ = ar, pi_ = ai;
#pragma unroll
        for (int s = 0; s < 6; ++s) { const float nr = pr_ * pr_ - pi_ * pi_, ni = 2.0f * pr_ * pi_; pr_ = nr; pi_ = ni; }
        const float2* Eb = E + ((size_t)b * 132 * 32 + g) * 64 + lane;
        int cc = 0;
        for (; cc + 8 <= c; cc += 8) {
            float2 e[8];
#pragma unroll
            for (int k = 0; k < 8; ++k) e[k] = Eb[(size_t)(cc + k) * 32 * 64];
#pragma unroll
            for (int k = 0; k < 8; ++k) { const float nr = pr_ * xr - pi_ * xi + e[k].x, ni = pr_ * xi + pi_ * xr + e[k].y; xr = nr; xi = ni; }
        }
        for (; cc < c; ++cc) { const float2 e = Eb[(size_t)cc * 32 * 64]; const float nr = pr_ * xr - pi_ * xi + e.x, ni = pr_ * xi + pi_ * xr + e.y; xr = nr; xi = ni; }
    }
    LAS float* BU = (LAS float*)wl;
#pragma unroll 1
    for (int sub = 0; sub < 2; ++sub) {
#pragma unroll
        for (int pb = 0; pb < 4; ++pb) {
            f32x16 z;
#pragma unroll
            for (int r = 0; r < 16; ++r) z[r] = 0.f;
            const f32x16 d = __builtin_amdgcn_mfma_f32_32x32x16_bf16(sub == 0 ? q.af[0] : q.af[1], q.bfr[pb], z, 0, 0, 0);
#pragma unroll
            for (int r = 0; r < 16; ++r) BU[((r & 3) + 8 * (r >> 2) + 4 * hi) * 128 + 32 * pb + r32] = d[r];
        }
        asm volatile("s_waitcnt lgkmcnt(0)" ::: "memory");
        const unsigned xb_re = (unsigned)(uintptr_t)wl + (((unsigned)lane >> 3) << 4) + (((unsigned)lane & 7u) << 1), xb_im = xb_re + 128u;
#pragma unroll 1
        for (int h2 = 0; h2 < 2; ++h2) {
            const LAS float* BUh = BU + h2 * 16 * 128;
            const unsigned xr_b = xb_re + h2 * 8192u, xi_b = xb_im + h2 * 8192u;
#pragma unroll
            for (int t16 = 0; t16 < 16; ++t16) {
                const float sr = BUh[t16 * 128 + lane], si = BUh[t16 * 128 + 64 + lane];
                const float nr = ar * xr - ai * xi + sr, ni = ar * xi + ai * xr + si; xr = nr; xi = ni;
                if (FINAL) {
                    const unsigned xp = pg8::cvt_pk_bf16(xr, xi);
                    *(LAS bf16_t*)((LAS unsigned char*)(uintptr_t)(xr_b ^ (unsigned)(t16 << 4)) + t16 * 512) = (bf16_t)(xp & 0xffffu);
                    *(LAS bf16_t*)((LAS unsigned char*)(uintptr_t)(xi_b ^ (unsigned)(t16 << 4)) + t16 * 512) = (bf16_t)(xp >> 16);
                }
            }
        }
        if (FINAL) {
            asm volatile("s_waitcnt lgkmcnt(0)" ::: "memory");
            bf16_t* Y = (bf16_t*)(ws + WS_Y);
#pragma unroll
            for (int mb = 0; mb < 2; ++mb) {
                f32x4 acc = {0.f, 0.f, 0.f, 0.f};
                const int tr = 16 * mb + (lane & 15);
#pragma unroll
                for (int ks = 0; ks < 4; ++ks) { const bf16x8 xf = *(const LAS bf16x8*)(wl + tr * 512 + (((4 * ks + (lane >> 4)) ^ (tr & 15)) << 4));
                    acc = __builtin_amdgcn_mfma_f32_16x16x32_bf16(xf, q.cf[ks], acc, 0, 0, 0); }
#pragma unroll
                for (int i2 = 0; i2 < 4; ++i2) { const int t = 32 * sub + 16 * mb + 4 * (lane >> 4) + i2;
                    const float uv = bf2f(sub == 0 ? q.uq[4 * mb + i2] : q.uq[8 + 4 * mb + i2]);
                    const float yv = acc[i2] + q.dsk * uv;
                    Y[((size_t)b * LP + 64 * c + t) * 512 + 16 * g + (lane & 15)] = (bf16_t)f2bf(gelu_tanh_f(yv)); }
            }
            asm volatile("s_waitcnt lgkmcnt(0)" ::: "memory");
        }
    }
    if (!FINAL) E[((size_t)(b * 132 + c) * 32 + g) * 64 + lane] = make_float2(xr, xi);
}
template <bool FINAL>
__device__ __forceinline__ void s5_run(const Params& p, LAS unsigned char* wl, int first, int stride, int nitems, int lane) {
    S5Ops cur, nxt;
    if (first < nitems) s5_load<FINAL>(p, first, lane, cur);
    for (int it = first; it < nitems; it += stride) {
        if (it + stride < nitems) s5_load<FINAL>(p, it + stride, lane, nxt);
        s5_compute<FINAL>(p, wl, it, lane, cur);
        cur = nxt;
    }
}
__device__ __forceinline__ unsigned long long rt() { return __builtin_amdgcn_s_memrealtime(); }
#define XB_TMO      128
#define XB_XCNT(j)  (256  + 64 * (j))
#define XB_XSUB(j)  (1280 + 64 * (j))
#define XB_XGEN(j)  (2304 + 64 * (j))
#define XB_TOP      3328
#define XB_TOPGEN   3392
#define XCD_BAR_WORDS 3456
#define XB_SPIN_CAP (1u << 18)

__device__ __forceinline__ unsigned xb_ld(unsigned* p)              { return __hip_atomic_load(p, __ATOMIC_RELAXED, __HIP_MEMORY_SCOPE_AGENT); }
__device__ __forceinline__ unsigned xb_add(unsigned* p, unsigned v) { return __hip_atomic_fetch_add(p, v, __ATOMIC_RELAXED, __HIP_MEMORY_SCOPE_AGENT); }
__device__ __forceinline__ unsigned xb_xcc_id() { return (unsigned)__builtin_amdgcn_s_getreg((3 << 11) | 20) & 0xFu; }
#define XB_SPIN(cond, bar) do { unsigned _sp = 0; while (cond) { __builtin_amdgcn_s_sleep(1); \
    if ((++_sp & 255u) == 0u) { if (xb_ld(&(bar)[XB_TMO])) break; if (_sp > XB_SPIN_CAP) { atomicAdd(&(bar)[XB_TMO], 1u); break; } } } } while (0)

struct XcdBarrier {
    unsigned* bar; unsigned x;
    volatile LAS unsigned* st;
};

__device__ __forceinline__ XcdBarrier xcd_barrier_post(unsigned* bar, volatile LAS unsigned* st) {
    XcdBarrier b; b.bar = bar; b.x = xb_xcc_id(); b.st = st;
    if (threadIdx.x == 0) (void)xb_add(&bar[XB_XCNT(b.x)], 1u);
    return b;
}
__device__ __forceinline__ void xcd_barrier_complete(unsigned* bar, unsigned x, unsigned& nloc, unsigned& nx) {
    const unsigned G = gridDim.x * gridDim.y * gridDim.z;
    unsigned sum, cnt, mine, sp = 0u;
    for (;;) {
        sum = 0u; cnt = 0u; mine = 0u;
#pragma unroll
        for (unsigned j = 0; j < 16; ++j) { const unsigned c = xb_ld(&bar[XB_XCNT(j)]); sum += c; cnt += (c > 0u) ? 1u : 0u; mine = (j == x) ? c : mine; }
        if (sum == G) break;
        __builtin_amdgcn_s_sleep(1);
        if ((++sp & 255u) == 0u) { if (xb_ld(&bar[XB_TMO])) break; if (sp > XB_SPIN_CAP) { atomicAdd(&bar[XB_TMO], 1u); break; } }
    }
    nloc = mine > 0u ? mine : 1u; nx = cnt > 0u ? cnt : 1u;
}

__device__ __forceinline__ void xcd_barrier(const XcdBarrier& b) {
    asm volatile("s_waitcnt vmcnt(0)" ::: "memory");
    __syncthreads();
    if (threadIdx.x == 0) {
        unsigned* bar = b.bar;
        __builtin_amdgcn_s_waitcnt(0);
        unsigned nloc = b.st[0], nx = b.st[1];
        if (nloc == 0u) { xcd_barrier_complete(bar, b.x, nloc, nx); b.st[0] = nloc; b.st[1] = nx; }
        const unsigned old = xb_add(&bar[XB_XSUB(b.x)], 1u);
        const unsigned gen = old / nloc;
        if (old + 1u == (gen + 1u) * nloc) {
            __builtin_amdgcn_fence(__ATOMIC_RELEASE, "agent");
            asm volatile("s_waitcnt vmcnt(0)" ::: "memory");
            const unsigned og = xb_add(&bar[XB_TOP], 1u);
            const unsigned tg = og / nx;
            if (og + 1u == (tg + 1u) * nx) xb_add(&bar[XB_TOPGEN], 1u);
            else XB_SPIN(xb_ld(&bar[XB_TOPGEN]) == tg, bar);
            __builtin_amdgcn_fence(__ATOMIC_ACQUIRE, "agent");
            xb_add(&bar[XB_XGEN(b.x)], 1u);
            asm volatile("s_waitcnt vmcnt(0)" ::: "memory");
        } else {
            XB_SPIN(xb_ld(&bar[XB_XGEN(b.x)]) == gen, bar);
            __builtin_amdgcn_fence(__ATOMIC_ACQUIRE, "agent");
            asm volatile("s_waitcnt vmcnt(0)" ::: "memory");
        }
    }
    __syncthreads();
}

__device__ __forceinline__ f32x4 meta_mm(const bf16_t* X, int ldx, const bf16_t* Wt, int K, int n0, int lane, int kb, int ke) {
    const bf16_t* ap = X + (size_t)(PADR + (lane & 15)) * ldx + 8 * (lane >> 4);
    const bf16_t* bp = Wt + (size_t)(n0 + (lane & 15)) * K + 8 * (lane >> 4);
    f32x4 acc = {0.f, 0.f, 0.f, 0.f};
#pragma unroll 4
    for (int k = kb; k < ke; k += 32) { const bf16x8 a = *(const bf16x8*)(ap + k), b = *(const bf16x8*)(bp + k); acc = __builtin_amdgcn_mfma_f32_16x16x32_bf16(a, b, acc, 0, 0, 0); }
    return acc;
}
template <int KIND>
__device__ __forceinline__ void meta_task(LAS unsigned char* lds, int wave, const bf16_t* X, int ldx, const bf16_t* Wt, int K, int n0, int lane, bf16_t* O, int ldc, const ssq_t* ssq_in, float* H, bf16_t* HB, ssq_t* ssq_out) {
    const int ks = K >> 3;
    f32x4 acc = meta_mm(X, ldx, Wt, K, n0, lane, wave * ks, (wave + 1) * ks);
    LAS f32x4* red = (LAS f32x4*)lds;
    red[wave * 64 + lane] = acc;
    __syncthreads();
    if (wave != 0) { __syncthreads(); return; }
#pragma unroll
    for (int w2 = 1; w2 < 8; ++w2) acc += red[w2 * 64 + lane];
    const int c = n0 + (lane & 15);
#pragma unroll
    for (int i = 0; i < 4; ++i) {
        const int r = PADR + 4 * (lane >> 4) + i;
        if (KIND == 0) {
            const float rs = ssq_rs(ssq_in + r);
            const bf16_t v = (bf16_t)f2bf(acc[i] * rs);
#pragma unroll
            for (int b = 0; b < NBATCH; ++b) O[(size_t)(b * LP + r) * ldc + c] = v;
        } else if (KIND == 1) {
            const float hv = bf2f((unsigned short)f2bf(bf2f(HB[(size_t)r * DM + c]) + acc[i]));
            float ss = hv * hv; ss += __shfl_xor(ss, 1); ss += __shfl_xor(ss, 2); ss += __shfl_xor(ss, 4); ss += __shfl_xor(ss, 8);
#pragma unroll
            for (int b = 0; b < NBATCH; ++b) { HB[(size_t)(b * LP + r) * DM + c] = (bf16_t)f2bf(hv); if ((lane & 15) == 0 && ssq_out) atomicAdd(ssq_out + b * LP + r, ssq_fix(ss)); }
        } else {
            const float rs = ssq_rs(ssq_in + r);
            const float v = acc[i] * rs, up = __shfl_xor(v, 4);
            if ((c & 4) == 0) O[(size_t)r * DFF + ((c >> 3) << 2) + (c & 3)] = (bf16_t)f2bf(v / (1.0f + __expf(-v)) * up);
        }
    }
    __syncthreads();
}
__device__ __forceinline__ void zero_pad_rows(bf16_t* B, int pitch, int gw, int NGW, int lane) {
    for (int r = gw; r < NBATCH * PADR; r += NGW) { u32x4* rp = (u32x4*)(B + (size_t)((r / PADR) * LP + (r % PADR)) * pitch);
        for (int j = lane; j < pitch / 8; j += 64) rp[j] = (u32x4){0u, 0u, 0u, 0u}; }
}
#ifndef REP3
#define REP3 1
#endif
#ifndef REP5
#define REP5 1
#endif
#ifndef REP10
#define REP10 1
#endif
#ifndef REP12
#define REP12 1
#endif
#ifndef REP0
#define REP0 1
#endif
#ifndef REP1
#define REP1 1
#endif
#ifndef REP2
#define REP2 1
#endif
#ifndef REP4
#define REP4 1
#endif
#ifndef REP6
#define REP6 1
#endif
#ifndef REP7
#define REP7 1
#endif
#ifndef REP8
#define REP8 1
#endif
#ifndef REP9
#define REP9 1
#endif
#ifndef REP11
#define REP11 1
#endif
__global__ void __launch_bounds__(NTHR, 2) mega_fwd(Params p) {
    extern __shared__ __attribute__((aligned(16))) unsigned char lds_raw[];
    LAS unsigned char* lds = (LAS unsigned char*)lds_raw;
    cg::grid_group grid = cg::this_grid();
    const int tid = threadIdx.x, lane = tid & 63, wave = __builtin_amdgcn_readfirstlane(tid >> 6);
    const int G = gridDim.x, gw = blockIdx.x * NW + wave, NGW = G * NW;
    unsigned char* ws = p.ws;
    unsigned* ctl = (unsigned*)(ws + WS_CTL);
    ssq_t* ssq = (ssq_t*)(ws + WS_SSQ);
    float* Fb = (float*)(ws + WS_F);
    float* H = (float*)(ws + WS_H);
    bf16_t* HB = (bf16_t*)(ws + WS_HB);
    bf16_t* QKV = (bf16_t*)(ws + WS_QKV);
    bf16_t* CAT = (bf16_t*)((unsigned char*)p.out + DO_CAT);
    float* STASH = (float*)((unsigned char*)p.out + DO_STASH);
    const int lo = p.ph_lo, hi_ph = p.ph_hi;
    volatile LAS unsigned* xst = (volatile LAS unsigned*)(lds + 131072 + 64);
    if (tid < 2) xst[tid] = 0u;
    __syncthreads();
    XcdBarrier xbar = xcd_barrier_post((unsigned*)(ws + WS_CTL + 16384), xst);
#ifndef PHMASK
#define PHMASK 0x3fff
#endif
#define IN(k) (((PHMASK >> (k)) & 1) && lo <= (k) && (k) < hi_ph)
#define SEAM(k) do { if (IN(k) && IN((k) + 1)) xcd_barrier(xbar); } while (0)
    if (p.ph_lo < 0) grid.sync();

    for (int rep = 0; rep < (IN(0) ? REP0 : 0); ++rep) {
        for (int i = blockIdx.x * NTHR + tid; i < 3 * MROWS; i += G * NTHR) ssq[MROWS + i] = 0ull;
        for (int row = gw; row < MROWS; row += NGW) {
            const int b = row / LP, pos = row % LP;
            f32x4 v[4]; float s = 0.f;
            if (pos < PADR) {
#pragma unroll
                for (int j = 0; j < 4; ++j) v[j] = (f32x4){0.f, 0.f, 0.f, 0.f};
            } else {
                const float* src = (pos < 256) ? (p.in[1] + (size_t)(pos - PADR) * DM) : (p.in[0] + ((size_t)b * SEQ + (pos - 256)) * DM);
#pragma unroll
                for (int j = 0; j < 4; ++j) { v[j] = ((const f32x4*)src)[lane + 64 * j]; s += (v[j][0] * v[j][0] + v[j][1] * v[j][1]) + (v[j][2] * v[j][2] + v[j][3] * v[j][3]); }
            }
            s = wave_sum(s);
#pragma unroll
            for (int j = 0; j < 4; ++j) {
                u32x2 w; w.x = pk2(v[j][0], v[j][1]); w.y = pk2(v[j][2], v[j][3]); ((u32x2*)(HB + (size_t)row * DM))[lane + 64 * j] = w; }
            if (lane == 0) ssq[row] = ssq_fix(s);
        }
        {
            LAS float* scr = (LAS float*)(lds + wave * 16384);
            const float* nmg = p.in[2]; const float* nfg = p.in[3];
            constexpr int I0 = 16 * 96, I1 = 16 * 32, I2 = 16 * 176, I3 = 44 * 32, I4 = 16 * 65, I5 = 8 * 16, I6 = 16 * 32, I7 = 16 * 176, I8 = 44 * 32;
            constexpr int NIT = I0 + I1 + I2 + I3 + I4 + I5 + I6 + I7 + I8;
            for (int it = gw; it < NIT; it += NGW) {
                int r = it;
                if (r < I0) { transpose_item(p.in[5], 1024, 3072, nmg, (bf16_t*)(ws + WS_W0IN), 1, scr, r, lane); continue; } r -= I0;
                if (r < I1) { transpose_item(p.in[6], 1024, 1024, nullptr, (bf16_t*)(ws + WS_W0OUT), 0, scr, r, lane); continue; } r -= I1;
                if (r < I2) { transpose_item(p.in[25], 1024, 5632, nfg, (bf16_t*)(ws + WS_WGU0), 3, scr, r, lane); continue; } r -= I2;
                if (r < I3) { transpose_item(p.in[26], 2816, 1024, nullptr, (bf16_t*)(ws + WS_WDN0), 0, scr, r, lane); continue; } r -= I3;
                if (r < I4) { transpose_item(p.in[12], 1024, 2056, nmg + 1024, (bf16_t*)(ws + WS_W1IN), 2, scr, r, lane); continue; } r -= I4;
                if (r < I5) { transpose_item(p.in[23], 512, 512, nullptr, (bf16_t*)(ws + WS_WGLU), 0, scr, r, lane); continue; } r -= I5;
                if (r < I6) { transpose_item(p.in[13], 1024, 1024, nullptr, (bf16_t*)(ws + WS_W1OUT), 0, scr, r, lane); continue; } r -= I6;
                if (r < I7) { transpose_item(p.in[25] + (size_t)1024 * 5632, 1024, 5632, nfg + 1024, (bf16_t*)(ws + WS_WGU1), 3, scr, r, lane); continue; } r -= I7;
                transpose_item(p.in[26] + (size_t)2816 * 1024, 2816, 1024, nullptr, (bf16_t*)(ws + WS_WDN1), 0, scr, r, lane);
            }
        }
        for (int idx = blockIdx.x * NTHR + tid; idx < 2048 * 16; idx += G * NTHR) {
            const int i = idx >> 4, h = idx & 15, g = i >> 6;
            const float lre = p.in[15][i], lim = p.in[16][i], dt = expf(p.in[17][g]);
            const float mag = expf(lre * dt), are = mag * cosf(lim * dt), aim = mag * sinf(lim * dt), den = lre * lre + lim * lim;
            const float gre = ((are - 1.0f) * lre + aim * lim) / den, gim = (aim * lre - (are - 1.0f) * lim) / den;
            if (h == 0) { float* ap = (float*)(ws + WS_S5A); ap[i] = are; ap[2048 + i] = aim; }
            float* bbr = (float*)(ws + WS_S5BB); float* bbi = bbr + 2048 * 16;
            bf16_t* bt = (bf16_t*)(ws + WS_S5BT) + ((size_t)g * 128 + (i & 63)) * 16;
            const float br = p.in[18][i * 16 + h], bi = p.in[19][i * 16 + h]; const float vr = gre * br - gim * bi, vi = gre * bi + gim * br;
            bbr[i * 16 + h] = vr; bbi[i * 16 + h] = vi; bt[h] = (bf16_t)f2bf(vr); bt[64 * 16 + h] = (bf16_t)f2bf(vi);
        }
        for (int i = blockIdx.x * NTHR + tid; i < 32 * 16 * 128; i += G * NTHR) {
            const int pp = i & 127, gh = i >> 7;
            const float v = (pp < 64) ? p.in[20][gh * 64 + pp] : -p.in[21][gh * 64 + (pp - 64)];
            ((bf16_t*)(ws + WS_S5CT))[i] = (bf16_t)f2bf(v);
        }
        for (int i = blockIdx.x * NTHR + tid; i < 8 * 1024; i += G * NTHR) {
            const int j = i >> 10, k = i & 1023;
            ((float*)(ws + WS_W1F))[i] = p.in[12][(size_t)k * 2056 + 1536 + j] * p.in[2][1024 + k];
        }
    }
    SEAM(0);

    for (int rep = 0; rep < (IN(1) ? REP1 : 0); ++rep) {
        pg8::Gemm g{HB, (const bf16_t*)(ws + WS_W0IN), MROWS, 3072, 1024}; pg8::StaticOrder S; S.init(NBATCH * SEQ, 3072, G, (int)blockIdx.x);
        pg8::EpiScaleBf16 E{QKV, 3072, ssq};
        pg8::gemm_phase<pg8::EpiScaleBf16, pg8::StaticOrder, true, true>(lds, g, S, E);
        if (rep == 0) { zero_pad_rows(QKV, 3072, gw, NGW, lane);
            for (int t = blockIdx.x; t < 3072 / 16; t += G) meta_task<0>(lds, wave, HB, DM, (const bf16_t*)(ws + WS_W0IN), 1024, 16 * t, lane, QKV, 3072, ssq, nullptr, nullptr, nullptr); }
    }
    SEAM(1);

    for (int rep = 0; rep < (IN(2) ? REP2 : 0); ++rep) {
        float lam;
        { const float a1 = wave_sum(p.in[7][lane] * p.in[8][lane]), a2 = wave_sum(p.in[9][lane] * p.in[10][lane]); lam = expf(a1) - expf(a2) + 0.2f; }
        constexpr int NDIFF = 16 * 33, NSB = 32 * 33;
        LAS int* misc = (LAS int*)(lds + att::L_MISC);
        for (;;) {
            if (tid == 0) misc[0] = (int)atomicAdd(ctl + rep, 1u);
            __syncthreads();
            int idx = misc[0];
            __syncthreads();
#ifdef REP2_DIFF_ONLY
            if (rep > 0 && idx >= NDIFF) break;
#endif
#ifdef REP2_SB_ONLY
            if (rep > 0) idx += NDIFF;
#endif
            if (idx >= NDIFF + NSB) break;
            if (idx < NDIFF) {
#ifndef NO_DIFF
                const int u = 32 - idx / 16, bh = idx % 16, b = bh >> 2, hd = bh & 3;
                const int r32 = lane & 31, hi = lane >> 5;
                f32x4* st = (f32x4*)(STASH + ((size_t)blockIdx.x * NTHR + tid) * 64);
#pragma unroll 1
                for (int comp = 0; comp < 2; ++comp) {
                    att::Args a{QKV, 3072, b * LP, u, 1536 + hd * 128 + comp * 64, 2048 + hd * 128 + comp * 64, 2560 + hd * 128, nullptr, 0.f};
                    f32x16 o[4]; float l;
                    att::run<1, 4, false>(lds, a, o, l);
                    const float inv = (l > 0.f) ? 1.0f / l : 0.f;
                    if (comp == 0) {
#pragma unroll
                        for (int c = 0; c < 4; ++c)
#pragma unroll
                            for (int g4 = 0; g4 < 4; ++g4) st[c * 4 + g4] = (f32x4){o[c][4 * g4] * inv, o[c][4 * g4 + 1] * inv, o[c][4 * g4 + 2] * inv, o[c][4 * g4 + 3] * inv};
                    } else {
                        float ss = 0.f;
#pragma unroll
                        for (int c = 0; c < 4; ++c)
#pragma unroll
                            for (int g4 = 0; g4 < 4; ++g4) { const f32x4 sv = st[c * 4 + g4];
#pragma unroll
                                for (int e = 0; e < 4; ++e) { const float v = sv[e] - lam * (o[c][4 * g4 + e] * inv); o[c][4 * g4 + e] = v; ss += v * v; } }
                        ss += __shfl_xor(ss, 32);
                        const float rs = 0.8f * rsqrtf(ss * (1.0f / 128.0f) + RMS_EPS);
                        const float* sg = p.in[11];
                        bf16_t* op = CAT + (size_t)(b * LP + 256 * u + 32 * wave + r32) * DM + 512 + hd * 128;
#pragma unroll
                        for (int c = 0; c < 4; ++c)
#pragma unroll
                            for (int g4 = 0; g4 < 4; ++g4) { const int dv = 32 * c + 8 * g4 + 4 * hi; const f32x4 gv = *(const f32x4*)(sg + dv);
                                u32x2 w; w.x = pk2(o[c][4 * g4] * rs * gv[0], o[c][4 * g4 + 1] * rs * gv[1]); w.y = pk2(o[c][4 * g4 + 2] * rs * gv[2], o[c][4 * g4 + 3] * rs * gv[3]);
                                *(u32x2*)(op + dv) = w; }
                    }
                }
#endif
            } else {
#ifndef NO_SB
                const int i2 = idx - NDIFF, u = 32 - i2 / 32, bh = i2 % 32, b = bh >> 3, h = bh & 7;
                const int r32 = lane & 31, hi = lane >> 5;
                att::Args a{QKV, 3072, b * LP, u, h * 64, 512 + h * 64, 1024 + h * 64, nullptr, 0.f};
                f32x16 o[2]; float l;
                att::run<0, 2, false>(lds, a, o, l);
                bf16_t* op = CAT + (size_t)(b * LP + 256 * u + 32 * wave + r32) * DM + h * 64;
#pragma unroll
                for (int c = 0; c < 2; ++c)
#pragma unroll
                    for (int g4 = 0; g4 < 4; ++g4) { const int dv = 32 * c + 8 * g4 + 4 * hi;
                        u32x2 w; w.x = pk2(o[c][4 * g4], o[c][4 * g4 + 1]); w.y = pk2(o[c][4 * g4 + 2], o[c][4 * g4 + 3]); *(u32x2*)(op + dv) = w; }
#endif
            }
        }
    }
    SEAM(2);

    if (IN(3)) {
        pg8::Gemm g{CAT, (const bf16_t*)(ws + WS_W0OUT), MROWS, 1024, 1024}; pg8::StaticOrder S; S.init(NBATCH * SEQ, 1024, G, (int)blockIdx.x);
        pg8::EpiResid<false> E{nullptr, HB, ssq + MROWS};
        pg8::gemm_phase<pg8::EpiResid<false>, pg8::StaticOrder, true, true>(lds, g, S, E);
        for (int t = blockIdx.x; t < 1024 / 16; t += G) meta_task<1>(lds, wave, CAT, DM, (const bf16_t*)(ws + WS_W0OUT), 1024, 16 * t, lane, nullptr, 0, nullptr, H, HB, ssq + MROWS);
    }
    SEAM(3);
    for (int rep = 0; rep < (IN(4) ? REP4 : 0); ++rep) {
        pg8::Gemm g{HB, (const bf16_t*)(ws + WS_WGU0), MROWS, 5632, 1024}; pg8::StaticOrder S; S.init(NBATCH * SEQ, 5632, G, (int)blockIdx.x);
        pg8::EpiSwiGLU E{QKV, ssq + MROWS};
        pg8::gemm_phase<pg8::EpiSwiGLU, pg8::StaticOrder, true, true>(lds, g, S, E);
        if (rep == 0) for (int t = blockIdx.x; t < 5632 / 16; t += G) meta_task<2>(lds, wave, HB, DM, (const bf16_t*)(ws + WS_WGU0), 1024, 16 * t, lane, QKV, 0, ssq + MROWS, nullptr, nullptr, nullptr);
    }
    SEAM(4);
    if (IN(5)) {
        pg8::Gemm g{QKV, (const bf16_t*)(ws + WS_WDN0), MROWS, 1024, 2816}; pg8::StaticOrder S; S.init(NBATCH * SEQ, 1024, G, (int)blockIdx.x);
        pg8::EpiResid<false> E{nullptr, HB, ssq + 2 * MROWS};
        pg8::gemm_phase<pg8::EpiResid<false>, pg8::StaticOrder, true, true>(lds, g, S, E);
        for (int t = blockIdx.x; t < 1024 / 16; t += G) meta_task<1>(lds, wave, QKV, DFF, (const bf16_t*)(ws + WS_WDN0), DFF, 16 * t, lane, nullptr, 0, nullptr, H, HB, ssq + 2 * MROWS);
    }
    SEAM(5);
    for (int rep = 0; rep < (IN(6) ? REP6 : 0); ++rep) {
        {
            pg8::Gemm g{HB, (const bf16_t*)(ws + WS_W1IN), MROWS, 2048, 1024}; pg8::StaticOrder S; S.init(NBATCH * SEQ, 2048, G, (int)blockIdx.x);
            pg8::EpiScaleBf16 E{QKV, 2048, ssq + 2 * MROWS};
            pg8::gemm_phase<pg8::EpiScaleBf16, pg8::StaticOrder, true, true>(lds, g, S, E);
        }
        if (rep == 0) { zero_pad_rows(QKV, 2048, gw, NGW, lane);
            for (int t = blockIdx.x; t < 2048 / 16; t += G) meta_task<0>(lds, wave, HB, DM, (const bf16_t*)(ws + WS_W1IN), 1024, 16 * t, lane, QKV, 2048, ssq + 2 * MROWS, nullptr, nullptr, nullptr); }
        const float* w1f = (const float*)(ws + WS_W1F);
        {
            u32x2 hw[4], hn[4];
            if (gw < MROWS) {
#pragma unroll
                for (int j = 0; j < 4; ++j) hw[j] = ((const u32x2*)(HB + (size_t)gw * DM))[lane + 64 * j];
            }
            for (int row = gw; row < MROWS; row += NGW) {
                const int b = row / LP, pos = row % LP;
                if (row + NGW < MROWS) {
#pragma unroll
                    for (int j = 0; j < 4; ++j) hn[j] = ((const u32x2*)(HB + (size_t)(row + NGW) * DM))[lane + 64 * j];
                }
                f32x4 v[4];
#pragma unroll
                for (int j = 0; j < 4; ++j) v[j] = (f32x4){bflo(hw[j].x), bfhi(hw[j].x), bflo(hw[j].y), bfhi(hw[j].y)};
                const float rs = ssq_rs(ssq + 2 * MROWS + row);
                float mine = 0.f;
#pragma unroll
                for (int hh = 0; hh < 8; ++hh) {
                    float d = 0.f;
#pragma unroll
                    for (int j = 0; j < 4; ++j) { const f32x4 wv = ((const f32x4*)(w1f + hh * 1024))[lane + 64 * j]; d += (v[j][0] * wv[0] + v[j][1] * wv[1]) + (v[j][2] * wv[2] + v[j][3] * wv[3]); }
                    d = wave_sum(d);
                    if (lane == hh) mine = d;
                }
                if (lane < 8) Fb[((size_t)b * 8 + lane) * LP + pos] = log_sigmoid_f(mine * rs + p.in[14][lane]);
#pragma unroll
                for (int j = 0; j < 4; ++j) hw[j] = hn[j];
            }
        }
    }
    SEAM(6);
    for (int rep = 0; rep < (IN(7) ? REP7 : 0); ++rep) {
        LAS float* sc = (LAS float*)lds;
        for (int chain = blockIdx.x; chain < (rep == 0 ? 32 : 0); chain += G) {
            float* Fc = Fb + (size_t)chain * LP;
            { float km = 0.f; const int cb = chain >> 3, ch = chain & 7;
              for (int j = 0; j < 17; ++j) { const int idx = tid * 17 + j; if (idx < LP) { const u32x4* kp = (const u32x4*)(QKV + ((size_t)cb * LP + idx) * 2048 + 512 + ch * 64); float s2 = 0.f;
#pragma unroll
                  for (int q4 = 0; q4 < 8; ++q4) { const u32x4 kv = kp[q4]; const float e0 = bflo(kv.x), e1 = bfhi(kv.x), e2 = bflo(kv.y), e3 = bfhi(kv.y), e4 = bflo(kv.z), e5 = bfhi(kv.z), e6 = bflo(kv.w), e7 = bfhi(kv.w);
                      s2 += (e0 * e0 + e1 * e1) + (e2 * e2 + e3 * e3) + (e4 * e4 + e5 * e5) + (e6 * e6 + e7 * e7); }
                  km = fmaxf(km, s2); } }
#pragma unroll
              for (int o2 = 32; o2 >= 1; o2 >>= 1) km = fmaxf(km, __shfl_xor(km, o2));
              if (lane == 0) sc[512 + wave] = km;
              __syncthreads();
              if (tid == 0) { float m8 = sc[512]; for (int w8 = 1; w8 < 8; ++w8) m8 = fmaxf(m8, sc[512 + w8]); ((float*)(ws + WS_CTL + 4096))[chain] = m8; }
              __syncthreads(); }
            float loc[17]; float run = 0.f;
#pragma unroll
            for (int j = 0; j < 17; ++j) { const int idx = tid * 17 + j; const float v = (idx < LP) ? Fc[idx] : 0.f; run += v; loc[j] = run; }
            sc[tid] = run;
            __syncthreads();
            for (int off = 1; off < NTHR; off <<= 1) { const float v = sc[tid] + ((tid >= off) ? sc[tid - off] : 0.f); __syncthreads(); sc[tid] = v; __syncthreads(); }
            const float base = sc[tid] - run;
#pragma unroll
            for (int j = 0; j < 17; ++j) { const int idx = tid * 17 + j; if (idx < LP) Fc[idx] = base + loc[j]; }
            __syncthreads();
        }
        __syncthreads();
        if (G > 64) { if (blockIdx.x >= 32) s5_run<false>(p, lds + wave * 16384, (blockIdx.x - 32) * NW + wave, (G - 32) * NW, 4 * 132 * 32, lane); }
        else s5_run<false>(p, lds + wave * 16384, gw, NGW, 4 * 132 * 32, lane);
    }
    SEAM(7);
    for (int rep = 0; rep < (IN(8) ? REP8 : 0); ++rep) {
        s5_run<true>(p, lds + wave * 16384, gw, NGW, 4 * 132 * 32, lane);
        __syncthreads();
        constexpr int NFOX = 32 * 33;
        LAS int* misc = (LAS int*)(lds + att::L_MISC);
        for (;;) {
            if (tid == 0) misc[0] = (int)atomicAdd(ctl + 64 + rep, 1u);
            __syncthreads();
            const int idx = misc[0];
            __syncthreads();
            if (idx >= NFOX) break;
            const int u = 32 - idx / 32, bh = idx % 32, b = bh >> 3, h = bh & 7;
            const int r32 = lane & 31, hi = lane >> 5;
            att::Args a{QKV, 2048, b * LP, u, h * 64, 512 + h * 64, 1024 + h * 64, Fb + (size_t)bh * LP, sqrtf(((const float*)(ws + WS_CTL + 4096))[bh])};
            f32x16 o[2]; float l;
            att::run<1, 2, true>(lds, a, o, l);
            const float inv = 1.0f / l;
            bf16_t* op = CAT + (size_t)(b * LP + 256 * u + 32 * wave + r32) * DM + h * 64;
#pragma unroll
            for (int c = 0; c < 2; ++c)
#pragma unroll
                for (int g4 = 0; g4 < 4; ++g4) { const int dv = 32 * c + 8 * g4 + 4 * hi;
                    u32x2 w; w.x = pk2(o[c][4 * g4] * inv, o[c][4 * g4 + 1] * inv); w.y = pk2(o[c][4 * g4 + 2] * inv, o[c][4 * g4 + 3] * inv); *(u32x2*)(op + dv) = w; }
        }
    }
    SEAM(8);
    for (int rep = 0; rep < (IN(9) ? REP9 : 0); ++rep) {
        pg8::Gemm g{(const bf16_t*)(ws + WS_Y), (const bf16_t*)(ws + WS_WGLU), MROWS, 512, 512}; pg8::StaticOrder S; S.init(NBATCH * SEQ, 512, G, (int)blockIdx.x);
        pg8::EpiGLU E{(const bf16_t*)(ws + WS_Y), p.in[24], CAT};
        pg8::gemm_phase<pg8::EpiGLU, pg8::StaticOrder, true, true>(lds, g, S, E);
    }
    SEAM(9);
    if (IN(10)) {
        pg8::Gemm g{CAT, (const bf16_t*)(ws + WS_W1OUT), MROWS, 1024, 1024}; pg8::StaticOrder S; S.init(NBATCH * SEQ, 1024, G, (int)blockIdx.x);
        pg8::EpiResid<false> E{nullptr, HB, ssq + 3 * MROWS};
        pg8::gemm_phase<pg8::EpiResid<false>, pg8::StaticOrder, true, true>(lds, g, S, E);
    }
    SEAM(10);
    for (int rep = 0; rep < (IN(11) ? REP11 : 0); ++rep) {
        pg8::Gemm g{HB, (const bf16_t*)(ws + WS_WGU1), MROWS, 5632, 1024}; pg8::StaticOrder S; S.init(NBATCH * SEQ, 5632, G, (int)blockIdx.x);
        pg8::EpiSwiGLU E{QKV, ssq + 3 * MROWS};
        pg8::gemm_phase<pg8::EpiSwiGLU, pg8::StaticOrder, true, true>(lds, g, S, E);
    }
    SEAM(11);
    if (IN(12)) {
        pg8::Gemm g{QKV, (const bf16_t*)(ws + WS_WDN1), MROWS, 1024, 2816}; pg8::StaticOrder S; S.init(NBATCH * SEQ, 1024, G, (int)blockIdx.x);
        pg8::EpiResid<true> E{H, HB, nullptr};
        pg8::gemm_phase<pg8::EpiResid<true>, pg8::StaticOrder, true, true>(lds, g, S, E);
    }
    SEAM(12);
#ifdef EXTRA_SYNCS
    for (int k = 0; k < EXTRA_SYNCS; ++k) xcd_barrier(xbar);
#endif
    if (IN(13)) {
        const float* fg = p.in[4];
        {
            f32x4 v[4], vn[4];
            if (gw < NBATCH * SEQ) { const size_t row0 = (size_t)(gw / SEQ) * LP + 256 + (gw % SEQ);
#pragma unroll
                for (int j = 0; j < 4; ++j) v[j] = ((const f32x4*)(H + row0 * DM))[lane + 64 * j]; }
            for (int r = gw; r < NBATCH * SEQ; r += NGW) {
                const int rn = r + NGW;
                if (rn < NBATCH * SEQ) { const size_t rown = (size_t)(rn / SEQ) * LP + 256 + (rn % SEQ);
#pragma unroll
                    for (int j = 0; j < 4; ++j) vn[j] = ((const f32x4*)(H + rown * DM))[lane + 64 * j]; }
                float s = 0.f;
#pragma unroll
                for (int j = 0; j < 4; ++j) s += (v[j][0] * v[j][0] + v[j][1] * v[j][1]) + (v[j][2] * v[j][2] + v[j][3] * v[j][3]);
                const float rs = rsqrtf(wave_sum(s) * (1.0f / 1024.0f) + RMS_EPS);
#pragma unroll
                for (int j = 0; j < 4; ++j) { const f32x4 gv = ((const f32x4*)fg)[lane + 64 * j]; ((f32x4*)(p.out + (size_t)r * DM))[lane + 64 * j] = v[j] * rs * gv; }
#pragma unroll
                for (int j = 0; j < 4; ++j) v[j] = vn[j];
            }
        }
    }
#undef IN
#undef SEAM
}

#ifndef N_LAUNCH_MODE
#define N_LAUNCH_MODE 1
#endif
extern "C" void kernel_launch(void* const* d_in, const int* in_sizes, int n_in, void* d_out, int out_size, void* d_ws, size_t ws_size, hipStream_t stream) {
    static int grid = 0;
    if (grid == 0) {
        if (n_in != 27 || ws_size < WS_END || out_size != NBATCH * SEQ * DM) { fprintf(stderr, "kernel_launch: unexpected shapes (n_in %d, ws %zu, out %d)\n", n_in, ws_size, out_size); grid = -1; return; }
        int dev = 0, cus = 0, per_cu = 0;
        (void)hipGetDevice(&dev); (void)hipDeviceGetAttribute(&cus, hipDeviceAttributeMultiprocessorCount, dev);
        if (hipFuncSetAttribute((const void*)mega_fwd, hipFuncAttributeMaxDynamicSharedMemorySize, LDS_BYTES) != hipSuccess) { fprintf(stderr, "kernel_launch: hipFuncSetAttribute failed\n"); grid = -1; return; }
        if (hipOccupancyMaxActiveBlocksPerMultiprocessor(&per_cu, (const void*)mega_fwd, NTHR, LDS_BYTES) != hipSuccess || per_cu < 1) { fprintf(stderr, "kernel_launch: occupancy query says %d\n", per_cu); per_cu = 1; }
        (void)hipGetLastError();
        grid = cus * 1;
        if (grid <= 0) grid = 256;
    }
    if (grid < 0) return;
    if (hipMemsetAsync((char*)d_ws + WS_CTL, 0, 65536, stream) != hipSuccess) { fprintf(stderr, "kernel_launch: memset of the control words failed\n"); return; }
    Params p{};
    for (int i = 0; i < 27; ++i) p.in[i] = (const float*)d_in[i];
    p.out = (float*)d_out; p.ws = (unsigned char*)d_ws;
#if N_LAUNCH_MODE == 1
    p.ph_lo = 0; p.ph_hi = 14;
    void* args[] = {&p};
    hipError_t e = hipLaunchCooperativeKernel((const void*)mega_fwd, dim3(grid), dim3(NTHR), args, LDS_BYTES, stream);
    if (e != hipSuccess) fprintf(stderr, "cooperative launch failed: %s (grid %d)\n", hipGetErrorString(e), grid);
#else
    for (int ph = 0; ph < 14; ++ph) { p.ph_lo = ph; p.ph_hi = ph + 1; hipLaunchKernelGGL(mega_fwd, dim3(grid), dim3(NTHR), LDS_BYTES, stream, p); }
#endif
}
```
